# Optimizing an MI355X kernel written in HIP

```python
import math
import jax, jax.numpy as jnp
from jax import lax
import numpy as np

D_MODEL = 2048
BATCH = 16
SEQ = 256
DEPTH = 4
DEC_BATCH = 4
DEC_SEQ = 4096
PAST_LEN = 512

GRID_W = 64
Q_BLOCK = 128
N_MIXERS = 3
N_A = (DEPTH + 2) // 3
N_B = (DEPTH + 1) // 3
N_C = DEPTH // 3
ROPE_BASE = 10000.0
EPS = 1e-6
H_A = 16
Q_LORA = 512
KV_LORA = 256
NOPE_A = 128
ROPE_A = 64
V_A = 128
H_B = 16
DH_B = 64
D_B = H_B * 2 * DH_B
H_C = 16
KVH_C = 4
HD_C = 128
G_C = H_C // KVH_C
D_FF = 5632
CONV_W = 3

kernel_name = "hybrid_mla_diff_gqa_convffn_prefix_dit"


def rms_norm(x, g):
    xf = x.astype(jnp.float32)
    y = xf * lax.rsqrt(jnp.mean(xf * xf, axis=-1, keepdims=True) + EPS)
    return (y * g.astype(jnp.float32)).astype(x.dtype)


def modulate(x, shift, scale):
    return x * (1 + scale) + shift


def rope_1d(x, pos):
    d = x.shape[-1]
    half = d // 2
    freqs = ROPE_BASE ** (-jnp.arange(half, dtype=jnp.float32) / half)
    ang = pos[:, None] * freqs[None, :]
    shape = (1, x.shape[1]) + (1,) * (x.ndim - 3) + (half,)
    cos = jnp.cos(ang).reshape(shape)
    sin = jnp.sin(ang).reshape(shape)
    x1 = x[..., :half].astype(jnp.float32)
    x2 = x[..., half:].astype(jnp.float32)
    return jnp.concatenate([x1 * cos - x2 * sin, x1 * sin + x2 * cos], axis=-1).astype(x.dtype)


def rope_2d(x, row, col):
    r = x.shape[-1] // 2
    return jnp.concatenate([rope_1d(x[..., :r], row), rope_1d(x[..., r:], col)], axis=-1)


def sweep_query_blocks(fn, *qs):
    b, s = qs[0].shape[:2]
    nb = s // Q_BLOCK
    blocks = tuple(jnp.moveaxis(q.reshape((b, nb, Q_BLOCK) + q.shape[2:]), 1, 0) for q in qs)
    out = lax.map(lambda blk: fn(*blk), blocks)
    out = jnp.moveaxis(out, 0, 1)
    return out.reshape((b, s) + out.shape[3:])


def mla_project(h, w_down, q_norm, kv_norm, w_uq, row, col):
    b, s, _ = h.shape
    down = h @ w_down
    cq = down[..., :Q_LORA]
    ckv = rms_norm(down[..., Q_LORA:Q_LORA + KV_LORA], kv_norm)
    kpe = down[..., Q_LORA + KV_LORA:]
    q = (rms_norm(cq, q_norm) @ w_uq).reshape(b, s, H_A, NOPE_A + ROPE_A)
    q_nope, q_pe = q[..., :NOPE_A], q[..., NOPE_A:]
    if row is not None:
        q_pe = rope_2d(q_pe, row, col)
        kpe = rope_2d(kpe, row, col)
    return q_nope, q_pe, ckv, kpe


def mla_attend(q_nope, q_pe, ckv, kpe, w_ukv, w_o):
    b, s = q_nope.shape[:2]
    l = ckv.shape[1]
    kv = (ckv @ w_ukv).reshape(b, l, H_A, NOPE_A + V_A)
    k_nope, v = kv[..., :NOPE_A], kv[..., NOPE_A:]
    scale = 1.0 / math.sqrt(NOPE_A + ROPE_A)

    def block(qn, qp):
        sc = (jnp.einsum('bqhd,bkhd->bhqk', qn, k_nope) + jnp.einsum('bqhr,bkr->bhqk', qp, kpe)).astype(jnp.float32) * scale
        p = jax.nn.softmax(sc, axis=-1)
        return jnp.einsum('bhqk,bkhd->bqhd', p.astype(v.dtype), v)

    o = sweep_query_blocks(block, q_nope, q_pe)
    return o.reshape(b, s, H_A * V_A) @ w_o


def mla_mixer(hp, hs, cache_ckv, cache_kpe, row, col, w_down, q_norm, kv_norm, w_uq, w_ukv, w_o):
    qn_p, qpe_p, ckv_p, kpe_p = mla_project(hp, w_down, q_norm, kv_norm, w_uq, None, None)
    out_p = mla_attend(qn_p, qpe_p, ckv_p, kpe_p, w_ukv, w_o)
    qn_s, qpe_s, ckv_s, kpe_s = mla_project(hs, w_down, q_norm, kv_norm, w_uq, row, col)
    out_s = mla_attend(qn_s, qpe_s, jnp.concatenate([cache_ckv, ckv_s], axis=1),
                       jnp.concatenate([cache_kpe, kpe_s], axis=1), w_ukv, w_o)
    return out_p, out_s, ckv_p, kpe_p


def diff_project(h, w_qkv, row, col):
    b, s, _ = h.shape
    qkv = h @ w_qkv
    q = qkv[..., :D_B].reshape(b, s, H_B, 2, DH_B)
    k = qkv[..., D_B:2 * D_B].reshape(b, s, H_B, 2, DH_B)
    v = qkv[..., 2 * D_B:].reshape(b, s, H_B, 2 * DH_B)
    if row is not None:
        q = rope_2d(q, row, col)
        k = rope_2d(k, row, col)
    return q, k, v


def diff_attend(q, k, v, lam, lam_init, subln, w_o):
    b, s = q.shape[:2]
    scale = 1.0 / math.sqrt(DH_B)

    def block(qb):
        sc = jnp.einsum('bqhcd,bkhcd->cbhqk', qb, k).astype(jnp.float32) * scale
        p = jax.nn.softmax(sc, axis=-1)
        a = p[0] - lam * p[1]
        return jnp.einsum('bhqk,bkhe->bqhe', a.astype(v.dtype), v)

    o = sweep_query_blocks(block, q)
    o = rms_norm(o, subln) * (1.0 - lam_init)
    return o.reshape(b, s, D_B) @ w_o


def diff_mixer(hp, hs, cache_k, cache_v, row, col, w_qkv, lam_vecs, subln, w_o, lam_init):
    lv = lam_vecs.astype(jnp.float32)
    lam = jnp.exp(jnp.sum(lv[0] * lv[1])) - jnp.exp(jnp.sum(lv[2] * lv[3])) + lam_init
    q_p, k_p, v_p = diff_project(hp, w_qkv, None, None)
    out_p = diff_attend(q_p, k_p, v_p, lam, lam_init, subln, w_o)
    q_s, k_s, v_s = diff_project(hs, w_qkv, row, col)
    out_s = diff_attend(q_s, jnp.concatenate([cache_k, k_s], axis=1),
                        jnp.concatenate([cache_v, v_s], axis=1), lam, lam_init, subln, w_o)
    return out_p, out_s, k_p, v_p


def gqa_project(h, w_qkv, q_norm, k_norm, row, col):
    b, s, _ = h.shape
    qkv = h @ w_qkv
    q = rms_norm(qkv[..., :H_C * HD_C].reshape(b, s, H_C, HD_C), q_norm)
    k = rms_norm(qkv[..., H_C * HD_C:(H_C + KVH_C) * HD_C].reshape(b, s, KVH_C, HD_C), k_norm)
    v = qkv[..., (H_C + KVH_C) * HD_C:].reshape(b, s, KVH_C, HD_C)
    if row is not None:
        q = rope_2d(q, row, col)
        k = rope_2d(k, row, col)
    return q, k, v


def gqa_attend(q, k, v, w_o):
    b, s = q.shape[:2]
    qg = q.reshape(b, s, KVH_C, G_C, HD_C)
    scale = 1.0 / math.sqrt(HD_C)

    def block(qb):
        sc = jnp.einsum('bqkgd,blkd->bkgql', qb, k).astype(jnp.float32) * scale
        p = jax.nn.softmax(sc, axis=-1)
        return jnp.einsum('bkgql,blkd->bqkgd', p.astype(v.dtype), v)

    o = sweep_query_blocks(block, qg)
    return o.reshape(b, s, H_C * HD_C) @ w_o


def gqa_mixer(hp, hs, cache_k, cache_v, row, col, w_qkv, q_norm, k_norm, w_o):
    q_p, k_p, v_p = gqa_project(hp, w_qkv, q_norm, k_norm, None, None)
    out_p = gqa_attend(q_p, k_p, v_p, w_o)
    q_s, k_s, v_s = gqa_project(hs, w_qkv, q_norm, k_norm, row, col)
    out_s = gqa_attend(q_s, jnp.concatenate([cache_k, k_s], axis=1),
                       jnp.concatenate([cache_v, v_s], axis=1), w_o)
    return out_p, out_s, k_p, v_p


def conv_ffn(h, w_in, conv_w, conv_b, w_down):
    u = h @ w_in
    up = jnp.pad(u, ((0, 0), (1, 1), (0, 0)))
    u = up[:, :-2] * conv_w[0] + up[:, 1:-1] * conv_w[1] + up[:, 2:] * conv_w[2] + conv_b
    gate, val = u[..., :D_FF], u[..., D_FF:]
    return (jax.nn.silu(gate) * val) @ w_down


def lambda_init_for(layer):
    return 0.8 - 0.6 * math.exp(-0.3 * layer)


def setup_inputs(seed: int = 0) -> dict:
    key = jax.random.key(seed)
    ks = iter(jax.random.split(key, 48))

    def nrm(shape, scale=1.0):
        return jax.random.normal(next(ks), shape, jnp.float32) * scale

    def gain(shape):
        return 1.0 + nrm(shape, 0.1)

    D = D_MODEL
    return {
        "x_prompt": nrm((BATCH, SEQ, D)),
        "x_sample": nrm((DEC_BATCH, DEC_SEQ, D)),
        "c": nrm((DEC_BATCH, D)),
        "cache_a_ckv": nrm((DEC_BATCH, N_A, PAST_LEN, KV_LORA)),
        "cache_a_kpe": nrm((DEC_BATCH, N_A, PAST_LEN, ROPE_A)),
        "cache_b_k": nrm((DEC_BATCH, N_B, PAST_LEN, H_B, 2, DH_B)),
        "cache_b_v": nrm((DEC_BATCH, N_B, PAST_LEN, H_B, 2 * DH_B)),
        "cache_c_k": nrm((DEC_BATCH, N_C, PAST_LEN, KVH_C, HD_C)),
        "cache_c_v": nrm((DEC_BATCH, N_C, PAST_LEN, KVH_C, HD_C)),
        "c_ctx": nrm((D,)),
        "norm_g": gain((DEPTH, 4, D)),
        "w_mod": nrm((DEPTH, D, 6 * D), 0.5 * D ** -0.5),
        "b_mod": nrm((DEPTH, 6 * D), 0.01),
        "ffn_w_in": nrm((DEPTH, D, 2 * D_FF), D ** -0.5),
        "ffn_conv_w": nrm((DEPTH, CONV_W, 2 * D_FF), CONV_W ** -0.5),
        "ffn_conv_b": nrm((DEPTH, 2 * D_FF), 0.01),
        "ffn_w_down": nrm((DEPTH, D_FF, D), D_FF ** -0.5),
        "a_w_down": nrm((N_A, D, Q_LORA + KV_LORA + ROPE_A), D ** -0.5),
        "a_q_norm": gain((N_A, Q_LORA)),
        "a_kv_norm": gain((N_A, KV_LORA)),
        "a_w_uq": nrm((N_A, Q_LORA, H_A * (NOPE_A + ROPE_A)), Q_LORA ** -0.5),
        "a_w_ukv": nrm((N_A, KV_LORA, H_A * (NOPE_A + V_A)), KV_LORA ** -0.5),
        "a_w_o": nrm((N_A, H_A * V_A, D), (H_A * V_A) ** -0.5),
        "b_w_qkv": nrm((N_B, D, 3 * D_B), D ** -0.5),
        "b_lambda": nrm((N_B, 4, DH_B), 0.1),
        "b_subln": gain((N_B, 2 * DH_B)),
        "b_w_o": nrm((N_B, D_B, D), D_B ** -0.5),
        "c_w_qkv": nrm((N_C, D, (H_C + 2 * KVH_C) * HD_C), D ** -0.5),
        "c_q_norm": gain((N_C, HD_C)),
        "c_k_norm": gain((N_C, HD_C)),
        "c_w_o": nrm((N_C, H_C * HD_C, D), (H_C * HD_C) ** -0.5),
    }


def reference(x_prompt, x_sample, c, cache_a_ckv, cache_a_kpe, cache_b_k, cache_b_v, cache_c_k, cache_c_v,
              c_ctx, norm_g, w_mod, b_mod, ffn_w_in, ffn_conv_w, ffn_conv_b, ffn_w_down,
              a_w_down, a_q_norm, a_kv_norm, a_w_uq, a_w_ukv, a_w_o,
              b_w_qkv, b_lambda, b_subln, b_w_o,
              c_w_qkv, c_q_norm, c_k_norm, c_w_o):
    t = x_sample.shape[1]
    rows = t // GRID_W
    row = jnp.repeat(jnp.arange(rows, dtype=jnp.float32), GRID_W)
    col = jnp.tile(jnp.arange(GRID_W, dtype=jnp.float32), rows)

    xp, xs = x_prompt, x_sample
    silu_ctx = jax.nn.silu(c_ctx)
    silu_c = jax.nn.silu(c)
    st_a_ckv, st_a_kpe, st_b_k, st_b_v, st_c_k, st_c_v = [], [], [], [], [], []

    for l in range(DEPTH):
        kind, j = l % N_MIXERS, l // N_MIXERS
        mp = jnp.split(silu_ctx @ w_mod[l] + b_mod[l], 6, axis=-1)
        ms = [m[:, None, :] for m in jnp.split(silu_c @ w_mod[l] + b_mod[l], 6, axis=-1)]

        hp = modulate(rms_norm(xp, norm_g[l, 0]), mp[0], mp[1])
        hs = modulate(rms_norm(xs, norm_g[l, 0]), ms[0], ms[1])
        if kind == 0:
            op, osm, s0, s1 = mla_mixer(hp, hs, cache_a_ckv[:, j], cache_a_kpe[:, j], row, col,
                                        a_w_down[j], a_q_norm[j], a_kv_norm[j], a_w_uq[j], a_w_ukv[j], a_w_o[j])
            st_a_ckv.append(s0)
            st_a_kpe.append(s1)
        elif kind == 1:
            op, osm, s0, s1 = diff_mixer(hp, hs, cache_b_k[:, j], cache_b_v[:, j], row, col,
                                         b_w_qkv[j], b_lambda[j], b_subln[j], b_w_o[j], lambda_init_for(l))
            st_b_k.append(s0)
            st_b_v.append(s1)
        else:
            op, osm, s0, s1 = gqa_mixer(hp, hs, cache_c_k[:, j], cache_c_v[:, j], row, col,
                                        c_w_qkv[j], c_q_norm[j], c_k_norm[j], c_w_o[j])
            st_c_k.append(s0)
            st_c_v.append(s1)
        xp = xp + mp[2] * rms_norm(op, norm_g[l, 1])
        xs = xs + ms[2] * rms_norm(osm, norm_g[l, 1])

        hp = modulate(rms_norm(xp, norm_g[l, 2]), mp[3], mp[4])
        hs = modulate(rms_norm(xs, norm_g[l, 2]), ms[3], ms[4])
        fp = conv_ffn(hp, ffn_w_in[l], ffn_conv_w[l], ffn_conv_b[l], ffn_w_down[l])
        fs = conv_ffn(hs, ffn_w_in[l], ffn_conv_w[l], ffn_conv_b[l], ffn_w_down[l])
        xp = xp + mp[5] * rms_norm(fp, norm_g[l, 3])
        xs = xs + ms[5] * rms_norm(fs, norm_g[l, 3])

    state_a_ckv = jnp.stack(st_a_ckv, axis=1)
    state_a_kpe = jnp.stack(st_a_kpe, axis=1)
    state_b_k = jnp.stack(st_b_k, axis=1)
    state_b_v = jnp.stack(st_b_v, axis=1)
    state_c_k = jnp.stack(st_c_k, axis=1)
    state_c_v = jnp.stack(st_c_v, axis=1)
    return (xp, xs, state_a_ckv, state_a_kpe, state_b_k, state_b_v, state_c_k, state_c_v)
```

```cpp
#include <hip/hip_runtime.h>
#include <cstdio>
#include <cstdint>

namespace pg8 {
#define PG8_LAS __attribute__((address_space(3)))
typedef unsigned short bf16_t;
typedef short bf16x8 __attribute__((ext_vector_type(8)));
typedef float f32x4 __attribute__((ext_vector_type(4)));
typedef unsigned u32x4 __attribute__((ext_vector_type(4)));
constexpr int BM = 256, BK = 64, HALF = 128, HTB = HALF * BK * 2  , STAGE_BYTES = 8 * HTB, NXCD = 8, WGM = 8;

__host__ __device__ __forceinline__ int lds_byte(int r, int c) { const int st = (r >> 4) * 2 + (c >> 5), rr = r & 15, cc = c & 31, ob = rr * 64 + cc * 2; return st * 1024 + (ob ^ (((ob >> 9) & 1) << 5)); }
__host__ __device__ __forceinline__ void stage_rc(int b, int& R, int& C) { const int st = b / 1024, sb = b % 1024, swz = sb ^ (((sb >> 9) & 1) << 5); R = (st >> 1) * 16 + swz / 64; C = (st & 1) * 32 + (swz % 64) / 2; }
__host__ __device__ __forceinline__ int perm32(int rho) { const int n = rho >> 4, i = rho & 15; return 8 * (i >> 2) + 4 * n + (i & 3); }

struct Unit { int pm, pn; };
struct Gemm { const bf16_t* A; const bf16_t* Bt; int M, N, K, lda, ldb; };

struct StaticOrder {
    int nM, nN, nwg, G, c;
    __host__ __device__ void init(int M, int N, int G_, int c_) { nM = M / BM; nN = N / BM; nwg = nM * nN; G = G_; c = c_; }
    __host__ __device__ bool next(int i, Unit& u) const {
        const long L = (long)i * G + c; if (L >= nwg) return false;
        int wgid = (int)L; { const int q = nwg / NXCD, r = nwg % NXCD, xcd = wgid % NXCD, off = wgid / NXCD; wgid = (xcd < r ? xcd * (q + 1) : r * (q + 1) + (xcd - r) * q) + off; }
        const int nig = WGM * nN, gid = wgid / nig, fm = gid * WGM, gsz = (nM - fm) < WGM ? (nM - fm) : WGM;
        u.pm = fm + ((wgid % nig) % gsz); u.pn = (wgid % nig) / gsz; return true;
    }
    __device__ __forceinline__ void a_ready(const Unit&) const {}
    __device__ __forceinline__ void done(const Unit&) const {}
};

struct OneUnit {
    Unit u;
    __device__ __forceinline__ bool next(int i, Unit& o) const { if (i) return false; o = u; return true; }
    __device__ __forceinline__ void a_ready(const Unit&) const {}
    __device__ __forceinline__ void done(const Unit&) const {}
};
__device__ __forceinline__ unsigned cvt_pk_bf16(float lo, float hi) { unsigned r; asm volatile("v_cvt_pk_bf16_f32 %0, %1, %2" : "=v"(r) : "v"(lo), "v"(hi)); return r; }

template <class E, class = void> struct EpiHasWt { static constexpr bool v = false; };
template <class E> struct EpiHasWt<E, decltype((void)E::WT)> { static constexpr bool v = true; };
struct EpiBf16 {
    static constexpr bool PERM = true, AFTER_DRAIN = false, PREFETCH = false, AROWPERM = false, WT = true;
    bf16_t* O; int ldc; mutable bool wt = false; bool allow = true;
    __device__ __forceinline__ void operator()(const f32x4 (&acc)[2][2][4][2], const Unit& u, int wr, int wc, int fr, int fq) const {
        const int row0 = u.pm * BM + wr * 64 + fr; const int col0 = u.pn * BM + wc * 32 + 8 * fq;
#pragma unroll
        for (int ai = 0; ai < 2; ++ai)
#pragma unroll
            for (int m = 0; m < 4; ++m) { bf16_t* rowp = O + (size_t)(row0 + ai * HALF + m * 16) * ldc + col0;
#pragma unroll
                for (int bj = 0; bj < 2; ++bj) { const f32x4 v0 = acc[ai][bj][m][0], v1 = acc[ai][bj][m][1];
                    u32x4 w; w.x = cvt_pk_bf16(v0[0], v0[1]); w.y = cvt_pk_bf16(v0[2], v0[3]); w.z = cvt_pk_bf16(v1[0], v1[1]); w.w = cvt_pk_bf16(v1[2], v1[3]);
                    if (wt) __builtin_nontemporal_store(w, (u32x4*)(rowp + bj * HALF)); else *(u32x4*)(rowp + bj * HALF) = w; } }
    }
};
struct EpiF32 {
    static constexpr bool PERM = false, AFTER_DRAIN = false, PREFETCH = false, AROWPERM = false;
    float* C; int ldc, row_off;
    __device__ __forceinline__ void operator()(const f32x4 (&acc)[2][2][4][2], const Unit& u, int wr, int wc, int fr, int fq) const {
        const int row0 = u.pm * BM - row_off + wr * 64 + fr, col0 = u.pn * BM + wc * 32 + 4 * fq;
#pragma unroll
        for (int ai = 0; ai < 2; ++ai)
#pragma unroll
            for (int m = 0; m < 4; ++m) { float* rowp = C + (size_t)(row0 + ai * HALF + m * 16) * ldc + col0;
#pragma unroll
                for (int bj = 0; bj < 2; ++bj)
#pragma unroll
                    for (int n = 0; n < 2; ++n) *(f32x4*)(rowp + bj * HALF + n * 16) = acc[ai][bj][m][n]; }
    }
};

template <class Epi, class Sched, bool ALIGN_EPI = false, bool SP2 = false>
__device__ __forceinline__ void gemm_phase(PG8_LAS unsigned char* lds, const Gemm g, const Sched& S, const Epi& E) {
    int tid_ = threadIdx.x; asm volatile("" : "+v"(tid_));
    const int tid = tid_, wid = __builtin_amdgcn_readfirstlane(tid >> 6), lane = tid & 63, wr = wid >> 2, wc = wid & 3, fr = lane & 15, fq = lane >> 4;
    const int K = g.K, nt = K / BK;
    unsigned voffA[2], voffB[2];
#pragma unroll
    for (int i = 0; i < 2; ++i) { int R, C; stage_rc(tid * 16 + i * 8192, R, C); const int Rb = Epi::PERM ? ((R & ~31) + perm32(R & 31)) : R;
        const int Ra = Epi::AROWPERM ? ((R & ~63) + 4 * (R & 15) + ((R >> 4) & 3)) : R;
        voffA[i] = (unsigned)(Ra * g.lda + C) * 2u; voffB[i] = (unsigned)(Rb * g.ldb + C) * 2u; }
    const size_t kstep = (size_t)(BK * 2);
    const size_t hstepA = (size_t)HALF * g.lda * 2, hstepB = (size_t)HALF * g.ldb * 2;
    const size_t tstepA = 2 * hstepA, tstepB = 2 * hstepB;
    const unsigned ldsw = (unsigned)wid * 1024u;
    const int aoff = lds_byte(wr * 64 + fr, fq * 8), boff = lds_byte(wc * 32 + fr, fq * 8);
#define PG8_SA(b, h) (((b) * 2 + (h)) * HTB)
#define PG8_SB(b, h) ((4 + (b) * 2 + (h)) * HTB)
    const __amdgpu_buffer_rsrc_t rsA = __builtin_amdgcn_make_buffer_rsrc((void*)g.A, 0, 0x7fffffff, 0x00020000), rsB = __builtin_amdgcn_make_buffer_rsrc((void*)g.Bt, 0, 0x7fffffff, 0x00020000);
#define PG8_RS_voffA rsA
#define PG8_RS_voffB rsB
#define PG8_B0_voffA ((const char*)g.A)
#define PG8_B0_voffB ((const char*)g.Bt)
#define PG8_STAGE(bufoff, gbase, voff) PG8_STAGE_(bufoff, gbase, voff, PG8_RS_##voff, PG8_B0_##voff)
#define PG8_STAGE_(bufoff, gbase, voff, rs, b0) do { const unsigned so_ = (unsigned)((const char*)(gbase) - (b0)); _Pragma("unroll") for (int _i = 0; _i < 2; ++_i) \
        __builtin_amdgcn_raw_ptr_buffer_load_lds(rs, (PG8_LAS unsigned*)(lds + (bufoff) + ldsw + _i * 8192), 16, (int)(voff)[_i], (int)so_, 0, 0); } while (0)
#define PG8_LDA(dst, b, h) do { _Pragma("unroll") for (int m = 0; m < 4; ++m) _Pragma("unroll") for (int k = 0; k < 2; ++k) dst[m][k] = *(const PG8_LAS bf16x8*)(lds + PG8_SA(b, h) + aoff + m * 2048 + k * 1024); } while (0)
#define PG8_LDB(dst, b, h) do { _Pragma("unroll") for (int n = 0; n < 2; ++n) _Pragma("unroll") for (int k = 0; k < 2; ++k) dst[n][k] = *(const PG8_LAS bf16x8*)(lds + PG8_SB(b, h) + boff + n * 2048 + k * 1024); } while (0)
#define PG8_MMA(ai, bj, At, Bt) do { __builtin_amdgcn_s_setprio(1); _Pragma("unroll") for (int m = 0; m < 4; ++m) _Pragma("unroll") for (int n = 0; n < 2; ++n) _Pragma("unroll") for (int k = 0; k < 2; ++k) \
        acc[ai][bj][m][n] = __builtin_amdgcn_mfma_f32_16x16x32_bf16(Bt[n][k], At[m][k], acc[ai][bj][m][n], 0, 0, 0); __builtin_amdgcn_s_setprio(0); } while (0)
#define PG8_WAIT_V(n) asm volatile("s_waitcnt vmcnt(" #n ")" ::: "memory")
#define PG8_WAIT_L(n) asm volatile("s_waitcnt lgkmcnt(" #n ")" ::: "memory")
#define PG8_BAR __builtin_amdgcn_s_barrier()
#define PG8_SCHED __builtin_amdgcn_sched_barrier(0)
    Unit cur, nxt; int ui = 0;
    if (!S.next(0, cur)) return;
    f32x4 acc[2][2][4][2];
#pragma unroll
    for (int a = 0; a < 2; ++a)
#pragma unroll
        for (int b = 0; b < 2; ++b)
#pragma unroll
            for (int m = 0; m < 4; ++m)
#pragma unroll
                for (int n = 0; n < 2; ++n) acc[a][b][m][n] = (f32x4){0.f, 0.f, 0.f, 0.f};
    bf16x8 At[4][2], B0[2][2], B1[2][2];
    const char* cA = (const char*)g.A + (size_t)cur.pm * tstepA; const char* cB = (const char*)g.Bt + (size_t)cur.pn * tstepB;
    float pf0 = 0.f, pf1 = 0.f;
    if constexpr (Epi::PREFETCH) E.prefetch(cur, tid, pf0, pf1);
    S.a_ready(cur);
    if constexpr (SP2) {
        PG8_STAGE(PG8_SB(0, 0), cB, voffB); PG8_STAGE(PG8_SB(0, 1), cB + hstepB, voffB); PG8_STAGE(PG8_SA(0, 0), cA, voffA); PG8_STAGE(PG8_SA(0, 1), cA + hstepA, voffA);
        if (wr == 1) PG8_BAR;
        PG8_WAIT_V(2); PG8_BAR;
        PG8_STAGE(PG8_SB(1, 0), cB + kstep, voffB); PG8_STAGE(PG8_SA(1, 0), cA + kstep, voffA); PG8_STAGE(PG8_SB(1, 1), cB + hstepB + kstep, voffB);
        PG8_WAIT_V(6); PG8_BAR;
    } else {
        PG8_STAGE(PG8_SB(0, 0), cB, voffB); PG8_STAGE(PG8_SA(0, 0), cA, voffA); PG8_STAGE(PG8_SB(0, 1), cB + hstepB, voffB); PG8_STAGE(PG8_SA(0, 1), cA + hstepA, voffA);
        if (wr == 1) PG8_BAR;
        PG8_WAIT_V(4); PG8_BAR;
        PG8_STAGE(PG8_SB(1, 0), cB + kstep, voffB); PG8_STAGE(PG8_SA(1, 0), cA + kstep, voffA); PG8_STAGE(PG8_SB(1, 1), cB + hstepB + kstep, voffB);
        PG8_WAIT_V(6); PG8_BAR;
    }
    for (;;) {
        const bool has_next = S.next(ui + 1, nxt);
        const char* nA = has_next ? (const char*)g.A + (size_t)nxt.pm * tstepA : cA; const char* nB = has_next ? (const char*)g.Bt + (size_t)nxt.pn * tstepB : cB;
        for (int t = 0; t < nt; t += 2) {
            const bool last = (t == nt - 2);
            const char* a1 = cA + (size_t)(t + 1) * kstep;
            const char* a2 = last ? nA : cA + (size_t)(t + 2) * kstep; const char* b2 = last ? nB : cB + (size_t)(t + 2) * kstep;
            const char* a3 = a2 + kstep; const char* b3 = b2 + kstep;
            if (last && has_next) S.a_ready(nxt);
            if constexpr (SP2) {
            PG8_LDB(B0, 0, 0); PG8_LDB(B1, 0, 1); PG8_SCHED; PG8_LDA(At, 0, 0); PG8_STAGE(PG8_SA(1, 1), a1 + hstepA, voffA);
            PG8_WAIT_V(8); PG8_WAIT_L(0); PG8_BAR; PG8_MMA(0, 0, At, B0); PG8_MMA(0, 1, At, B1); PG8_BAR; PG8_SCHED;
            PG8_LDA(At, 0, 1); PG8_STAGE(PG8_SB(0, 0), b2, voffB); PG8_STAGE(PG8_SB(0, 1), b2 + hstepB, voffB); PG8_STAGE(PG8_SA(0, 0), a2, voffA);
            PG8_WAIT_V(8); PG8_WAIT_L(0); PG8_BAR; PG8_MMA(1, 0, At, B0); PG8_MMA(1, 1, At, B1); PG8_BAR; PG8_SCHED;
            PG8_LDB(B0, 1, 0); PG8_LDB(B1, 1, 1); PG8_SCHED; PG8_LDA(At, 1, 0); PG8_STAGE(PG8_SA(0, 1), a2 + hstepA, voffA);
            PG8_WAIT_V(8); PG8_WAIT_L(0); PG8_BAR; PG8_MMA(0, 0, At, B0); PG8_MMA(0, 1, At, B1); PG8_BAR; PG8_SCHED;
            PG8_LDA(At, 1, 1); PG8_STAGE(PG8_SB(1, 0), b3, voffB); PG8_STAGE(PG8_SB(1, 1), b3 + hstepB, voffB); PG8_STAGE(PG8_SA(1, 0), a3, voffA);
            PG8_WAIT_V(8); PG8_WAIT_L(0); PG8_BAR; PG8_MMA(1, 0, At, B0); PG8_MMA(1, 1, At, B1); PG8_BAR; PG8_SCHED;
            } else {
            PG8_LDB(B0, 0, 0); PG8_SCHED; PG8_LDA(At, 0, 0); PG8_STAGE(PG8_SA(1, 1), a1 + hstepA, voffA);
            PG8_WAIT_L(8); PG8_BAR; PG8_WAIT_L(0); PG8_MMA(0, 0, At, B0); PG8_BAR; PG8_SCHED;
            PG8_LDB(B1, 0, 1); PG8_STAGE(PG8_SB(0, 0), b2, voffB);
            PG8_BAR; PG8_WAIT_L(0); PG8_MMA(0, 1, At, B1); PG8_BAR;
            PG8_LDA(At, 0, 1); PG8_STAGE(PG8_SA(0, 0), a2, voffA);
            PG8_BAR; PG8_WAIT_L(0); PG8_MMA(1, 0, At, B0); PG8_BAR; PG8_SCHED;
            PG8_STAGE(PG8_SB(0, 1), b2 + hstepB, voffB);
            PG8_WAIT_V(6); PG8_BAR; PG8_MMA(1, 1, At, B1); PG8_BAR;
            PG8_LDB(B0, 1, 0); PG8_SCHED; PG8_LDA(At, 1, 0); PG8_STAGE(PG8_SA(0, 1), a2 + hstepA, voffA);
            PG8_WAIT_L(8); PG8_BAR; PG8_WAIT_L(0); PG8_MMA(0, 0, At, B0); PG8_BAR; PG8_SCHED;
            PG8_LDB(B1, 1, 1); PG8_STAGE(PG8_SB(1, 0), b3, voffB);
            PG8_BAR; PG8_WAIT_L(0); PG8_MMA(0, 1, At, B1); PG8_BAR;
            PG8_LDA(At, 1, 1); PG8_STAGE(PG8_SA(1, 0), a3, voffA);
            PG8_BAR; PG8_WAIT_L(0); PG8_MMA(1, 0, At, B0); PG8_BAR; PG8_SCHED;
            PG8_STAGE(PG8_SB(1, 1), b3 + hstepB, voffB);
            PG8_WAIT_V(6); PG8_BAR; PG8_MMA(1, 1, At, B1); PG8_BAR;
            }
        }
        if constexpr (ALIGN_EPI) { if (wr == 0) PG8_BAR; }
        if constexpr (EpiHasWt<Epi>::v) E.wt = E.allow && !has_next;
        if constexpr (!Epi::AFTER_DRAIN) { if constexpr (Epi::PREFETCH) E.stash(tid, pf0, pf1); E(acc, cur, wr, wc, fr, fq); S.done(cur); }
        if (!has_next) break;
#pragma unroll
        for (int a = 0; a < 2; ++a)
#pragma unroll
            for (int b = 0; b < 2; ++b)
#pragma unroll
                for (int m = 0; m < 4; ++m)
#pragma unroll
                    for (int n = 0; n < 2; ++n) acc[a][b][m][n] = (f32x4){0.f, 0.f, 0.f, 0.f};
        cur = nxt; cA = nA; cB = nB; ++ui;
        if constexpr (Epi::PREFETCH) E.prefetch(cur, tid, pf0, pf1);
        if constexpr (ALIGN_EPI) { if (wr == 1) PG8_BAR; }
    }
    PG8_WAIT_V(0);
    if constexpr (!ALIGN_EPI) { if (wr == 0) PG8_BAR; }
    PG8_BAR;
    if constexpr (Epi::AFTER_DRAIN) { E.fused(acc, cur, wr, wc, fr, fq, lds, wid, lane); S.done(cur); }
#undef PG8_SA
#undef PG8_SB
#undef PG8_STAGE
#undef PG8_STAGE_
#undef PG8_RS_voffA
#undef PG8_RS_voffB
#undef PG8_B0_voffA
#undef PG8_B0_voffB
#undef PG8_LDA
#undef PG8_LDB
#undef PG8_MMA
#undef PG8_WAIT_V
#undef PG8_WAIT_L
#undef PG8_BAR
#undef PG8_SCHED
}
}


#define GAS __attribute__((address_space(1)))
#define LAS __attribute__((address_space(3)))
typedef unsigned short bf16;
typedef unsigned v4u __attribute__((ext_vector_type(4)));
typedef unsigned v2u __attribute__((ext_vector_type(2)));
typedef float f32x4 __attribute__((ext_vector_type(4)));
typedef float f32x2 __attribute__((ext_vector_type(2)));
typedef short bf16x8 __attribute__((ext_vector_type(8)));
typedef short s16x4 __attribute__((ext_vector_type(4)));
typedef float f32x16 __attribute__((ext_vector_type(16)));
#define LDS_WAIT() asm volatile("s_waitcnt lgkmcnt(0)" ::: "memory")
#define VM_WAIT() asm volatile("s_waitcnt vmcnt(0)" ::: "memory")

constexpr int D = 2048, NB = 16, SEQ = 256, DB = 4, DSEQ = 4096, PAST = 512;
constexpr int MP = NB * SEQ, MS = DB * DSEQ, M = MP + MS;
constexpr int LSEQ = PAST + DSEQ;
constexpr int LKV = MP + DB * LSEQ;
constexpr int DFF = 5632, NFF = 2 * DFF;
constexpr float EPS = 1e-6f;
constexpr float LAM_INIT_1 = 0.35550906758f;
constexpr int NWAVES = 8;

constexpr size_t O_YP = 0, O_YS = (size_t)MP * D, O_SA_CKV = (size_t)M * D, O_SA_KPE = O_SA_CKV + (size_t)NB * 2 * SEQ * 256,
                 O_SB_K = O_SA_KPE + (size_t)NB * 2 * SEQ * 64, O_SB_V = O_SB_K + (size_t)NB * SEQ * 2048, O_SC_K = O_SB_V + (size_t)NB * SEQ * 2048,
                 O_SC_V = O_SC_K + (size_t)NB * SEQ * 512, O_END = O_SC_V + (size_t)NB * SEQ * 512;
static_assert(O_END == 65536000, "out size");

constexpr size_t MiB = 1u << 20;
constexpr size_t WS_CTL = 0, CTL_ZERO_BYTES = 1 * MiB;
constexpr size_t WS_MOD = 1 * MiB;
constexpr size_t WS_MISC = 2 * MiB;
constexpr size_t WS_W_A_DOWN = 3 * MiB, WS_W_A_UQ = 11 * MiB, WS_W_A_UKV = 17 * MiB, WS_W_A_O = 21 * MiB;
constexpr size_t WS_W_B_QKV = 37 * MiB, WS_W_B_O = 61 * MiB, WS_W_C_QKV = 69 * MiB, WS_W_C_O = 81 * MiB;
constexpr size_t WS_W_FIN = 89 * MiB, WS_W_FDN = 265 * MiB;
constexpr size_t WS_H = 353 * MiB, WS_T = 433 * MiB, WS_AO = 513 * MiB, WS_R = 593 * MiB, WS_SLAB = 1256 * MiB, WS_X16 = 1320 * MiB, WS_EDGE = 1400 * MiB, WS_END = 1416 * MiB;
constexpr int MSPLIT = 16384;
constexpr size_t SLAB_ELEMS = (size_t)(M - MSPLIT) * D;
constexpr size_t R_U = 0, R_G = 440 * MiB;
constexpr size_t R_A_D1 = 0, R_A_SSP = 40 * MiB  , R_A_CKVF = 60 * MiB, R_A_KPEF = 72 * MiB, R_A_Q = 76 * MiB, R_A_KV = 196 * MiB;
constexpr size_t R_B_Q = 0, R_B_KF = 240 * MiB, R_B_VF = 328 * MiB, R_B_OC = 416 * MiB;
constexpr size_t R_C_Q = 0, R_C_KF = 120 * MiB, R_C_VF = 142 * MiB;
static_assert(R_G + (size_t)M * DFF * 2 <= WS_SLAB - WS_R && R_A_KV + (size_t)LKV * 4096 * 2 <= WS_SLAB - WS_R && R_B_OC + (size_t)M * 4096 * 2 <= WS_SLAB - WS_R, "scratch overlays");
constexpr int CW_BAR = 4096;

constexpr int RING_BYTES = 131072;
constexpr int LDSCTL_OFF = RING_BYTES, MISC_OFF = LDSCTL_OFF + 320;
constexpr int LDS_BYTES = 147456;
constexpr int EPI_LDS_OFF = RING_BYTES + 1024;
static_assert(EPI_LDS_OFF + 12288 <= LDS_BYTES, "LDS map");

struct Params { const float* in[31]; float* out; unsigned char* ws; };
enum { I_XP = 0, I_XS, I_C, I_CA_CKV, I_CA_KPE, I_CB_K, I_CB_V, I_CC_K, I_CC_V, I_CCTX, I_NORMG, I_WMOD, I_BMOD, I_FWIN, I_FCW, I_FCB, I_FWDN,
       I_AWD, I_AQN, I_AKVN, I_AWUQ, I_AWUKV, I_AWO, I_BWQKV, I_BLAM, I_BSUBLN, I_BWO, I_CWQKV, I_CQN, I_CKN, I_CWO };

__device__ __forceinline__ unsigned f2bf(float f) { unsigned u = __builtin_bit_cast(unsigned, f); return (u + 0x7fffu + ((u >> 16) & 1u)) >> 16; }
__device__ __forceinline__ unsigned pk2(float lo, float hi) { return f2bf(lo) | (f2bf(hi) << 16); }
__device__ __forceinline__ float bf2f(unsigned short b) { return __builtin_bit_cast(float, (unsigned)b << 16); }
__device__ __forceinline__ float bflo(unsigned w) { return __builtin_bit_cast(float, w << 16); }
__device__ __forceinline__ float bfhi(unsigned w) { return __builtin_bit_cast(float, w & 0xffff0000u); }
__device__ __forceinline__ float wave_sum(float v) {
#pragma unroll
    for (int o = 1; o < 64; o <<= 1) v += __shfl_xor(v, o);
    return v;
}

#define XB_TMO      128
#define XB_XCNT(j)  (256  + 64 * (j))
#define XB_XSUB(j)  (1280 + 64 * (j))
#define XB_XGEN(j)  (2304 + 64 * (j))
#define XB_TOP      3328
#define XB_TOPGEN   3392
#define XCD_BAR_WORDS 3456
#define XB_SPIN_CAP (1u << 22)

__device__ __forceinline__ unsigned xb_ld(unsigned* p)              { return __hip_atomic_load(p, __ATOMIC_RELAXED, __HIP_MEMORY_SCOPE_AGENT); }
__device__ __forceinline__ unsigned xb_add(unsigned* p, unsigned v) { return __hip_atomic_fetch_add(p, v, __ATOMIC_RELAXED, __HIP_MEMORY_SCOPE_AGENT); }
__device__ __forceinline__ unsigned xb_xcc_id() { return (unsigned)__builtin_amdgcn_s_getreg((3 << 11) | 20) & 0xFu; }
#define XB_SPIN(cond, bar) do { unsigned _sp = 0; while (cond) { __builtin_amdgcn_s_sleep(1); \
    if ((++_sp & 255u) == 0u) { if (xb_ld(&(bar)[XB_TMO])) break; if (_sp > XB_SPIN_CAP) { atomicAdd(&(bar)[XB_TMO], 1u); break; } } } } while (0)

struct XcdBarrier { unsigned* bar; unsigned x; volatile LAS unsigned* st; };

__device__ __forceinline__ XcdBarrier xcd_barrier_post(unsigned* bar, volatile LAS unsigned* st) {
    XcdBarrier b; b.bar = bar; b.x = xb_xcc_id(); b.st = st;
    if (threadIdx.x == 0) (void)xb_add(&bar[XB_XCNT(b.x)], 1u);
    return b;
}
__device__ __forceinline__ void xcd_barrier_complete(unsigned* bar, unsigned x, unsigned& nloc, unsigned& nx) {
    const unsigned G = gridDim.x * gridDim.y * gridDim.z;
    unsigned sum, cnt, mine, sp = 0u;
    for (;;) {
        sum = 0u; cnt = 0u; mine = 0u;
#pragma unroll
        for (unsigned j = 0; j < 16; ++j) { const unsigned c = xb_ld(&bar[XB_XCNT(j)]); sum += c; cnt += (c > 0u) ? 1u : 0u; mine = (j == x) ? c : mine; }
        if (sum == G) break;
        __builtin_amdgcn_s_sleep(1);
        if ((++sp & 255u) == 0u) { if (xb_ld(&bar[XB_TMO])) break; if (sp > XB_SPIN_CAP) { atomicAdd(&bar[XB_TMO], 1u); break; } }
    }
    nloc = mine > 0u ? mine : 1u; nx = cnt > 0u ? cnt : 1u;
}
__device__ __forceinline__ void xcd_barrier(const XcdBarrier& b) {
    asm volatile("s_waitcnt vmcnt(0)" ::: "memory");
    __syncthreads();
    if (threadIdx.x == 0) {
        unsigned* bar = b.bar;
        __builtin_amdgcn_s_waitcnt(0);
        unsigned nloc = b.st[0], nx = b.st[1];
        if (nloc == 0u) { xcd_barrier_complete(bar, b.x, nloc, nx); b.st[0] = nloc; b.st[1] = nx; }
        const unsigned old = xb_add(&bar[XB_XSUB(b.x)], 1u);
        const unsigned gen = old / nloc;
        if (old + 1u == (gen + 1u) * nloc) {
            __builtin_amdgcn_fence(__ATOMIC_RELEASE, "agent");
            asm volatile("s_waitcnt vmcnt(0)" ::: "memory");
            const unsigned og = xb_add(&bar[XB_TOP], 1u);
            const unsigned tg = og / nx;
            if (og + 1u == (tg + 1u) * nx) xb_add(&bar[XB_TOPGEN], 1u);
            else XB_SPIN(xb_ld(&bar[XB_TOPGEN]) == tg, bar);
            __builtin_amdgcn_fence(__ATOMIC_ACQUIRE, "agent");
            xb_add(&bar[XB_XGEN(b.x)], 1u);
            asm volatile("s_waitcnt vmcnt(0)" ::: "memory");
        } else {
            XB_SPIN(xb_ld(&bar[XB_XGEN(b.x)]) == gen, bar);
            __builtin_amdgcn_fence(__ATOMIC_ACQUIRE, "agent");
            asm volatile("s_waitcnt vmcnt(0)" ::: "memory");
        }
    }
    __syncthreads();
}

struct Frame {
    unsigned char* lds;
    LAS unsigned char* ldsl;
    int tid, lane, wave, vcu, G, gw, NGW;
};
__device__ __forceinline__ Frame make_frame(unsigned char* lds) {
    Frame F; F.lds = lds; F.ldsl = (LAS unsigned char*)lds;
    int t = threadIdx.x; asm volatile("" : "+v"(t));
    F.tid = t; F.lane = t & 63; F.wave = __builtin_amdgcn_readfirstlane(t >> 6);
    int bx = blockIdx.x; asm volatile("" : "+s"(bx));
    F.G = gridDim.x; F.vcu = (F.G % 8 == 0) ? (bx % 8) * (F.G / 8) + bx / 8 : bx;
    F.gw = F.vcu * NWAVES + F.wave; F.NGW = F.G * NWAVES;
    return F;
}

__device__ __forceinline__ int wrow_perm(int n, int mode) {
    if (mode == 1) { if (n >= 2560) return n; const int h = n >> 7, d = n & 127; const int wc = 2 * (d >> 6) + ((d >> 4) & 1), nn = (d >> 5) & 1; return (h << 7) + 32 * wc + 16 * nn + (d & 15); }
    if (mode == 2) { const int isval = n >= DFF ? 1 : 0, c = n - isval * DFF; return (c >> 7) * 256 + isval * 128 + (c & 127); }
    return n;
}
__device__ __forceinline__ void p0_transpose_item(const float* __restrict__ W, int K, int N, bf16* __restrict__ WT, LAS float* scr, int item, int lane, int mode, const float* kscale) {
    const int nblk = N / 32, kb = item / nblk, nb = item % nblk, k0 = 64 * kb, n0 = 32 * nb;
    { float tv[32]; const float* wp = W + (size_t)(k0 + (lane >> 5)) * N + n0 + (lane & 31);
#pragma unroll
      for (int i = 0; i < 32; ++i) tv[i] = wp[(size_t)(2 * i) * N];
#pragma unroll
      for (int i = 0; i < 32; ++i) scr[(2 * i + (lane >> 5)) * 33 + (lane & 31)] = tv[i]; }
    LDS_WAIT(); asm volatile("" ::: "memory");
    const int c = lane & 7;
    float ks[8] = {1.f, 1.f, 1.f, 1.f, 1.f, 1.f, 1.f, 1.f};
    if (kscale) {
#pragma unroll
        for (int q = 0; q < 8; ++q) ks[q] = kscale[k0 + 8 * c + q]; }
#pragma unroll
    for (int j = 0; j < 4; ++j) { const int n = (lane >> 3) + 8 * j; const LAS float* s = scr + (8 * c) * 33 + n;
        v4u o; o.x = pk2(s[0 * 33] * ks[0], s[1 * 33] * ks[1]); o.y = pk2(s[2 * 33] * ks[2], s[3 * 33] * ks[3]); o.z = pk2(s[4 * 33] * ks[4], s[5 * 33] * ks[5]); o.w = pk2(s[6 * 33] * ks[6], s[7 * 33] * ks[7]);
        *(v4u*)(WT + (size_t)wrow_perm(n0 + n, mode) * K + k0 + 8 * c) = o; }
    LDS_WAIT(); asm volatile("" ::: "memory");
}

__device__ __forceinline__ float silu_f(float x) { return x / (1.0f + __expf(-x)); }

__device__ __forceinline__ void p0_prologue(const Params& P, unsigned char* ldsp) {
    const Frame F = make_frame(ldsp);
    unsigned char* ws = P.ws;
    {
        LAS float* scr = (LAS float*)(F.ldsl + F.wave * 16384);
        constexpr int IT_AWD = (2048 / 64) * (832 / 32), IT_AWUQ = (512 / 64) * (3072 / 32), IT_AWUKV = (256 / 64) * (4096 / 32), IT_WO = (2048 / 64) * (2048 / 32);
        constexpr int IT_BQKV = (2048 / 64) * (6144 / 32), IT_CQKV = (2048 / 64) * (3072 / 32), IT_FIN = (2048 / 64) * (NFF / 32), IT_FDN = (DFF / 64) * (2048 / 32);
        constexpr int NITEMS = 2 * (IT_AWD + IT_AWUQ + IT_AWUKV + IT_WO) + IT_BQKV + IT_WO + IT_CQKV + IT_WO + 4 * IT_FIN + 4 * IT_FDN;
        for (int it = F.gw; it < NITEMS; it += F.NGW) {
            int r = it; const float* W; bf16* WT; int K, N, mode = 0; const float* kscale = nullptr;
            if (r < 4 * IT_FIN) { const int l = r / IT_FIN; r -= l * IT_FIN; W = P.in[I_FWIN] + (size_t)l * 2048 * NFF; WT = (bf16*)(ws + WS_W_FIN + (size_t)l * 44 * MiB); K = 2048; N = NFF; mode = 2; }
            else if ((r -= 4 * IT_FIN) < 4 * IT_FDN) { const int l = r / IT_FDN; r -= l * IT_FDN; W = P.in[I_FWDN] + (size_t)l * DFF * 2048; WT = (bf16*)(ws + WS_W_FDN + (size_t)l * 22 * MiB); K = DFF; N = 2048; }
            else if ((r -= 4 * IT_FDN) < IT_BQKV) { W = P.in[I_BWQKV]; WT = (bf16*)(ws + WS_W_B_QKV); K = 2048; N = 6144; }
            else if ((r -= IT_BQKV) < IT_CQKV) { W = P.in[I_CWQKV]; WT = (bf16*)(ws + WS_W_C_QKV); K = 2048; N = 3072; mode = 1; }
            else if ((r -= IT_CQKV) < IT_WO) { W = P.in[I_BWO]; WT = (bf16*)(ws + WS_W_B_O); K = 2048; N = 2048; }
            else if ((r -= IT_WO) < IT_WO) { W = P.in[I_CWO]; WT = (bf16*)(ws + WS_W_C_O); K = 2048; N = 2048; }
            else if ((r -= IT_WO) < 2 * IT_WO) { const int j = r / IT_WO; r -= j * IT_WO; W = P.in[I_AWO] + (size_t)j * 2048 * 2048; WT = (bf16*)(ws + WS_W_A_O + (size_t)j * 8 * MiB); K = 2048; N = 2048; }
            else if ((r -= 2 * IT_WO) < 2 * IT_AWD) { const int j = r / IT_AWD; r -= j * IT_AWD; W = P.in[I_AWD] + (size_t)j * 2048 * 832; WT = (bf16*)(ws + WS_W_A_DOWN + (size_t)j * 4 * MiB); K = 2048; N = 832; }
            else if ((r -= 2 * IT_AWD) < 2 * IT_AWUQ) { const int j = r / IT_AWUQ; r -= j * IT_AWUQ; W = P.in[I_AWUQ] + (size_t)j * 512 * 3072; WT = (bf16*)(ws + WS_W_A_UQ + (size_t)j * 3 * MiB); K = 512; N = 3072; kscale = P.in[I_AQN] + j * 512; }
            else { r -= 2 * IT_AWUQ; const int j = r / IT_AWUKV; r -= j * IT_AWUKV; W = P.in[I_AWUKV] + (size_t)j * 256 * 4096; WT = (bf16*)(ws + WS_W_A_UKV + (size_t)j * 2 * MiB); K = 256; N = 4096; }
            p0_transpose_item(W, K, N, WT, scr, r, F.lane, mode, kscale);
        }
    }
    {
        const size_t n16 = (size_t)(1024 - 832) * 2048 * 2 / 16;
        for (size_t i = (size_t)F.gw * 64 + F.lane; i < 2 * n16; i += (size_t)F.NGW * 64) { const size_t j = i / n16, o = i % n16;
            *(v4u*)(ws + WS_W_A_DOWN + j * 4 * MiB + (size_t)832 * 2048 * 2 + o * 16) = (v4u){0u, 0u, 0u, 0u}; }
    }
    {
        float* misc = (float*)(ws + WS_MISC);
        const int e = F.gw * 64 + F.lane;
        if (e < 1024 + 2048) {
            const bool t16 = e < 1024; const int ee = t16 ? e : e - 1024; const int half = t16 ? 16 : 32; const int pos = ee / half, i = ee % half;
            const float fr = exp2f(-(float)i / (float)half * 13.287712379549449f);
            const float ang = (float)pos * fr;
            const double a = (double)ang;
            float* dst = misc + (t16 ? 256 : 4096) + 2 * ee;
            dst[0] = (float)cos(a); dst[1] = (float)sin(a);
        }
        if (F.gw == F.NGW - 1) {
            const float* lv = P.in[I_BLAM];
            const float s0 = wave_sum(lv[F.lane] * lv[64 + F.lane]), s1 = wave_sum(lv[128 + F.lane] * lv[192 + F.lane]);
            if (F.lane == 0) misc[0] = expf(s0) - expf(s1) + LAM_INIT_1;
        }
    }
    {
        LAS float* sl = (LAS float*)F.ldsl;
        LAS float* red = sl + 5 * 2048;
        __syncthreads();
        for (int i = F.tid; i < 5 * 2048; i += 512) { const float x = i < 2048 ? P.in[I_CCTX][i] : P.in[I_C][i - 2048]; sl[i] = silu_f(x); }
        __syncthreads();
        float* MOD = (float*)(ws + WS_MOD);
        for (int u = F.vcu; u < 4 * 96; u += F.G) {
            const int l = u / 96, n0 = (u % 96) * 128;
            const float* wm = P.in[I_WMOD] + (size_t)l * 2048 * 12288 + n0 + 2 * F.lane;
            float a0[5] = {0.f, 0.f, 0.f, 0.f, 0.f}, a1[5] = {0.f, 0.f, 0.f, 0.f, 0.f};
            const int k0 = F.wave * 256;
#pragma unroll 8
            for (int k = k0; k < k0 + 256; ++k) { const f32x2 w = *(const f32x2*)(wm + (size_t)k * 12288);
#pragma unroll
                for (int j = 0; j < 5; ++j) { const float s = sl[j * 2048 + k]; a0[j] += s * w.x; a1[j] += s * w.y; } }
#pragma unroll
            for (int j = 0; j < 5; ++j) { red[(F.wave * 5 + j) * 128 + 2 * F.lane] = a0[j]; red[(F.wave * 5 + j) * 128 + 2 * F.lane + 1] = a1[j]; }
            __syncthreads();
            for (int o = F.tid; o < 5 * 128; o += 512) { const int j = o / 128, n = o % 128; float s = 0.f;
#pragma unroll
                for (int w = 0; w < 8; ++w) s += red[(w * 5 + j) * 128 + n];
                MOD[((size_t)l * 5 + j) * 12288 + n0 + n] = s + P.in[I_BMOD][(size_t)l * 12288 + n0 + n]; }
            __syncthreads();
        }
    }
}

__device__ __forceinline__ int mod_index(int m) { return m < MP ? 0 : 1 + ((m - MP) >> 12); }

template <bool RES, bool NORM, bool XIN, bool XOUT32>
__device__ __forceinline__ void rn_process(int m, int lane, const f32x4 (&xa)[8], const v4u (&xh)[4], const v4u (&ta)[4], const bf16* slab, bf16* X16, float* Xout, const float* ga, const float* gt, const float* gb, const float* sh, const float* sc, bf16* H) {
    float x[4][8];
#pragma unroll
    for (int jj = 0; jj < 4; ++jj) {
        if constexpr (XIN) { const f32x4 a = xa[2 * jj], b = xa[2 * jj + 1];
            x[jj][0] = a.x; x[jj][1] = a.y; x[jj][2] = a.z; x[jj][3] = a.w; x[jj][4] = b.x; x[jj][5] = b.y; x[jj][6] = b.z; x[jj][7] = b.w; }
        else { const v4u w = xh[jj];
            x[jj][0] = bflo(w.x); x[jj][1] = bfhi(w.x); x[jj][2] = bflo(w.y); x[jj][3] = bfhi(w.y); x[jj][4] = bflo(w.z); x[jj][5] = bfhi(w.z); x[jj][6] = bflo(w.w); x[jj][7] = bfhi(w.w); } }
    if constexpr (RES) {
        float t[4][8]; float ss = 0.f;
        if (m >= MSPLIT) {
            const bf16* s0 = slab + (size_t)(m - MSPLIT) * D; const bf16* s1 = s0 + SLAB_ELEMS;
#pragma unroll
            for (int jj = 0; jj < 4; ++jj) { const int c = 8 * (64 * jj + lane); const v4u a = *(const v4u*)(s0 + c), b = *(const v4u*)(s1 + c);
                t[jj][0] = bflo(a.x) + bflo(b.x); t[jj][1] = bfhi(a.x) + bfhi(b.x); t[jj][2] = bflo(a.y) + bflo(b.y); t[jj][3] = bfhi(a.y) + bfhi(b.y);
                t[jj][4] = bflo(a.z) + bflo(b.z); t[jj][5] = bfhi(a.z) + bfhi(b.z); t[jj][6] = bflo(a.w) + bflo(b.w); t[jj][7] = bfhi(a.w) + bfhi(b.w); }
        } else {
#pragma unroll
            for (int jj = 0; jj < 4; ++jj) { const v4u w = ta[jj];
                t[jj][0] = bflo(w.x); t[jj][1] = bfhi(w.x); t[jj][2] = bflo(w.y); t[jj][3] = bfhi(w.y); t[jj][4] = bflo(w.z); t[jj][5] = bfhi(w.z); t[jj][6] = bflo(w.w); t[jj][7] = bfhi(w.w); }
        }
#pragma unroll
        for (int jj = 0; jj < 4; ++jj)
#pragma unroll
            for (int e = 0; e < 8; ++e) ss += t[jj][e] * t[jj][e];
        const float rstd = rsqrtf(wave_sum(ss) * (1.0f / D) + EPS);
#pragma unroll
        for (int jj = 0; jj < 4; ++jj) { const int c = 8 * (64 * jj + lane);
            const f32x4 g0 = *(const f32x4*)(ga + c), g1 = *(const f32x4*)(ga + c + 4), q0 = *(const f32x4*)(gt + c), q1 = *(const f32x4*)(gt + c + 4);
            const float gg[8] = {g0.x, g0.y, g0.z, g0.w, g1.x, g1.y, g1.z, g1.w}, qq[8] = {q0.x, q0.y, q0.z, q0.w, q1.x, q1.y, q1.z, q1.w};
#pragma unroll
            for (int e = 0; e < 8; ++e) x[jj][e] += qq[e] * (t[jj][e] * rstd * gg[e]);
            if constexpr (XOUT32) { float* xr = Xout + (size_t)m * D; *(f32x4*)(xr + c) = (f32x4){x[jj][0], x[jj][1], x[jj][2], x[jj][3]}; *(f32x4*)(xr + c + 4) = (f32x4){x[jj][4], x[jj][5], x[jj][6], x[jj][7]}; }
            else { v4u o; o.x = pk2(x[jj][0], x[jj][1]); o.y = pk2(x[jj][2], x[jj][3]); o.z = pk2(x[jj][4], x[jj][5]); o.w = pk2(x[jj][6], x[jj][7]); *(v4u*)(X16 + (size_t)m * D + c) = o;
                if constexpr (NORM) {
#pragma unroll
                    for (int e = 0; e < 8; e += 2) { const unsigned w = e == 0 ? o.x : (e == 2 ? o.y : (e == 4 ? o.z : o.w)); x[jj][e] = bflo(w); x[jj][e + 1] = bfhi(w); } } }
        }
    }
    if constexpr (NORM) {
        float ss = 0.f;
#pragma unroll
        for (int jj = 0; jj < 4; ++jj)
#pragma unroll
            for (int e = 0; e < 8; ++e) ss += x[jj][e] * x[jj][e];
        const float rstd = rsqrtf(wave_sum(ss) * (1.0f / D) + EPS);
#pragma unroll
        for (int jj = 0; jj < 4; ++jj) { const int c = 8 * (64 * jj + lane);
            const f32x4 g0 = *(const f32x4*)(gb + c), g1 = *(const f32x4*)(gb + c + 4), h0 = *(const f32x4*)(sh + c), h1 = *(const f32x4*)(sh + c + 4), s0 = *(const f32x4*)(sc + c), s1 = *(const f32x4*)(sc + c + 4);
            const float gg[8] = {g0.x, g0.y, g0.z, g0.w, g1.x, g1.y, g1.z, g1.w}, hh[8] = {h0.x, h0.y, h0.z, h0.w, h1.x, h1.y, h1.z, h1.w}, cc[8] = {s0.x, s0.y, s0.z, s0.w, s1.x, s1.y, s1.z, s1.w};
            float y[8];
#pragma unroll
            for (int e = 0; e < 8; ++e) y[e] = (x[jj][e] * rstd * gg[e]) * (1.0f + cc[e]) + hh[e];
            v4u o; o.x = pk2(y[0], y[1]); o.y = pk2(y[2], y[3]); o.z = pk2(y[4], y[5]); o.w = pk2(y[6], y[7]);
            *(v4u*)(H + (size_t)m * D + c) = o; }
    }
}
template <bool RES, bool NORM, bool XIN, bool XOUT32>
__device__ __forceinline__ void resnorm_phase(const Params& P, unsigned char* ldsp, const bf16* T, const float* ga, const float* modv  , int gate_idx,
                                              const float* gb, const float* modn  , int shift_idx, int scale_idx, bf16* H) {
    const Frame F = make_frame(ldsp);
    const float* xin_p = P.in[I_XP]; const float* xin_s = P.in[I_XS]; bf16* X16 = (bf16*)(P.ws + WS_X16);
#define RN_LOAD(m_, XA, XH, TA) do { \
        if constexpr (XIN) { const float* xs_ = (m_) < MP ? xin_p + (size_t)(m_) * D : xin_s + (size_t)((m_) - MP) * D; \
            _Pragma("unroll") for (int jj = 0; jj < 4; ++jj) { const int c = 8 * (64 * jj + F.lane); XA[2 * jj] = *(const f32x4*)(xs_ + c); XA[2 * jj + 1] = *(const f32x4*)(xs_ + c + 4); } } \
        else { _Pragma("unroll") for (int jj = 0; jj < 4; ++jj) XH[jj] = *(const v4u*)(X16 + (size_t)(m_) * D + 8 * (64 * jj + F.lane)); } \
        if constexpr (RES) { if ((m_) < MSPLIT) { _Pragma("unroll") for (int jj = 0; jj < 4; ++jj) TA[jj] = *(const v4u*)(T + (size_t)(m_) * D + 8 * (64 * jj + F.lane)); } } } while (0)
#define RN_PROC(m_, XA, XH, TA) do { const int mi_ = mod_index(m_); \
        rn_process<RES, NORM, XIN, XOUT32>((m_), F.lane, XA, XH, TA, (const bf16*)(P.ws + WS_SLAB), X16, P.out, ga, RES ? modv + (size_t)mi_ * 12288 + (size_t)gate_idx * D : nullptr, gb, \
                              NORM ? modn + (size_t)mi_ * 12288 + (size_t)shift_idx * D : nullptr, NORM ? modn + (size_t)mi_ * 12288 + (size_t)scale_idx * D : nullptr, H); } while (0)
    f32x4 xa[8] = {}, xb[8] = {}; v4u xha[4] = {}, xhb[4] = {}, xhc[4] = {}, ta[4] = {}, tb[4] = {}, tc[4] = {};
    int m = F.gw; if (m >= M) return;
    const int S = F.NGW;
    if constexpr (XIN) {
        RN_LOAD(m, xa, xha, ta);
        for (;;) {
            if (m + S < M) RN_LOAD(m + S, xb, xhb, tb);
            RN_PROC(m, xa, xha, ta); m += S; if (m >= M) break;
            if (m + S < M) RN_LOAD(m + S, xa, xha, ta);
            RN_PROC(m, xb, xhb, tb); m += S; if (m >= M) break;
        }
    } else {
        RN_LOAD(m, xa, xha, ta); if (m + S < M) RN_LOAD(m + S, xa, xhb, tb);
        for (;;) {
            if (m + 2 * S < M) RN_LOAD(m + 2 * S, xa, xhc, tc);
            RN_PROC(m, xa, xha, ta); m += S; if (m >= M) break;
            if (m + 2 * S < M) RN_LOAD(m + 2 * S, xa, xha, ta);
            RN_PROC(m, xa, xhb, tb); m += S; if (m >= M) break;
            if (m + 2 * S < M) RN_LOAD(m + 2 * S, xa, xhb, tb);
            RN_PROC(m, xa, xhc, tc); m += S; if (m >= M) break;
        }
    }
#undef RN_LOAD
#undef RN_PROC
}

__device__ __forceinline__ float rope64(float v, int lane, int trow, int tcol, const f32x2* T16) {
    const int g = lane >> 5, w = lane & 31, i = w & 15;
    const float other = __shfl_xor(v, 16);
    const f32x2 cs = T16[(g ? tcol : trow) * 16 + i];
    return (w < 16) ? v * cs.x - other * cs.y : other * cs.y + v * cs.x;
}
__device__ __forceinline__ float rope_h64(float v, int lane, int pos, const f32x2* T32) {
    const int i = lane & 31;
    const float other = __shfl_xor(v, 32);
    const f32x2 cs = T32[pos * 32 + i];
    return (lane < 32) ? v * cs.x - other * cs.y : other * cs.y + v * cs.x;
}
__device__ __forceinline__ int key_row(int m) { return m < MP ? m : MP + ((m - MP) >> 12) * LSEQ + PAST + ((m - MP) & 4095); }

__device__ __forceinline__ void mla_cache_rows(const Params& P, unsigned char* ldsp, int j) {
    const Frame F = make_frame(ldsp);
    unsigned char* R = P.ws + WS_R; bf16* CKVF = (bf16*)(R + R_A_CKVF); bf16* KPEF = (bf16*)(R + R_A_KPEF);
    for (int r = F.gw; r < DB * PAST; r += F.NGW) {
        const int mb = r >> 9, p = r & 511; const int kr = MP + mb * LSEQ + p;
        const f32x4 c = *(const f32x4*)(P.in[I_CA_CKV] + ((size_t)(mb * 2 + j) * PAST + p) * 256 + 4 * F.lane);
        v2u o; o.x = pk2(c.x, c.y); o.y = pk2(c.z, c.w);
        *(v2u*)(CKVF + (size_t)kr * 256 + 4 * F.lane) = o;
        KPEF[(size_t)kr * 64 + F.lane] = (bf16)f2bf(P.in[I_CA_KPE][((size_t)(mb * 2 + j) * PAST + p) * 64 + F.lane]);
    }
}
__device__ __forceinline__ void diff_cache_rows(const Params& P, unsigned char* ldsp) {
    const Frame F = make_frame(ldsp);
    unsigned char* R = P.ws + WS_R; bf16* KF = (bf16*)(R + R_B_KF); bf16* VF = (bf16*)(R + R_B_VF);
    for (int r = F.gw; r < DB * PAST; r += F.NGW) {
        const int mb = r >> 9, p = r & 511; const int kr = MP + mb * LSEQ + p;
        const float* ck = P.in[I_CB_K] + (size_t)r * 2048; const float* cv = P.in[I_CB_V] + (size_t)r * 2048;
#pragma unroll
        for (int jj = 0; jj < 4; ++jj) { const int c = 8 * (64 * jj + F.lane);
            const f32x4 a = *(const f32x4*)(ck + c), b = *(const f32x4*)(ck + c + 4), e = *(const f32x4*)(cv + c), f = *(const f32x4*)(cv + c + 4);
            v4u o; o.x = pk2(a.x, a.y); o.y = pk2(a.z, a.w); o.z = pk2(b.x, b.y); o.w = pk2(b.z, b.w); *(v4u*)(KF + (size_t)kr * 2048 + c) = o;
            v4u q; q.x = pk2(e.x, e.y); q.y = pk2(e.z, e.w); q.z = pk2(f.x, f.y); q.w = pk2(f.z, f.w); *(v4u*)(VF + (size_t)kr * 2048 + c) = q; }
    }
}
__device__ __forceinline__ void diff_combine_phase(const Params& P, unsigned char* ldsp) {
    const Frame F = make_frame(ldsp);
    const bf16* OC = (const bf16*)(P.ws + WS_R + R_B_OC); bf16* AO = (bf16*)(P.ws + WS_AO);
    const float lam = ((const float*)(P.ws + WS_MISC))[0];
    const f32x2 sg = *(const f32x2*)(P.in[I_BSUBLN] + 2 * F.lane);
    for (int m = F.gw; m < M; m += F.NGW) {
        const unsigned* oc = (const unsigned*)(OC + (size_t)m * 4096) + F.lane; unsigned* ao = (unsigned*)(AO + (size_t)m * 2048) + F.lane;
#pragma unroll 4
        for (int h = 0; h < 16; ++h) { const unsigned w0 = oc[h * 128], w1 = oc[h * 128 + 64];
            const float a = bflo(w0) - lam * bflo(w1), b = bfhi(w0) - lam * bfhi(w1);
            const float rstd = rsqrtf(wave_sum(a * a + b * b) * (1.0f / 128.0f) + EPS) * (1.0f - LAM_INIT_1);
            ao[h * 64] = pk2(a * rstd * sg.x, b * rstd * sg.y); }
    }
}

__device__ __forceinline__ void gqa_cache_rows(const Params& P, unsigned char* ldsp) {
    const Frame F = make_frame(ldsp);
    unsigned char* R = P.ws + WS_R; bf16* KF = (bf16*)(R + R_C_KF); bf16* VF = (bf16*)(R + R_C_VF);
    for (int r = F.gw; r < DB * PAST; r += F.NGW) {
        const int mb = r >> 9, p = r & 511; const int kr = MP + mb * LSEQ + p;
        const float* ck = P.in[I_CC_K] + (size_t)r * 512 + 8 * F.lane; const float* cv = P.in[I_CC_V] + (size_t)r * 512 + 8 * F.lane;
        const f32x4 a = *(const f32x4*)ck, b = *(const f32x4*)(ck + 4), e = *(const f32x4*)cv, f = *(const f32x4*)(cv + 4);
        v4u o; o.x = pk2(a.x, a.y); o.y = pk2(a.z, a.w); o.z = pk2(b.x, b.y); o.w = pk2(b.z, b.w); *(v4u*)(KF + (size_t)kr * 512 + 8 * F.lane) = o;
        v4u q; q.x = pk2(e.x, e.y); q.y = pk2(e.z, e.w); q.z = pk2(f.x, f.y); q.w = pk2(f.z, f.w); *(v4u*)(VF + (size_t)kr * 512 + 8 * F.lane) = q;
    }
}

__device__ __forceinline__ v2u pack4(const f32x4 v) { v2u w; w.x = pg8::cvt_pk_bf16(v[0], v[1]); w.y = pg8::cvt_pk_bf16(v[2], v[3]); return w; }
__device__ __forceinline__ void rot4(f32x4& v0, f32x4& v1, const f32x4 cs01, const f32x4 cs23) {
    const f32x4 c = {cs01.x, cs01.z, cs23.x, cs23.z}, s = {cs01.y, cs01.w, cs23.y, cs23.w};
    const f32x4 a = v0 * c - v1 * s, b = v0 * s + v1 * c; v0 = a; v1 = b;
}
struct EpiMlaDown {
    static constexpr bool PERM = false, AFTER_DRAIN = false, PREFETCH = false, AROWPERM = false;
    bf16* D1; float* SSP; bf16* CKVF; bf16* KPEF; float* SCKV; float* SKPE; const float* kvn; const float* T16; LAS float* Pl; int j;
    __device__ __forceinline__ void operator()(const pg8::f32x4 (&acc)[2][2][4][2], const pg8::Unit& u, int wr, int wc, int fr_, int fq_) const {
        int fr = fr_, fq = fq_; asm volatile("" : "+v"(fr), "+v"(fq));
        const bool smp = u.pm >= MP / 256;
        if (u.pn < 2) {
#pragma unroll
            for (int ai = 0; ai < 2; ++ai)
#pragma unroll
                for (int m = 0; m < 4; ++m) { const int row = u.pm * 256 + ai * 128 + wr * 64 + m * 16 + fr; float ss = 0.f;
#pragma unroll
                    for (int bj = 0; bj < 2; ++bj) { const f32x4 a = acc[ai][bj][m][0], b = acc[ai][bj][m][1];
                        ss += ((a.x * a.x + a.y * a.y) + (a.z * a.z + a.w * a.w)) + ((b.x * b.x + b.y * b.y) + (b.z * b.z + b.w * b.w));
                        bf16* dst = D1 + (size_t)row * 1024 + u.pn * 256 + bj * 128 + wc * 32 + 4 * fq; *(v2u*)dst = pack4(a); *(v2u*)(dst + 16) = pack4(b); }
                    ss += __shfl_xor(ss, 16); ss += __shfl_xor(ss, 32);
                    if (fq == 0) SSP[(size_t)(u.pn * 4 + wc) * M + row] = ss; }
        } else if (u.pn == 2) {
#pragma unroll
            for (int ai = 0; ai < 2; ++ai)
#pragma unroll
                for (int m = 0; m < 4; ++m) { float ss = 0.f;
#pragma unroll
                    for (int bj = 0; bj < 2; ++bj) { const f32x4 a = acc[ai][bj][m][0], b = acc[ai][bj][m][1];
                        ss += ((a.x * a.x + a.y * a.y) + (a.z * a.z + a.w * a.w)) + ((b.x * b.x + b.y * b.y) + (b.z * b.z + b.w * b.w)); }
                    ss += __shfl_xor(ss, 16); ss += __shfl_xor(ss, 32);
                    if (fq == 0) Pl[(ai * 128 + wr * 64 + m * 16 + fr) * 4 + wc] = ss; }
            asm volatile("s_waitcnt lgkmcnt(0)" ::: "memory"); __builtin_amdgcn_s_barrier(); asm volatile("" ::: "memory");
#pragma unroll
            for (int ai = 0; ai < 2; ++ai)
#pragma unroll
                for (int m = 0; m < 4; ++m) { const int rl = ai * 128 + wr * 64 + m * 16 + fr, row = u.pm * 256 + rl; const int t = (row - MP) & 4095;
                    const int kr = smp ? MP + ((row - MP) >> 12) * LSEQ + PAST + t : row;
                    const f32x4 pp = *(const LAS f32x4*)(Pl + rl * 4); const float rstd = rsqrtf(((pp.x + pp.y) + (pp.z + pp.w)) * (1.0f / 256.0f) + EPS);
#pragma unroll
                    for (int bj = 0; bj < 2; ++bj) { const int c = bj * 128 + wc * 32 + 4 * fq;
                        const f32x4 y0 = acc[ai][bj][m][0] * rstd * *(const f32x4*)(kvn + c), y1 = acc[ai][bj][m][1] * rstd * *(const f32x4*)(kvn + c + 16);
                        bf16* dst = CKVF + (size_t)kr * 256 + c; *(v2u*)dst = pack4(y0); *(v2u*)(dst + 16) = pack4(y1);
                        if (!smp) { float* s = SCKV + ((size_t)((row >> 8) * 2 + j) * SEQ + (row & 255)) * 256 + c; *(f32x4*)s = y0; *(f32x4*)(s + 16) = y1; } } }
        } else if (wc < 2) {
#pragma unroll
            for (int ai = 0; ai < 2; ++ai)
#pragma unroll
                for (int m = 0; m < 4; ++m) { const int row = u.pm * 256 + ai * 128 + wr * 64 + m * 16 + fr; const int t = (row - MP) & 4095;
                    const int kr = smp ? MP + ((row - MP) >> 12) * LSEQ + PAST + t : row; const int c = wc * 32 + 4 * fq;
                    f32x4 v0 = acc[ai][0][m][0], v1 = acc[ai][0][m][1];
                    if (smp) { const int pos = wc ? (t & 63) : (t >> 6); const float* tp = T16 + (pos * 16 + 4 * fq) * 2; rot4(v0, v1, *(const f32x4*)tp, *(const f32x4*)(tp + 4)); }
                    else { float* s = SKPE + ((size_t)((row >> 8) * 2 + j) * SEQ + (row & 255)) * 64 + c; *(f32x4*)s = v0; *(f32x4*)(s + 16) = v1; }
                    bf16* dst = KPEF + (size_t)kr * 64 + c; *(v2u*)dst = pack4(v0); *(v2u*)(dst + 16) = pack4(v1); }
        }
    }
};
struct EpiMlaQ {
    static constexpr bool PERM = false, AFTER_DRAIN = false, PREFETCH = false, AROWPERM = false;
    bf16* Q; const float* T16; const float* SSP; LAS float* RSL;
    __device__ __forceinline__ void operator()(const pg8::f32x4 (&acc)[2][2][4][2], const pg8::Unit& u, int wr, int wc, int fr, int fq) const {
        const bool smp = u.pm >= MP / 256;
        { const int tid = (wr * 4 + wc) * 64 + fq * 16 + fr;
          if (tid < 256) { const int row = u.pm * 256 + tid; float s = 0.f;
#pragma unroll
              for (int q = 0; q < 8; ++q) s += SSP[(size_t)q * M + row];
              RSL[tid] = rsqrtf(s * (1.0f / 512.0f) + EPS); }
          asm volatile("s_waitcnt lgkmcnt(0)" ::: "memory"); __builtin_amdgcn_s_barrier(); asm volatile("" ::: "memory"); }
#pragma unroll
        for (int ai = 0; ai < 2; ++ai)
#pragma unroll
            for (int m = 0; m < 4; ++m) {
                const int rl = ai * 128 + wr * 64 + m * 16 + fr, row = u.pm * 256 + rl; const int t = (row - MP) & 4095;
                const float rs = RSL[rl];
#pragma unroll
                for (int bj = 0; bj < 2; ++bj) {
                    const int colb = u.pn * 256 + bj * 128 + wc * 32; const int g6 = (colb >> 5) % 6;
                    f32x4 v0 = acc[ai][bj][m][0] * rs, v1 = acc[ai][bj][m][1] * rs;
                    if (smp && g6 >= 4) { const int pos = g6 == 4 ? (t >> 6) : (t & 63); const float* tp = T16 + (pos * 16 + 4 * fq) * 2; rot4(v0, v1, *(const f32x4*)tp, *(const f32x4*)(tp + 4)); }
                    bf16* dst = Q + (size_t)row * 3072 + colb + 4 * fq;
                    *(v2u*)dst = pack4(v0); *(v2u*)(dst + 16) = pack4(v1);
                }
            }
    }
};
struct EpiDiffQKV {
    static constexpr bool PERM = false, AFTER_DRAIN = false, PREFETCH = false, AROWPERM = false;
    bf16* Q; bf16* KF; bf16* VF; float* SK; float* SV; const float* T16;
    __device__ __forceinline__ void operator()(const pg8::f32x4 (&acc)[2][2][4][2], const pg8::Unit& u, int wr, int wc, int fr, int fq) const {
        const int region = u.pn >> 3; const bool smp = u.pm >= MP / 256;
#pragma unroll
        for (int ai = 0; ai < 2; ++ai)
#pragma unroll
            for (int m = 0; m < 4; ++m) {
                const int row = u.pm * 256 + ai * 128 + wr * 64 + m * 16 + fr; const int t = (row - MP) & 4095;
                const int kr = smp ? MP + ((row - MP) >> 12) * LSEQ + PAST + t : row;
#pragma unroll
                for (int bj = 0; bj < 2; ++bj) {
                    const int colr = (u.pn & 7) * 256 + bj * 128 + wc * 32 + 4 * fq;
                    f32x4 v0 = acc[ai][bj][m][0], v1 = acc[ai][bj][m][1];
                    if (region < 2 && smp) { const int pos = (wc & 1) ? (t & 63) : (t >> 6); const float* tp = T16 + (pos * 16 + 4 * fq) * 2; rot4(v0, v1, *(const f32x4*)tp, *(const f32x4*)(tp + 4)); }
                    bf16* dst = region == 0 ? Q + (size_t)row * 2048 + colr : (region == 1 ? KF : VF) + (size_t)kr * 2048 + colr;
                    *(v2u*)dst = pack4(v0); *(v2u*)(dst + 16) = pack4(v1);
                    if (region >= 1 && !smp) { float* s = (region == 1 ? SK : SV) + (size_t)row * 2048 + colr; *(f32x4*)s = v0; *(f32x4*)(s + 16) = v1; }
                }
            }
    }
};
struct EpiGqaQKV {
    static constexpr bool PERM = false, AFTER_DRAIN = false, PREFETCH = false, AROWPERM = false;
    bf16* Q; bf16* KF; bf16* VF; float* SK; float* SV; const float* T32; const float* qn; const float* kn; LAS float* Pl;
    __device__ __forceinline__ void operator()(const pg8::f32x4 (&acc)[2][2][4][2], const pg8::Unit& u, int wr, int wc, int fr, int fq) const {
        const bool smp = u.pm >= MP / 256; const bool isv = u.pn >= 10, isk = u.pn >= 8 && !isv;
        if (!isv) {
#pragma unroll
            for (int ai = 0; ai < 2; ++ai)
#pragma unroll
                for (int m = 0; m < 4; ++m)
#pragma unroll
                    for (int bj = 0; bj < 2; ++bj) { const f32x4 a = acc[ai][bj][m][0], b = acc[ai][bj][m][1];
                        float ss = ((a.x * a.x + a.y * a.y) + (a.z * a.z + a.w * a.w)) + ((b.x * b.x + b.y * b.y) + (b.z * b.z + b.w * b.w));
                        ss += __shfl_xor(ss, 16); ss += __shfl_xor(ss, 32);
                        if (fq == 0) Pl[((ai * 128 + wr * 64 + m * 16 + fr) * 2 + bj) * 4 + wc] = ss; }
            asm volatile("s_waitcnt lgkmcnt(0)" ::: "memory"); __builtin_amdgcn_s_barrier(); asm volatile("" ::: "memory");
        }
#pragma unroll
        for (int ai = 0; ai < 2; ++ai)
#pragma unroll
            for (int m = 0; m < 4; ++m) {
                const int row = u.pm * 256 + ai * 128 + wr * 64 + m * 16 + fr; const int t = (row - MP) & 4095;
                const int kr = smp ? MP + ((row - MP) >> 12) * LSEQ + PAST + t : row;
#pragma unroll
                for (int bj = 0; bj < 2; ++bj) {
                    const int head = u.pn * 2 + bj;
                    f32x4 v0 = acc[ai][bj][m][0], v1 = acc[ai][bj][m][1];
                    if (isv) { const int c = (head - 20) * 128 + wc * 32 + 4 * fq; bf16* dst = VF + (size_t)kr * 512 + c; *(v2u*)dst = pack4(v0); *(v2u*)(dst + 16) = pack4(v1);
                        if (!smp) { float* s = SV + (size_t)row * 512 + c; *(f32x4*)s = v0; *(f32x4*)(s + 16) = v1; } }
                    else {
                        const f32x4 pp = *(const LAS f32x4*)(Pl + ((ai * 128 + wr * 64 + m * 16 + fr) * 2 + bj) * 4);
                        const float rstd = rsqrtf(((pp.x + pp.y) + (pp.z + pp.w)) * (1.0f / 128.0f) + EPS);
                        const int d0 = 64 * (wc >> 1) + 16 * (wc & 1) + 4 * fq;
                        const float* gn = isk ? kn : qn;
                        v0 = v0 * rstd * *(const f32x4*)(gn + d0); v1 = v1 * rstd * *(const f32x4*)(gn + d0 + 32);
                        if (isk && !smp) { float* s = SK + (size_t)row * 512 + (head - 16) * 128 + d0; *(f32x4*)s = v0; *(f32x4*)(s + 32) = v1; }
                        if (smp) { const int pos = (wc >> 1) ? (t & 63) : (t >> 6); const float* tp = T32 + (pos * 32 + 16 * (wc & 1) + 4 * fq) * 2; rot4(v0, v1, *(const f32x4*)tp, *(const f32x4*)(tp + 4)); }
                        bf16* dst = isk ? KF + (size_t)kr * 512 + (head - 16) * 128 + d0 : Q + (size_t)row * 2048 + head * 128 + d0;
                        *(v2u*)dst = pack4(v0); *(v2u*)(dst + 32) = pack4(v1);
                    }
                }
            }
    }
};

template <int CTRL> __device__ __forceinline__ float dppf(float old, float src) { return __builtin_bit_cast(float, __builtin_amdgcn_update_dpp(__builtin_bit_cast(int, old), __builtin_bit_cast(int, src), CTRL, 0xf, 0xf, false)); }
constexpr int DPP_SHL1 = 0x101, DPP_SHR1 = 0x111, DPP_ROR1 = 0x121, DPP_ROR15 = 0x12F;
__device__ __forceinline__ void fmac_shr1(float& y, float src, float wv) { asm("v_fmac_f32_dpp %0, %1, %2 row_shr:1 row_mask:0xf bank_mask:0xf" : "+v"(y) : "v"(src), "v"(wv)); }
__device__ __forceinline__ void fmac_shl1(float& y, float src, float wv) { asm("v_fmac_f32_dpp %0, %1, %2 row_shl:1 row_mask:0xf bank_mask:0xf" : "+v"(y) : "v"(src), "v"(wv)); }
__device__ __forceinline__ void fmac_ror1(float& y, float src, float wv) { asm("v_fmac_f32_dpp %0, %1, %2 row_ror:1 row_mask:0xf bank_mask:0xf" : "+v"(y) : "v"(src), "v"(wv)); }
__device__ __forceinline__ void fmac_ror15(float& y, float src, float wv) { asm("v_fmac_f32_dpp %0, %1, %2 row_ror:15 row_mask:0xf bank_mask:0xf" : "+v"(y) : "v"(src), "v"(wv)); }
__device__ __forceinline__ float silu_gate(float g, float v) { return g * v * __builtin_amdgcn_rcpf(1.0f + __builtin_amdgcn_exp2f(-1.4426950408889634f * g)); }
struct EpiConvGate {
    static constexpr bool PERM = true, AFTER_DRAIN = false, PREFETCH = true, AROWPERM = true;
    bf16* G; float* EDGE; const float* cw; const float* cb; LAS float* EX;
    __device__ __forceinline__ void prefetch(const pg8::Unit& u, int tid, float& p0, float& p1) const {
        const int idx = tid * 2, k = idx >> 8, bjl = (idx >> 7) & 1, cl = idx & 127;
        const float* src = (k < 3 ? cw + (size_t)k * NFF : cb) + bjl * DFF + u.pn * 128 + cl; const f32x2 v = *(const f32x2*)src; p0 = v.x; p1 = v.y; }
    __device__ __forceinline__ void stash(int tid, float p0, float p1) const { *(LAS f32x2*)(EX + 2048 + tid * 2) = (f32x2){p0, p1}; }
    __device__ __forceinline__ void operator()(const pg8::f32x4 (&acc)[2][2][4][2], const pg8::Unit& u, int wr, int wc, int fr, int fq) const {
        const int ch = wc * 32 + 8 * fq;
        LAS float* WL = EX + 2048;
#pragma unroll
        for (int ai = 0; ai < 2; ++ai) { const int b = 2 * ai + wr;
#pragma unroll
            for (int bj = 0; bj < 2; ++bj)
#pragma unroll
                for (int n = 0; n < 2; ++n) {
                    if (fr == 0)  *(LAS f32x4*)(EX + ((b * 2 + 0) * 2 + bj) * 128 + ch + 4 * n) = acc[ai][bj][0][n];
                    if (fr == 15) *(LAS f32x4*)(EX + ((b * 2 + 1) * 2 + bj) * 128 + ch + 4 * n) = acc[ai][bj][3][n];
                } }
        if (u.pm >= MP / 256) {
            float* ed = EDGE + ((size_t)u.pm * 44 + u.pn) * 1024;
#pragma unroll
            for (int bj = 0; bj < 2; ++bj)
#pragma unroll
                for (int n = 0; n < 2; ++n) {
                    if (wr == 0 && fr == 0)  { *(f32x4*)(ed + 0 * 256 + bj * 128 + ch + 4 * n) = acc[0][bj][0][n]; *(f32x4*)(ed + 1 * 256 + bj * 128 + ch + 4 * n) = acc[0][bj][1][n]; }
                    if (wr == 1 && fr == 15) { *(f32x4*)(ed + 2 * 256 + bj * 128 + ch + 4 * n) = acc[1][bj][2][n]; *(f32x4*)(ed + 3 * 256 + bj * 128 + ch + 4 * n) = acc[1][bj][3][n]; }
                }
        }
        asm volatile("s_waitcnt lgkmcnt(0)" ::: "memory"); __builtin_amdgcn_s_barrier(); asm volatile("" ::: "memory");
        v2u keep[2][4];
#pragma unroll
        for (int n = 0; n < 2; ++n) {
            f32x4 w0[2], w1[2], w2[2], bb[2], w0e[2], w2e[2];
#pragma unroll
            for (int bj = 0; bj < 2; ++bj) { const int c = bj * 128 + ch + 4 * n; const f32x4 z = {0.f, 0.f, 0.f, 0.f};
                w0[bj] = *(const LAS f32x4*)(WL + c); w1[bj] = *(const LAS f32x4*)(WL + 256 + c); w2[bj] = *(const LAS f32x4*)(WL + 512 + c); bb[bj] = *(const LAS f32x4*)(WL + 768 + c);
                w0e[bj] = fr == 0 ? w0[bj] : z; w2e[bj] = fr == 15 ? w2[bj] : z; }
#pragma unroll
            for (int ai = 0; ai < 2; ++ai) { const int b = 2 * ai + wr;
                f32x4 y[2][4];
#pragma unroll
                for (int bj = 0; bj < 2; ++bj) {
                    const f32x4 z = {0.f, 0.f, 0.f, 0.f};
                    const f32x4 ht = b > 0 ? *(const LAS f32x4*)(EX + (((b - 1) * 2 + 1) * 2 + bj) * 128 + ch + 4 * n) : z;
                    const f32x4 hb = b < 3 ? *(const LAS f32x4*)(EX + (((b + 1) * 2 + 0) * 2 + bj) * 128 + ch + 4 * n) : z;
                    const f32x4 v0 = acc[ai][bj][0][n], v1 = acc[ai][bj][1][n], v2 = acc[ai][bj][2][n], v3 = acc[ai][bj][3][n];
                    f32x4 y0 = w1[bj] * v0 + bb[bj] + w2[bj] * v1 + w0e[bj] * ht;
                    const f32x4 y1 = w1[bj] * v1 + bb[bj] + w0[bj] * v0 + w2[bj] * v2;
                    const f32x4 y2 = w1[bj] * v2 + bb[bj] + w0[bj] * v1 + w2[bj] * v3;
                    f32x4 y3 = w1[bj] * v3 + bb[bj] + w0[bj] * v2 + w2e[bj] * hb;
#pragma unroll
                    for (int e = 0; e < 4; ++e) { float a0 = y0[e], a3 = y3[e];
                        fmac_shr1(a0, v3[e], w0[bj][e]);
                        fmac_shl1(a3, v0[e], w2[bj][e]);
                        y0[e] = a0; y3[e] = a3; }
                    y[bj][0] = y0; y[bj][1] = y1; y[bj][2] = y2; y[bj][3] = y3;
                }
#pragma unroll
                for (int m = 0; m < 4; ++m) { f32x4 g;
#pragma unroll
                    for (int e = 0; e < 4; ++e) g[e] = silu_gate(y[0][m][e], y[1][m][e]);
                    const int row = u.pm * 256 + ai * 128 + wr * 64 + 4 * fr + m;
                    const v2u pk = pack4(g);
                    if (n == 0) keep[ai][m] = pk;
                    else { v4u o; o.x = keep[ai][m].x; o.y = keep[ai][m].y; o.z = pk.x; o.w = pk.y; *(v4u*)(G + (size_t)row * DFF + u.pn * 128 + ch) = o; } }
            }
        }
    }
};
__device__ __forceinline__ void conv_fix_phase(const Params& P, unsigned char* ldsp, int l) {
    const Frame F = make_frame(ldsp);
    bf16* G = (bf16*)(P.ws + WS_R + R_G); const float* EDGE = (const float*)(P.ws + WS_EDGE);
    const float* cw = P.in[I_FCW] + (size_t)l * 3 * NFF; const float* cb = P.in[I_FCB] + (size_t)l * NFF;
    for (int it = F.gw; it < DB * 15 * 44; it += F.NGW) {
        const int pn = it % 44, eb = it / 44, mb = eb / 15, k = eb % 15, pm = MP / 256 + mb * 16 + k;
        const float* e0 = EDGE + ((size_t)pm * 44 + pn) * 1024; const float* e1 = EDGE + ((size_t)(pm + 1) * 44 + pn) * 1024;
        const int c2 = 2 * F.lane;
        f32x2 ua[2], ub[2], uc[2], ud[2], w0[2], w1[2], w2[2], bb[2];
#pragma unroll
        for (int bj = 0; bj < 2; ++bj) { ua[bj] = *(const f32x2*)(e0 + 2 * 256 + bj * 128 + c2); ub[bj] = *(const f32x2*)(e0 + 3 * 256 + bj * 128 + c2); uc[bj] = *(const f32x2*)(e1 + bj * 128 + c2); ud[bj] = *(const f32x2*)(e1 + 256 + bj * 128 + c2);
            const int c = bj * DFF + pn * 128 + c2; w0[bj] = *(const f32x2*)(cw + c); w1[bj] = *(const f32x2*)(cw + NFF + c); w2[bj] = *(const f32x2*)(cw + 2 * NFF + c); bb[bj] = *(const f32x2*)(cb + c); }
        f32x2 ya[2], yb[2];
#pragma unroll
        for (int bj = 0; bj < 2; ++bj) { ya[bj] = w0[bj] * ua[bj] + w1[bj] * ub[bj] + w2[bj] * uc[bj] + bb[bj]; yb[bj] = w0[bj] * ub[bj] + w1[bj] * uc[bj] + w2[bj] * ud[bj] + bb[bj]; }
        const int rlast = pm * 256 + 255;
        *(unsigned*)(G + (size_t)rlast * DFF + pn * 128 + c2) = pg8::cvt_pk_bf16(silu_gate(ya[0].x, ya[1].x), silu_gate(ya[0].y, ya[1].y));
        *(unsigned*)(G + (size_t)(rlast + 1) * DFF + pn * 128 + c2) = pg8::cvt_pk_bf16(silu_gate(yb[0].x, yb[1].x), silu_gate(yb[0].y, yb[1].y));
    }
}

__device__ __forceinline__ void cg_row(const v4u pg, const v4u cg, const v4u ng, const v4u pv, const v4u cv, const v4u nv, const float (&wg)[3][8], const float (&wv)[3][8], const float (&bg)[8], const float (&bv)[8], bf16* dst) {
    const unsigned pgw[4] = {pg.x, pg.y, pg.z, pg.w}, cgw[4] = {cg.x, cg.y, cg.z, cg.w}, ngw[4] = {ng.x, ng.y, ng.z, ng.w};
    const unsigned pvw[4] = {pv.x, pv.y, pv.z, pv.w}, cvw[4] = {cv.x, cv.y, cv.z, cv.w}, nvw[4] = {nv.x, nv.y, nv.z, nv.w};
    float y[8];
#pragma unroll
    for (int e = 0; e < 8; ++e) { const int w = e >> 1;
        const float gp = (e & 1) ? bfhi(pgw[w]) : bflo(pgw[w]), gc = (e & 1) ? bfhi(cgw[w]) : bflo(cgw[w]), gn = (e & 1) ? bfhi(ngw[w]) : bflo(ngw[w]);
        const float vp = (e & 1) ? bfhi(pvw[w]) : bflo(pvw[w]), vc = (e & 1) ? bfhi(cvw[w]) : bflo(cvw[w]), vn = (e & 1) ? bfhi(nvw[w]) : bflo(nvw[w]);
        const float gt = gp * wg[0][e] + gc * wg[1][e] + gn * wg[2][e] + bg[e];
        const float vl = vp * wv[0][e] + vc * wv[1][e] + vn * wv[2][e] + bv[e];
        y[e] = silu_f(gt) * vl; }
    v4u o; o.x = pk2(y[0], y[1]); o.y = pk2(y[2], y[3]); o.z = pk2(y[4], y[5]); o.w = pk2(y[6], y[7]);
    *(v4u*)dst = o;
}
__device__ __forceinline__ void conv_gate_phase(const Params& P, unsigned char* ldsp, int l) {
    const Frame F = make_frame(ldsp);
    const bf16* U = (const bf16*)(P.ws + WS_R + R_U); bf16* G = (bf16*)(P.ws + WS_R + R_G);
    const float* cw = P.in[I_FCW] + (size_t)l * 3 * NFF; const float* cb = P.in[I_FCB] + (size_t)l * NFF;
    constexpr int RC = 32, NRC = M / RC, NCC = DFF / 512;
    for (int u = F.gw; u < NRC * NCC; u += F.NGW) {
        const int rc = u / NCC, cc = u % NCC, r0 = rc * RC, c0 = cc * 512 + 8 * F.lane;
        float wg[3][8], wv[3][8], bg[8], bv[8];
#pragma unroll
        for (int k = 0; k < 3; ++k) { const f32x4 a = *(const f32x4*)(cw + (size_t)k * NFF + c0), b = *(const f32x4*)(cw + (size_t)k * NFF + c0 + 4), c = *(const f32x4*)(cw + (size_t)k * NFF + DFF + c0), d = *(const f32x4*)(cw + (size_t)k * NFF + DFF + c0 + 4);
            wg[k][0] = a.x; wg[k][1] = a.y; wg[k][2] = a.z; wg[k][3] = a.w; wg[k][4] = b.x; wg[k][5] = b.y; wg[k][6] = b.z; wg[k][7] = b.w;
            wv[k][0] = c.x; wv[k][1] = c.y; wv[k][2] = c.z; wv[k][3] = c.w; wv[k][4] = d.x; wv[k][5] = d.y; wv[k][6] = d.z; wv[k][7] = d.w; }
        { const f32x4 a = *(const f32x4*)(cb + c0), b = *(const f32x4*)(cb + c0 + 4), c = *(const f32x4*)(cb + DFF + c0), d = *(const f32x4*)(cb + DFF + c0 + 4);
            bg[0] = a.x; bg[1] = a.y; bg[2] = a.z; bg[3] = a.w; bg[4] = b.x; bg[5] = b.y; bg[6] = b.z; bg[7] = b.w;
            bv[0] = c.x; bv[1] = c.y; bv[2] = c.z; bv[3] = c.w; bv[4] = d.x; bv[5] = d.y; bv[6] = d.z; bv[7] = d.w; }
        const int spos = r0 < MP ? (r0 & 255) : ((r0 - MP) & 4095), slen = r0 < MP ? 256 : 4096;
        const bool has_prev = spos > 0, has_next = spos + RC < slen;
        const v4u z = {0u, 0u, 0u, 0u};
        const bf16* Ug = U + (size_t)r0 * NFF + c0; const bf16* Uv = Ug + DFF; bf16* Go = G + (size_t)r0 * DFF + c0;
        v4u pg = has_prev ? *(const v4u*)(Ug - NFF) : z, pv = has_prev ? *(const v4u*)(Uv - NFF) : z;
        v4u cg = *(const v4u*)Ug, cv = *(const v4u*)Uv;
        v4u ag[4], av[4], bgq[4], bvq[4];
#define CG_LOAD(XG, XV, r_) do { _Pragma("unroll") for (int q = 0; q < 4; ++q) { const int rr = (r_) + 1 + q; const bool ok = rr < RC || (rr == RC && has_next); \
            XG[q] = ok ? *(const v4u*)(Ug + (size_t)rr * NFF) : z; XV[q] = ok ? *(const v4u*)(Uv + (size_t)rr * NFF) : z; } } while (0)
#define CG_STEP(XG, XV, r_) do { cg_row(pg, cg, XG[0], pv, cv, XV[0], wg, wv, bg, bv, Go + (size_t)(r_) * DFF); cg_row(cg, XG[0], XG[1], cv, XV[0], XV[1], wg, wv, bg, bv, Go + (size_t)((r_) + 1) * DFF); \
            cg_row(XG[0], XG[1], XG[2], XV[0], XV[1], XV[2], wg, wv, bg, bv, Go + (size_t)((r_) + 2) * DFF); cg_row(XG[1], XG[2], XG[3], XV[1], XV[2], XV[3], wg, wv, bg, bv, Go + (size_t)((r_) + 3) * DFF); \
            pg = XG[2]; pv = XV[2]; cg = XG[3]; cv = XV[3]; } while (0)
        CG_LOAD(ag, av, 0);
        for (int r = 0; r < RC; r += 8) {
            CG_LOAD(bgq, bvq, r + 4);
            CG_STEP(ag, av, r);
            if (r + 8 < RC) CG_LOAD(ag, av, r + 8);
            CG_STEP(bgq, bvq, r + 4);
        }
#undef CG_LOAD
#undef CG_STEP
    }
}

#ifndef SEED_MASK
#define SEED_MASK 7
#endif
#ifndef M192
#define M192 true
#endif
namespace att {
constexpr int NW = 8, QBLK = 32, KVBLK = 64;
constexpr float THR = 8.f;
#define SBAR() __builtin_amdgcn_sched_barrier(0)
__device__ __forceinline__ int crow(int r, int hi) { return (r & 3) + 8 * (r >> 2) + 4 * hi; }
__device__ __forceinline__ unsigned cvtpk(float lo, float hi) { unsigned r; asm volatile("v_cvt_pk_bf16_f32 %0, %1, %2" : "=v"(r) : "v"(lo), "v"(hi)); return r; }
__device__ __forceinline__ bf16x8 ld8(const bf16* p) { return *reinterpret_cast<const bf16x8*>(p); }

template <int DQK> __device__ __forceinline__ void partialSM(f32x16& p0, f32x16& p1, float& m_reg, float& mn, float& alpha) {
  constexpr float SCALE = DQK == 64 ? 0.125f : (DQK == 128 ? 0.088388347648318440f : 0.072168783648703220f);
  constexpr float C = SCALE * 1.4426950408889634f;
  float pmax = p0[0];
#pragma unroll
  for (int r = 1; r < 16; ++r) pmax = fmaxf(pmax, p0[r]);
#pragma unroll
  for (int r = 0; r < 16; ++r) pmax = fmaxf(pmax, p1[r]);
  { auto rr = __builtin_amdgcn_permlane32_swap(__float_as_uint(pmax), __float_as_uint(pmax), false, false);
    pmax = fmaxf(__uint_as_float(rr[0]), __uint_as_float(rr[1])); }
  if (__builtin_expect(__all(pmax - m_reg <= THR / SCALE), 1)) { mn = m_reg; alpha = 1.f; }
  else { mn = fmaxf(m_reg, pmax); alpha = __builtin_amdgcn_exp2f((m_reg - mn) * C); m_reg = mn; }
  const float mnC = -mn * C;
#pragma unroll
  for (int r = 0; r < 16; ++r) p0[r] = fmaf(p0[r], C, mnC);
#pragma unroll
  for (int r = 0; r < 16; ++r) p1[r] = fmaf(p1[r], C, mnC);
#pragma unroll
  for (int r = 0; r < 16; ++r) p0[r] = __builtin_amdgcn_exp2f(p0[r]);
}
__device__ __forceinline__ void finishSM(f32x16& p0, f32x16& p1, float alpha, float& l_reg, bf16x8& pa0, bf16x8& pa1, bf16x8& pa2, bf16x8& pa3) {
#pragma unroll
  for (int r = 0; r < 16; ++r) p1[r] = __builtin_amdgcn_exp2f(p1[r]);
  float ps = 0;
#pragma unroll
  for (int r = 0; r < 16; ++r) ps += p0[r];
#pragma unroll
  for (int r = 0; r < 16; ++r) ps += p1[r];
  { auto rr = __builtin_amdgcn_permlane32_swap(__float_as_uint(ps), __float_as_uint(ps), false, false);
    ps = __uint_as_float(rr[0]) + __uint_as_float(rr[1]); }
  l_reg = l_reg * alpha + ps;
#define PK4(P, BASE, OUT) do { unsigned a0 = cvtpk(P[BASE + 0], P[BASE + 1]), a1 = cvtpk(P[BASE + 2], P[BASE + 3]);   \
    unsigned b0 = cvtpk(P[BASE + 4], P[BASE + 5]), b1 = cvtpk(P[BASE + 6], P[BASE + 7]);                              \
    auto r0 = __builtin_amdgcn_permlane32_swap(a0, b0, false, false); auto r1 = __builtin_amdgcn_permlane32_swap(a1, b1, false, false); \
    v4u w = {r0[0], r1[0], r0[1], r1[1]}; OUT = *reinterpret_cast<bf16x8*>(&w); } while (0)
  PK4(p0, 0, pa0); PK4(p0, 8, pa1); PK4(p1, 0, pa2); PK4(p1, 8, pa3);
#undef PK4
}
template <int DQK> __device__ __forceinline__ int kswz(int row, int colB) { return row * (DQK * 2) + (colB ^ ((DQK == 128 ? (row & 15) : ((row >> 1) & 7)) << 4)); }
template <int DQK, bool QLDS> __device__ __forceinline__ void qkt(f32x16& p0, f32x16& p1, const char* Ks, const bf16x8* qr, const char* qpe, int r32, int hi) {
  p0 = f32x16{}; p1 = f32x16{};
#pragma unroll
  for (int d0 = 0; d0 < DQK / 16; ++d0) { const int cb = (d0 * 16 + hi * 8) * 2;
    const bf16x8 b0 = *reinterpret_cast<const bf16x8*>(Ks + kswz<DQK>(r32, cb));
    const bf16x8 b1 = *reinterpret_cast<const bf16x8*>(Ks + kswz<DQK>(32 + r32, cb));
    bf16x8 q;
    if constexpr (QLDS) { if (d0 >= 8) q = *reinterpret_cast<const bf16x8*>(qpe + kswz<64>(r32, cb - 256)); else q = qr[d0]; } else q = qr[d0];
    p0 = __builtin_amdgcn_mfma_f32_32x32x16_bf16(b0, q, p0, 0, 0, 0);
    p1 = __builtin_amdgcn_mfma_f32_32x32x16_bf16(b1, q, p1, 0, 0, 0); }
}
__device__ __forceinline__ int v_st(int k, int c) { const int kk = (k & ~0xC) | ((k & 4) << 1) | ((k & 8) >> 1); return ((kk >> 3) * 4 + (c >> 5)) * 512 + ((kk & 7) * 32 + (c & 31)) * 2; }
__device__ __forceinline__ int v_stn(int k, int c) { return ((k >> 3) * 4 + (c >> 5)) * 512 + ((k & 7) * 32 + (c & 31)) * 2; }
__device__ __forceinline__ int v_rd_base(int lane) { return ((lane & 3) << 3) | (((lane >> 2) & 3) << 6) | (((lane >> 4) & 1) << 5) | (((lane >> 5) & 1) << 8); }
constexpr int v_rd_off(int d0, int ks, int half) { return d0 * 512 + ks * 4096 + half * 2048; }
template <int OFF> __device__ __forceinline__ s16x4 tr_read(int vb) {
  s16x4 r; asm volatile("ds_read_b64_tr_b16 %0, %1 offset:%2" : "=&v"(r) : "v"(vb), "i"(OFF) : "memory"); return r;
}
template <int D0> __device__ __forceinline__ void pv_one(f32x16& od, int vb, bf16x8 pa0, bf16x8 pa1, bf16x8 pa2, bf16x8 pa3) {
  const s16x4 l0 = tr_read<v_rd_off(D0, 0, 0)>(vb), h0 = tr_read<v_rd_off(D0, 0, 1)>(vb), l1 = tr_read<v_rd_off(D0, 1, 0)>(vb), h1 = tr_read<v_rd_off(D0, 1, 1)>(vb);
  const s16x4 l2 = tr_read<v_rd_off(D0, 2, 0)>(vb), h2 = tr_read<v_rd_off(D0, 2, 1)>(vb), l3 = tr_read<v_rd_off(D0, 3, 0)>(vb), h3 = tr_read<v_rd_off(D0, 3, 1)>(vb);
  asm volatile("s_waitcnt lgkmcnt(0)" ::: "memory"); SBAR();
#define PK(L, H) (bf16x8){L[0], L[1], L[2], L[3], H[0], H[1], H[2], H[3]}
  od = __builtin_amdgcn_mfma_f32_32x32x16_bf16(pa0, PK(l0, h0), od, 0, 0, 0);
  od = __builtin_amdgcn_mfma_f32_32x32x16_bf16(pa1, PK(l1, h1), od, 0, 0, 0);
  od = __builtin_amdgcn_mfma_f32_32x32x16_bf16(pa2, PK(l2, h2), od, 0, 0, 0);
  od = __builtin_amdgcn_mfma_f32_32x32x16_bf16(pa3, PK(l3, h3), od, 0, 0, 0);
#undef PK
}
__device__ __forceinline__ void pv_d0(f32x16* o, int vb, bf16x8 pa0, bf16x8 pa1, bf16x8 pa2, bf16x8 pa3) {
  pv_one<0>(o[0], vb, pa0, pa1, pa2, pa3); pv_one<1>(o[1], vb, pa0, pa1, pa2, pa3); pv_one<2>(o[2], vb, pa0, pa1, pa2, pa3); pv_one<3>(o[3], vb, pa0, pa1, pa2, pa3);
}

template <int DQK, int SDEPTH, bool QLDS>
__device__ __forceinline__ void attn_unit(const bf16* __restrict__ Qb, int ldq, const bf16* __restrict__ Kh, int ldk, const bf16* __restrict__ Kp, int ldkp,
                                          const bf16* __restrict__ Vh, int ldv, bf16* __restrict__ Ob, int ldo, int seq, char* lds) {
  constexpr int SHM_V = KVBLK * 128 * 2, SHM_K = KVBLK * DQK * 2;
  int tid_ = threadIdx.x; asm volatile("" : "+v"(tid_));
  const int tid = tid_, wid = tid >> 6, lane = tid & 63, r32 = lane & 31, hi = lane >> 5;
  char* V_lds = lds; char* K_lds = lds + 2 * SHM_V;
  float* wsf = (float*)(lds + 2 * SHM_V + 2 * SHM_K) + wid * 64; float* li_l = wsf; float* al_l = wsf + 32;
  constexpr int NQR = QLDS ? 8 : DQK / 16;
  float m_reg = -1e30f, l_reg = 0; f32x16 o[4] = {}; bf16x8 qr[NQR];
  const bf16* Qw = Qb + (long)(wid * QBLK + r32) * ldq + hi * 8;
#pragma unroll
  for (int d0 = 0; d0 < NQR; ++d0) qr[d0] = ld8(Qw + d0 * 16);
  char* qpe_l = lds + 2 * SHM_V + 2 * SHM_K + 2048 + wid * 4096;
  if constexpr (QLDS) {
#pragma unroll
    for (int d0 = 8; d0 < DQK / 16; ++d0) *(bf16x8*)(qpe_l + kswz<64>(r32, (d0 * 16 + hi * 8) * 2 - 256)) = ld8(Qw + d0 * 16);
    asm volatile("s_waitcnt lgkmcnt(0)" ::: "memory");
  }
  const int sr = tid >> 4, sc = (tid & 15) * 8, vst0 = v_st(sr, sc), vst1 = v_st(32 + sr, sc);
  const int sr8 = tid >> 3, sc8 = (tid & 7) * 8;
  const int vb0 = (int)(uintptr_t)V_lds + v_rd_base(lane);
  struct Slot { bf16x8 vs0, vs1, ks0, ks1, kp; } sr_[SDEPTH];
  constexpr int SE = 0, SO = SDEPTH - 1;
#define SLOAD(i, k0) do { sr_[i].vs0 = ld8(&Vh[(long)((k0) + sr) * ldv + sc]); sr_[i].vs1 = ld8(&Vh[(long)((k0) + 32 + sr) * ldv + sc]); \
    if constexpr (DQK == 64) { sr_[i].ks0 = ld8(&Kh[(long)((k0) + sr8) * ldk + sc8]); } \
    else { sr_[i].ks0 = ld8(&Kh[(long)((k0) + sr) * ldk + sc]); sr_[i].ks1 = ld8(&Kh[(long)((k0) + 32 + sr) * ldk + sc]); } \
    if constexpr (DQK == 192) { sr_[i].kp = ld8(&Kp[(long)((k0) + sr8) * ldkp + sc8]); } } while (0)
#define SWRITE(b, i) do { *(bf16x8*)(V_lds + (b) * SHM_V + vst0) = sr_[i].vs0; *(bf16x8*)(V_lds + (b) * SHM_V + vst1) = sr_[i].vs1; \
    if constexpr (DQK == 64) { *(bf16x8*)(K_lds + (b) * SHM_K + kswz<DQK>(sr8, sc8 * 2)) = sr_[i].ks0; } \
    else { *(bf16x8*)(K_lds + (b) * SHM_K + kswz<DQK>(sr, sc * 2)) = sr_[i].ks0; *(bf16x8*)(K_lds + (b) * SHM_K + kswz<DQK>(32 + sr, sc * 2)) = sr_[i].ks1; } \
    if constexpr (DQK == 192) { *(bf16x8*)(K_lds + (b) * SHM_K + kswz<DQK>(sr8, 256 + sc8 * 2)) = sr_[i].kp; } } while (0)
  constexpr int LPT = DQK == 64 ? 3 : (DQK == 128 ? 4 : 5);
#define SWAIT() do { if constexpr (SDEPTH == 1) asm volatile("s_waitcnt vmcnt(0)" ::: "memory"); else if constexpr (LPT == 3) asm volatile("s_waitcnt vmcnt(3)" ::: "memory"); else if constexpr (LPT == 4) asm volatile("s_waitcnt vmcnt(4)" ::: "memory"); else asm volatile("s_waitcnt vmcnt(5)" ::: "memory"); } while (0)
#define RESC(a) do { if (__any((a) < 1.f)) { if (hi == 0) al_l[r32] = (a); asm volatile("s_waitcnt lgkmcnt(0)" ::: "memory"); \
    _Pragma("unroll") for (int d = 0; d < 4; ++d) _Pragma("unroll") for (int r = 0; r < 16; ++r) o[d][r] *= al_l[crow(r, hi)]; } } while (0)
  f32x16 pA0, pA1, pB0, pB1; float mnA, mnB, alA, alB; bf16x8 pa0, pa1, pa2, pa3; const int NT = seq / KVBLK;
  SLOAD(SE, 0); asm volatile("s_waitcnt vmcnt(0)" ::: "memory"); SWRITE(0, SE); __syncthreads();
  qkt<DQK, QLDS>(pA0, pA1, K_lds, qr, qpe_l, r32, hi); partialSM<DQK>(pA0, pA1, m_reg, mnA, alA);
  SLOAD(SO, KVBLK); if constexpr (SDEPTH == 2) { if (2 < NT) SLOAD(SE, 2 * KVBLK); }
  SWAIT(); SWRITE(1, SO); __syncthreads();
  for (int j = 1; j + 1 < NT; j += 2) {
    SBAR(); qkt<DQK, QLDS>(pB0, pB1, K_lds + SHM_K, qr, qpe_l, r32, hi);
    finishSM(pA0, pA1, alA, l_reg, pa0, pa1, pa2, pa3); SBAR();
    SLOAD(SO, (j + SDEPTH) * KVBLK); SBAR();
    pv_d0(o, vb0, pa0, pa1, pa2, pa3); partialSM<DQK>(pB0, pB1, m_reg, mnB, alB);
    __syncthreads(); SWAIT(); SWRITE(0, SE);
    RESC(alB); __syncthreads();
    SBAR(); qkt<DQK, QLDS>(pA0, pA1, K_lds, qr, qpe_l, r32, hi);
    finishSM(pB0, pB1, alB, l_reg, pa0, pa1, pa2, pa3); SBAR();
    if (SDEPTH == 1 || j + 3 < NT) SLOAD(SE, (j + 1 + SDEPTH) * KVBLK); SBAR();
    pv_d0(o, vb0 + SHM_V, pa0, pa1, pa2, pa3); partialSM<DQK>(pA0, pA1, m_reg, mnA, alA);
    __syncthreads(); SWAIT(); SWRITE(1, SO);
    RESC(alA); __syncthreads();
  }
  SBAR(); qkt<DQK, QLDS>(pB0, pB1, K_lds + SHM_K, qr, qpe_l, r32, hi);
  finishSM(pA0, pA1, alA, l_reg, pa0, pa1, pa2, pa3); SBAR();
  pv_d0(o, vb0, pa0, pa1, pa2, pa3); partialSM<DQK>(pB0, pB1, m_reg, mnB, alB);
  __syncthreads(); RESC(alB);
  finishSM(pB0, pB1, alB, l_reg, pa0, pa1, pa2, pa3); SBAR();
  pv_d0(o, vb0 + SHM_V, pa0, pa1, pa2, pa3);
  if (hi == 0) li_l[r32] = l_reg; asm volatile("s_waitcnt lgkmcnt(0)" ::: "memory");
  float rli[16];
#pragma unroll
  for (int r = 0; r < 16; ++r) rli[r] = __builtin_amdgcn_rcpf(li_l[crow(r, hi)]);
  bf16* Ow = Ob + (long)(wid * QBLK) * ldo;
#pragma unroll
  for (int r = 0; r < 16; ++r) { const int orow = crow(r, hi);
#pragma unroll
    for (int d0 = 0; d0 < 4; ++d0) Ow[(long)orow * ldo + d0 * 32 + r32] = (bf16)f2bf(o[d0][r] * rli[r]); }
#undef SLOAD
#undef SWRITE
#undef SWAIT
#undef RESC
}

template <int DQK, bool QLDS>
__device__ __forceinline__ void attn_unit_s(const bf16* __restrict__ Qb, int ldq, const bf16* __restrict__ Kh, int ldk, const bf16* __restrict__ Kp, int ldkp,
                                            const bf16* __restrict__ Vh, int ldv, bf16* __restrict__ Ob, int ldo, int seq, char* lds) {
  constexpr int SHM_V = KVBLK * 128 * 2, SHM_K = KVBLK * DQK * 2;
  int tid_ = threadIdx.x; asm volatile("" : "+v"(tid_));
  const int tid = tid_, wid = tid >> 6, lane = tid & 63, r32 = lane & 31, hi = lane >> 5;
  char* V_lds = lds; char* K_lds = lds + 2 * SHM_V;
  float* wsf = (float*)(lds + 2 * SHM_V + 2 * SHM_K) + wid * 64; float* li_l = wsf; float* al_l = wsf + 32;
  constexpr int NQR = QLDS ? 8 : DQK / 16;
  float m_reg = -1e30f, l_reg = 0; f32x16 o[4] = {}; bf16x8 qr[NQR];
  const bf16* Qw = Qb + (long)(wid * QBLK + r32) * ldq + hi * 8;
#pragma unroll
  for (int d0 = 0; d0 < NQR; ++d0) qr[d0] = ld8(Qw + d0 * 16);
  char* qpe_l = lds + 2 * SHM_V + 2 * SHM_K + 2048 + wid * 4096;
  if constexpr (QLDS) {
#pragma unroll
    for (int d0 = 8; d0 < DQK / 16; ++d0) *(bf16x8*)(qpe_l + kswz<64>(r32, (d0 * 16 + hi * 8) * 2 - 256)) = ld8(Qw + d0 * 16);
    asm volatile("s_waitcnt lgkmcnt(0)" ::: "memory");
  }
  const int sr = tid >> 4, sc = (tid & 15) * 8, vst0 = v_st(sr, sc), vst1 = v_st(32 + sr, sc);
  const int sr8 = tid >> 3, sc8 = (tid & 7) * 8;
  const int vb0 = (int)(uintptr_t)V_lds + v_rd_base(lane);
  bf16x8 vs0, vs1, ks0, ks1, kp;
#define SLOAD1(k0) do { vs0 = ld8(&Vh[(long)((k0) + sr) * ldv + sc]); vs1 = ld8(&Vh[(long)((k0) + 32 + sr) * ldv + sc]); \
    if constexpr (DQK == 64) { ks0 = ld8(&Kh[(long)((k0) + sr8) * ldk + sc8]); } \
    else { ks0 = ld8(&Kh[(long)((k0) + sr) * ldk + sc]); ks1 = ld8(&Kh[(long)((k0) + 32 + sr) * ldk + sc]); } \
    if constexpr (DQK == 192) { kp = ld8(&Kp[(long)((k0) + sr8) * ldkp + sc8]); } } while (0)
#define SWRITE1(b) do { *(bf16x8*)(V_lds + (b) * SHM_V + vst0) = vs0; *(bf16x8*)(V_lds + (b) * SHM_V + vst1) = vs1; \
    if constexpr (DQK == 64) { *(bf16x8*)(K_lds + (b) * SHM_K + kswz<DQK>(sr8, sc8 * 2)) = ks0; } \
    else { *(bf16x8*)(K_lds + (b) * SHM_K + kswz<DQK>(sr, sc * 2)) = ks0; *(bf16x8*)(K_lds + (b) * SHM_K + kswz<DQK>(32 + sr, sc * 2)) = ks1; } \
    if constexpr (DQK == 192) { *(bf16x8*)(K_lds + (b) * SHM_K + kswz<DQK>(sr8, 256 + sc8 * 2)) = kp; } } while (0)
#define RESC1(a) do { if (__any((a) < 1.f)) { if (hi == 0) al_l[r32] = (a); asm volatile("s_waitcnt lgkmcnt(0)" ::: "memory"); \
    _Pragma("unroll") for (int d = 0; d < 4; ++d) _Pragma("unroll") for (int r = 0; r < 16; ++r) o[d][r] *= al_l[crow(r, hi)]; } } while (0)
  f32x16 p0, p1; float mn, al; bf16x8 pa0, pa1, pa2, pa3; const int NT = seq / KVBLK;
  SLOAD1(0); asm volatile("s_waitcnt vmcnt(0)" ::: "memory"); SWRITE1(0); SLOAD1(KVBLK); __syncthreads();
  for (int j = 0; j < NT; j += 2) {
    SWRITE1(1);
    if (j + 2 < NT) SLOAD1((j + 2) * KVBLK);
    SBAR(); qkt<DQK, QLDS>(p0, p1, K_lds, qr, qpe_l, r32, hi); partialSM<DQK>(p0, p1, m_reg, mn, al);
    RESC1(al); finishSM(p0, p1, al, l_reg, pa0, pa1, pa2, pa3); SBAR();
    pv_d0(o, vb0, pa0, pa1, pa2, pa3);
    __syncthreads();
    if (j + 2 < NT) SWRITE1(0);
    if (j + 3 < NT) SLOAD1((j + 3) * KVBLK);
    SBAR(); qkt<DQK, QLDS>(p0, p1, K_lds + SHM_K, qr, qpe_l, r32, hi); partialSM<DQK>(p0, p1, m_reg, mn, al);
    RESC1(al); finishSM(p0, p1, al, l_reg, pa0, pa1, pa2, pa3); SBAR();
    pv_d0(o, vb0 + SHM_V, pa0, pa1, pa2, pa3);
    __syncthreads();
  }
  if (hi == 0) li_l[r32] = l_reg; asm volatile("s_waitcnt lgkmcnt(0)" ::: "memory");
  float rli[16];
#pragma unroll
  for (int r = 0; r < 16; ++r) rli[r] = __builtin_amdgcn_rcpf(li_l[crow(r, hi)]);
  bf16* Ow = Ob + (long)(wid * QBLK) * ldo;
#pragma unroll
  for (int r = 0; r < 16; ++r) { const int orow = crow(r, hi);
#pragma unroll
    for (int d0 = 0; d0 < 4; ++d0) Ow[(long)orow * ldo + d0 * 32 + r32] = (bf16)f2bf(o[d0][r] * rli[r]); }
#undef SLOAD1
#undef SWRITE1
#undef RESC1
}

template <int DQK> __device__ __forceinline__ void softmax_tile(f32x16& p0, f32x16& p1, float& m_reg, float& l_reg, float& alpha, bf16x8& pa0, bf16x8& pa1, bf16x8& pa2, bf16x8& pa3) {
  float mn; partialSM<DQK>(p0, p1, m_reg, mn, alpha); finishSM(p0, p1, alpha, l_reg, pa0, pa1, pa2, pa3);
}
#define PK4S(P, BASE, OUT) do { v4u w = {cvtpk(P[BASE + 0], P[BASE + 1]), cvtpk(P[BASE + 2], P[BASE + 3]), cvtpk(P[BASE + 4], P[BASE + 5]), cvtpk(P[BASE + 6], P[BASE + 7])}; \
    OUT = *reinterpret_cast<bf16x8*>(&w); } while (0)
__device__ __forceinline__ float xhalf_max(float v) {
  auto rr = __builtin_amdgcn_permlane32_swap(__float_as_uint(v), __float_as_uint(v), false, false);
  float mx_; asm("v_max_f32 %0, %1, %2" : "=v"(mx_) : "v"(rr[0]), "v"(rr[1]));
  return mx_;
}
__device__ __forceinline__ float ownmax32(const f32x16& p0, const f32x16& p1) {
  float pmax = p0[0];
#pragma unroll
  for (int r = 1; r < 16; ++r) pmax = fmaxf(pmax, p0[r]);
#pragma unroll
  for (int r = 0; r < 16; ++r) pmax = fmaxf(pmax, p1[r]);
  return pmax;
}
__device__ __forceinline__ float rowmax32(const f32x16& p0, const f32x16& p1) {
  float pmax = p0[0];
#pragma unroll
  for (int r = 1; r < 16; ++r) pmax = fmaxf(pmax, p0[r]);
#pragma unroll
  for (int r = 0; r < 16; ++r) pmax = fmaxf(pmax, p1[r]);
  return xhalf_max(pmax);
}
__device__ __forceinline__ float expsum32(f32x16& p0, f32x16& p1) {
#pragma unroll
  for (int r = 0; r < 16; ++r) p0[r] = __builtin_amdgcn_exp2f(p0[r]);
#pragma unroll
  for (int r = 0; r < 16; ++r) p1[r] = __builtin_amdgcn_exp2f(p1[r]);
  float ps = p0[0];
#pragma unroll
  for (int r = 1; r < 16; ++r) ps += p0[r];
#pragma unroll
  for (int r = 0; r < 16; ++r) ps += p1[r];
  return ps;
}
__device__ __forceinline__ void softmax_first(f32x16& p0, f32x16& p1, float& m_reg, float& l_reg, float& alpha, f32x16& minit, bf16x8& pa0, bf16x8& pa1, bf16x8& pa2, bf16x8& pa3) {
  const float pmax = rowmax32(p0, p1);
  m_reg = pmax; alpha = 1.f;
#pragma unroll
  for (int r = 0; r < 16; ++r) { minit[r] = -pmax; p0[r] -= pmax; p1[r] -= pmax; }
  l_reg = expsum32(p0, p1);
  PK4S(p0, 0, pa0); PK4S(p0, 8, pa1); PK4S(p1, 0, pa2); PK4S(p1, 8, pa3);
}
__device__ __forceinline__ bool softmax_seeded(f32x16& p0, f32x16& p1, float& m_reg, float& l_reg, float& alpha, f32x16& minit, bf16x8& pa0, bf16x8& pa1, bf16x8& pa2, bf16x8& pa3) {
  const float pown = ownmax32(p0, p1); bool moved = false;
  if (__builtin_expect(__all(pown <= THR * 1.4426950408889634f), 1)) { alpha = 1.f; }
  else { moved = true; const float pmax = xhalf_max(pown); const float d = fmaxf(pmax, 0.f); alpha = __builtin_amdgcn_exp2f(-d); m_reg += d;
#pragma unroll
    for (int r = 0; r < 16; ++r) { p0[r] -= d; p1[r] -= d; minit[r] = -m_reg; } }
  const float ps = expsum32(p0, p1);
  l_reg = l_reg * alpha + ps;
  PK4S(p0, 0, pa0); PK4S(p0, 8, pa1); PK4S(p1, 0, pa2); PK4S(p1, 8, pa3);
  return moved;
}
#undef PK4S
__device__ __forceinline__ bf16x8 scale_bf16x8(bf16x8 v, float c) {
  v4u u = *reinterpret_cast<v4u*>(&v), w;
#pragma unroll
  for (int i = 0; i < 4; ++i) { const float lo = __uint_as_float(u[i] << 16) * c, hi = __uint_as_float(u[i] & 0xffff0000u) * c; w[i] = cvtpk(lo, hi); }
  return *reinterpret_cast<bf16x8*>(&w);
}
typedef short v4i16_t __attribute__((ext_vector_type(4)));
__device__ __forceinline__ s16x4 vtr(int addr) { return __builtin_bit_cast(s16x4, __builtin_amdgcn_ds_read_tr16_b64_v4i16((__attribute__((address_space(3))) v4i16_t*)(uintptr_t)(unsigned)addr)); }
template <int DQK, bool HAVE_QK, bool SEED>
__device__ __forceinline__ void mseg(f32x16* o, f32x16& p0, f32x16& p1, const f32x16& minit, const char* Ks, int vb, const bf16x8* qr, bf16x8 pa0, bf16x8 pa1, bf16x8 pa2, bf16x8 pa3, int r32, int hi) {
  constexpr int CH = DQK == 192 ? 2 : DQK / 64;
  s16x4 va[8], vbq[8]; bf16x8 ka[2 * CH], kb[2 * CH];
#define VRD(dst, D0) do { _Pragma("unroll") for (int ks = 0; ks < 4; ++ks) { dst[2 * ks] = vtr(vb + v_rd_off(D0, ks, 0)); dst[2 * ks + 1] = vtr(vb + v_rd_off(D0, ks, 1)); } } while (0)
#define KRD(dst, C) do { _Pragma("unroll") for (int i = 0; i < CH; ++i) { const int cb = (((C) * CH + i) * 16 + hi * 8) * 2; \
    dst[2 * i] = *reinterpret_cast<const bf16x8*>(Ks + kswz<DQK>(r32, cb)); dst[2 * i + 1] = *reinterpret_cast<const bf16x8*>(Ks + kswz<DQK>(32 + r32, cb)); } } while (0)
#define PKV(L, H) (bf16x8){L[0], L[1], L[2], L[3], H[0], H[1], H[2], H[3]}
#define PVM(src, D0) do { o[D0] = __builtin_amdgcn_mfma_f32_32x32x16_bf16(pa0, PKV(src[0], src[1]), o[D0], 0, 0, 0); o[D0] = __builtin_amdgcn_mfma_f32_32x32x16_bf16(pa1, PKV(src[2], src[3]), o[D0], 0, 0, 0); \
    o[D0] = __builtin_amdgcn_mfma_f32_32x32x16_bf16(pa2, PKV(src[4], src[5]), o[D0], 0, 0, 0); o[D0] = __builtin_amdgcn_mfma_f32_32x32x16_bf16(pa3, PKV(src[6], src[7]), o[D0], 0, 0, 0); } while (0)
#define QKM(src, C) do { _Pragma("unroll") for (int i = 0; i < CH; ++i) { p0 = __builtin_amdgcn_mfma_f32_32x32x16_bf16(src[2 * i], qr[(C) * CH + i], p0, 0, 0, 0); \
    p1 = __builtin_amdgcn_mfma_f32_32x32x16_bf16(src[2 * i + 1], qr[(C) * CH + i], p1, 0, 0, 0); } } while (0)
  if constexpr (HAVE_QK) { if constexpr (SEED) { p0 = minit; p1 = minit; } else { p0 = f32x16{}; p1 = f32x16{}; } }
#define IL_PV() do { _Pragma("unroll") for (int g_ = 0; g_ < 4; ++g_) { __builtin_amdgcn_sched_group_barrier(0x008, 1, 0); __builtin_amdgcn_sched_group_barrier(0x100, 2, 0); } } while (0)
#define IL_QK() do { _Pragma("unroll") for (int g_ = 0; g_ < 2 * CH; ++g_) { __builtin_amdgcn_sched_group_barrier(0x008, 1, 0); __builtin_amdgcn_sched_group_barrier(0x100, 1, 0); } } while (0)
  __builtin_amdgcn_s_setprio(1);
  if constexpr (DQK != 192) {
    VRD(va, 0); if constexpr (HAVE_QK) KRD(ka, 0); SBAR();
    VRD(vbq, 1); PVM(va, 0); IL_PV(); SBAR();
    if constexpr (HAVE_QK) { KRD(kb, 1); QKM(ka, 0); IL_QK(); SBAR(); }
    VRD(va, 2); PVM(vbq, 1); IL_PV(); SBAR();
    if constexpr (HAVE_QK) { KRD(ka, 2); QKM(kb, 1); IL_QK(); SBAR(); }
    VRD(vbq, 3); PVM(va, 2); IL_PV(); SBAR();
    if constexpr (HAVE_QK) { KRD(kb, 3); QKM(ka, 2); IL_QK(); SBAR(); }
    PVM(vbq, 3); SBAR();
    if constexpr (HAVE_QK) { QKM(kb, 3); SBAR(); }
  } else {
    VRD(va, 0); if constexpr (HAVE_QK) KRD(ka, 0); SBAR();
    VRD(vbq, 1); PVM(va, 0); IL_PV(); SBAR();
    if constexpr (HAVE_QK) { KRD(kb, 1); QKM(ka, 0); IL_QK(); SBAR(); }
    VRD(va, 2); PVM(vbq, 1); IL_PV(); SBAR();
    if constexpr (HAVE_QK) { KRD(ka, 2); QKM(kb, 1); IL_QK(); SBAR(); KRD(kb, 3); QKM(ka, 2); IL_QK(); SBAR(); }
    VRD(vbq, 3); PVM(va, 2); IL_PV(); SBAR();
    if constexpr (HAVE_QK) { KRD(ka, 4); QKM(kb, 3); IL_QK(); SBAR(); KRD(kb, 5); QKM(ka, 4); IL_QK(); SBAR(); }
    PVM(vbq, 3); SBAR();
    if constexpr (HAVE_QK) { QKM(kb, 5); SBAR(); }
  }
  __builtin_amdgcn_s_setprio(0);
#undef IL_PV
#undef IL_QK
#undef VRD
#undef KRD
#undef PKV
#undef PVM
#undef QKM
}
template <bool HAVE_QK, bool SEED>
__device__ __forceinline__ void mseg192(f32x16* o, f32x16& p0, f32x16& p1, const f32x16& minit, const char* Ks, int vb, const bf16x8* qr, bf16x8 pa0, bf16x8 pa1, bf16x8 pa2, bf16x8 pa3, int r32, int hi) {
  bf16x8 b0x, b0y, b1x, b1y, b2x, b2y;
#define PKV(L, H) (bf16x8){L[0], L[1], L[2], L[3], H[0], H[1], H[2], H[3]}
#define MF32(a, b, c) __builtin_amdgcn_mfma_f32_32x32x16_bf16(a, b, c, 0, 0, 0)
#define SGB(m, n) __builtin_amdgcn_sched_group_barrier(m, n, 0)
  if constexpr (HAVE_QK) { if constexpr (SEED) { p0 = minit; p1 = minit; } else { p0 = f32x16{}; p1 = f32x16{}; } }
  __builtin_amdgcn_s_setprio(1);
  if constexpr (HAVE_QK) {
    b0x = PKV(vtr(vb + v_rd_off(0, 0, 0)), vtr(vb + v_rd_off(0, 0, 1))); b0y = PKV(vtr(vb + v_rd_off(0, 1, 0)), vtr(vb + v_rd_off(0, 1, 1)));
    { const int cb = (0 * 16 + hi * 8) * 2; b1x = *reinterpret_cast<const bf16x8*>(Ks + kswz<192>(r32, cb)); b1y = *reinterpret_cast<const bf16x8*>(Ks + kswz<192>(32 + r32, cb)); }
    SBAR();
    b2x = PKV(vtr(vb + v_rd_off(0, 2, 0)), vtr(vb + v_rd_off(0, 2, 1))); b2y = PKV(vtr(vb + v_rd_off(0, 3, 0)), vtr(vb + v_rd_off(0, 3, 1))); o[0] = MF32(pa0, b0x, o[0]); o[0] = MF32(pa1, b0y, o[0]); SGB(0x008, 1); SGB(0x100, 2); SGB(0x008, 1); SGB(0x100, 2); SBAR();
    { const int cb = (1 * 16 + hi * 8) * 2; b0x = *reinterpret_cast<const bf16x8*>(Ks + kswz<192>(r32, cb)); b0y = *reinterpret_cast<const bf16x8*>(Ks + kswz<192>(32 + r32, cb)); } p0 = MF32(b1x, qr[0], p0); p1 = MF32(b1y, qr[0], p1); SGB(0x008, 1); SGB(0x100, 1); SGB(0x008, 1); SGB(0x100, 1); SBAR();
    { const int cb = (2 * 16 + hi * 8) * 2; b1x = *reinterpret_cast<const bf16x8*>(Ks + kswz<192>(r32, cb)); b1y = *reinterpret_cast<const bf16x8*>(Ks + kswz<192>(32 + r32, cb)); } o[0] = MF32(pa2, b2x, o[0]); o[0] = MF32(pa3, b2y, o[0]); SGB(0x008, 1); SGB(0x100, 1); SGB(0x008, 1); SGB(0x100, 1); SBAR();
    b2x = PKV(vtr(vb + v_rd_off(1, 0, 0)), vtr(vb + v_rd_off(1, 0, 1))); b2y = PKV(vtr(vb + v_rd_off(1, 1, 0)), vtr(vb + v_rd_off(1, 1, 1))); p0 = MF32(b0x, qr[1], p0); p1 = MF32(b0y, qr[1], p1); SGB(0x008, 1); SGB(0x100, 2); SGB(0x008, 1); SGB(0x100, 2); SBAR();
    { const int cb = (3 * 16 + hi * 8) * 2; b0x = *reinterpret_cast<const bf16x8*>(Ks + kswz<192>(r32, cb)); b0y = *reinterpret_cast<const bf16x8*>(Ks + kswz<192>(32 + r32, cb)); } p0 = MF32(b1x, qr[2], p0); p1 = MF32(b1y, qr[2], p1); SGB(0x008, 1); SGB(0x100, 1); SGB(0x008, 1); SGB(0x100, 1); SBAR();
    b1x = PKV(vtr(vb + v_rd_off(1, 2, 0)), vtr(vb + v_rd_off(1, 2, 1))); b1y = PKV(vtr(vb + v_rd_off(1, 3, 0)), vtr(vb + v_rd_off(1, 3, 1))); o[1] = MF32(pa0, b2x, o[1]); o[1] = MF32(pa1, b2y, o[1]); SGB(0x008, 1); SGB(0x100, 2); SGB(0x008, 1); SGB(0x100, 2); SBAR();
    { const int cb = (4 * 16 + hi * 8) * 2; b2x = *reinterpret_cast<const bf16x8*>(Ks + kswz<192>(r32, cb)); b2y = *reinterpret_cast<const bf16x8*>(Ks + kswz<192>(32 + r32, cb)); } p0 = MF32(b0x, qr[3], p0); p1 = MF32(b0y, qr[3], p1); SGB(0x008, 1); SGB(0x100, 1); SGB(0x008, 1); SGB(0x100, 1); SBAR();
    { const int cb = (5 * 16 + hi * 8) * 2; b0x = *reinterpret_cast<const bf16x8*>(Ks + kswz<192>(r32, cb)); b0y = *reinterpret_cast<const bf16x8*>(Ks + kswz<192>(32 + r32, cb)); } o[1] = MF32(pa2, b1x, o[1]); o[1] = MF32(pa3, b1y, o[1]); SGB(0x008, 1); SGB(0x100, 1); SGB(0x008, 1); SGB(0x100, 1); SBAR();
    b1x = PKV(vtr(vb + v_rd_off(2, 0, 0)), vtr(vb + v_rd_off(2, 0, 1))); b1y = PKV(vtr(vb + v_rd_off(2, 1, 0)), vtr(vb + v_rd_off(2, 1, 1))); p0 = MF32(b2x, qr[4], p0); p1 = MF32(b2y, qr[4], p1); SGB(0x008, 1); SGB(0x100, 2); SGB(0x008, 1); SGB(0x100, 2); SBAR();
    { const int cb = (6 * 16 + hi * 8) * 2; b2x = *reinterpret_cast<const bf16x8*>(Ks + kswz<192>(r32, cb)); b2y = *reinterpret_cast<const bf16x8*>(Ks + kswz<192>(32 + r32, cb)); } p0 = MF32(b0x, qr[5], p0); p1 = MF32(b0y, qr[5], p1); SGB(0x008, 1); SGB(0x100, 1); SGB(0x008, 1); SGB(0x100, 1); SBAR();
    b0x = PKV(vtr(vb + v_rd_off(2, 2, 0)), vtr(vb + v_rd_off(2, 2, 1))); b0y = PKV(vtr(vb + v_rd_off(2, 3, 0)), vtr(vb + v_rd_off(2, 3, 1))); o[2] = MF32(pa0, b1x, o[2]); o[2] = MF32(pa1, b1y, o[2]); SGB(0x008, 1); SGB(0x100, 2); SGB(0x008, 1); SGB(0x100, 2); SBAR();
    { const int cb = (7 * 16 + hi * 8) * 2; b1x = *reinterpret_cast<const bf16x8*>(Ks + kswz<192>(r32, cb)); b1y = *reinterpret_cast<const bf16x8*>(Ks + kswz<192>(32 + r32, cb)); } p0 = MF32(b2x, qr[6], p0); p1 = MF32(b2y, qr[6], p1); SGB(0x008, 1); SGB(0x100, 1); SGB(0x008, 1); SGB(0x100, 1); SBAR();
    { const int cb = (8 * 16 + hi * 8) * 2; b2x = *reinterpret_cast<const bf16x8*>(Ks + kswz<192>(r32, cb)); b2y = *reinterpret_cast<const bf16x8*>(Ks + kswz<192>(32 + r32, cb)); } o[2] = MF32(pa2, b0x, o[2]); o[2] = MF32(pa3, b0y, o[2]); SGB(0x008, 1); SGB(0x100, 1); SGB(0x008, 1); SGB(0x100, 1); SBAR();
    b0x = PKV(vtr(vb + v_rd_off(3, 0, 0)), vtr(vb + v_rd_off(3, 0, 1))); b0y = PKV(vtr(vb + v_rd_off(3, 1, 0)), vtr(vb + v_rd_off(3, 1, 1))); p0 = MF32(b1x, qr[7], p0); p1 = MF32(b1y, qr[7], p1); SGB(0x008, 1); SGB(0x100, 2); SGB(0x008, 1); SGB(0x100, 2); SBAR();
    { const int cb = (9 * 16 + hi * 8) * 2; b1x = *reinterpret_cast<const bf16x8*>(Ks + kswz<192>(r32, cb)); b1y = *reinterpret_cast<const bf16x8*>(Ks + kswz<192>(32 + r32, cb)); } p0 = MF32(b2x, qr[8], p0); p1 = MF32(b2y, qr[8], p1); SGB(0x008, 1); SGB(0x100, 1); SGB(0x008, 1); SGB(0x100, 1); SBAR();
    b2x = PKV(vtr(vb + v_rd_off(3, 2, 0)), vtr(vb + v_rd_off(3, 2, 1))); b2y = PKV(vtr(vb + v_rd_off(3, 3, 0)), vtr(vb + v_rd_off(3, 3, 1))); o[3] = MF32(pa0, b0x, o[3]); o[3] = MF32(pa1, b0y, o[3]); SGB(0x008, 1); SGB(0x100, 2); SGB(0x008, 1); SGB(0x100, 2); SBAR();
    { const int cb = (10 * 16 + hi * 8) * 2; b0x = *reinterpret_cast<const bf16x8*>(Ks + kswz<192>(r32, cb)); b0y = *reinterpret_cast<const bf16x8*>(Ks + kswz<192>(32 + r32, cb)); } p0 = MF32(b1x, qr[9], p0); p1 = MF32(b1y, qr[9], p1); SGB(0x008, 1); SGB(0x100, 1); SGB(0x008, 1); SGB(0x100, 1); SBAR();
    { const int cb = (11 * 16 + hi * 8) * 2; b1x = *reinterpret_cast<const bf16x8*>(Ks + kswz<192>(r32, cb)); b1y = *reinterpret_cast<const bf16x8*>(Ks + kswz<192>(32 + r32, cb)); } o[3] = MF32(pa2, b2x, o[3]); o[3] = MF32(pa3, b2y, o[3]); SGB(0x008, 1); SGB(0x100, 1); SGB(0x008, 1); SGB(0x100, 1); SBAR();
    p0 = MF32(b0x, qr[10], p0); p1 = MF32(b0y, qr[10], p1); SBAR();
    p0 = MF32(b1x, qr[11], p0); p1 = MF32(b1y, qr[11], p1); SBAR();
  } else {
    b0x = PKV(vtr(vb + v_rd_off(0, 0, 0)), vtr(vb + v_rd_off(0, 0, 1))); b0y = PKV(vtr(vb + v_rd_off(0, 1, 0)), vtr(vb + v_rd_off(0, 1, 1)));
    b1x = PKV(vtr(vb + v_rd_off(0, 2, 0)), vtr(vb + v_rd_off(0, 2, 1))); b1y = PKV(vtr(vb + v_rd_off(0, 3, 0)), vtr(vb + v_rd_off(0, 3, 1)));
    SBAR();
    b2x = PKV(vtr(vb + v_rd_off(1, 0, 0)), vtr(vb + v_rd_off(1, 0, 1))); b2y = PKV(vtr(vb + v_rd_off(1, 1, 0)), vtr(vb + v_rd_off(1, 1, 1))); o[0] = MF32(pa0, b0x, o[0]); o[0] = MF32(pa1, b0y, o[0]); SGB(0x008, 1); SGB(0x100, 2); SGB(0x008, 1); SGB(0x100, 2); SBAR();
    b0x = PKV(vtr(vb + v_rd_off(1, 2, 0)), vtr(vb + v_rd_off(1, 2, 1))); b0y = PKV(vtr(vb + v_rd_off(1, 3, 0)), vtr(vb + v_rd_off(1, 3, 1))); o[0] = MF32(pa2, b1x, o[0]); o[0] = MF32(pa3, b1y, o[0]); SGB(0x008, 1); SGB(0x100, 2); SGB(0x008, 1); SGB(0x100, 2); SBAR();
    b1x = PKV(vtr(vb + v_rd_off(2, 0, 0)), vtr(vb + v_rd_off(2, 0, 1))); b1y = PKV(vtr(vb + v_rd_off(2, 1, 0)), vtr(vb + v_rd_off(2, 1, 1))); o[1] = MF32(pa0, b2x, o[1]); o[1] = MF32(pa1, b2y, o[1]); SGB(0x008, 1); SGB(0x100, 2); SGB(0x008, 1); SGB(0x100, 2); SBAR();
    b2x = PKV(vtr(vb + v_rd_off(2, 2, 0)), vtr(vb + v_rd_off(2, 2, 1))); b2y = PKV(vtr(vb + v_rd_off(2, 3, 0)), vtr(vb + v_rd_off(2, 3, 1))); o[1] = MF32(pa2, b0x, o[1]); o[1] = MF32(pa3, b0y, o[1]); SGB(0x008, 1); SGB(0x100, 2); SGB(0x008, 1); SGB(0x100, 2); SBAR();
    b0x = PKV(vtr(vb + v_rd_off(3, 0, 0)), vtr(vb + v_rd_off(3, 0, 1))); b0y = PKV(vtr(vb + v_rd_off(3, 1, 0)), vtr(vb + v_rd_off(3, 1, 1))); o[2] = MF32(pa0, b1x, o[2]); o[2] = MF32(pa1, b1y, o[2]); SGB(0x008, 1); SGB(0x100, 2); SGB(0x008, 1); SGB(0x100, 2); SBAR();
    b1x = PKV(vtr(vb + v_rd_off(3, 2, 0)), vtr(vb + v_rd_off(3, 2, 1))); b1y = PKV(vtr(vb + v_rd_off(3, 3, 0)), vtr(vb + v_rd_off(3, 3, 1))); o[2] = MF32(pa2, b2x, o[2]); o[2] = MF32(pa3, b2y, o[2]); SGB(0x008, 1); SGB(0x100, 2); SGB(0x008, 1); SGB(0x100, 2); SBAR();
    o[3] = MF32(pa0, b0x, o[3]); o[3] = MF32(pa1, b0y, o[3]); SBAR();
    o[3] = MF32(pa2, b1x, o[3]); o[3] = MF32(pa3, b1y, o[3]); SBAR();
  }
  __builtin_amdgcn_s_setprio(0);
#undef PKV
#undef MF32
#undef SGB
}
template <int DQK, bool QLDS, int COMB = 0>
__device__ __forceinline__ void attn_unit_pp(const bf16* __restrict__ Qb, int ldq, const bf16* __restrict__ Kh, int ldk, const bf16* __restrict__ Kp, int ldkp,
                                             const bf16* __restrict__ Vh, int ldv, bf16* __restrict__ Ob, int ldo, int seq, char* lds,
                                             const bf16* O0 = nullptr, int ldo0 = 0, float lam = 0.f, const float* sg = nullptr, float cscale = 1.f) {
  constexpr int SHM_V = KVBLK * 128 * 2, SHM_K = KVBLK * DQK * 2, OFF_K = 3 * SHM_V, OFF_W = OFF_K + 2 * SHM_K, OFF_Q = OFF_W + 2048;
  int tid_ = threadIdx.x; asm volatile("" : "+v"(tid_));
  const int tid = tid_, wid = tid >> 6, lane = tid & 63, r32 = lane & 31, hi = lane >> 5;
  const int grp = __builtin_amdgcn_readfirstlane(wid >> 2);
  char* V_lds = lds; char* K_lds = lds + OFF_K;
  float* wsf = (float*)(lds + OFF_W) + wid * 64; float* li_l = wsf; float* al_l = wsf + 32;
  constexpr int NQR = QLDS ? 8 : DQK / 16;
  float m_reg = -1e30f, l_reg = 0; f32x16 o[4] = {}; bf16x8 qr[NQR];
  const bf16* Qw = Qb + (long)(wid * QBLK + r32) * ldq + hi * 8;
#pragma unroll
  for (int d0 = 0; d0 < NQR; ++d0) qr[d0] = ld8(Qw + d0 * 16);
  constexpr bool SEED = SEED_MASK & (DQK == 64 ? 1 : (DQK == 128 ? 2 : 4));
  f32x16 minit = {};
  if constexpr (SEED) { constexpr float QS = (DQK == 64 ? 0.125f : (DQK == 128 ? 0.088388347648318440f : 0.072168783648703220f)) * 1.4426950408889634f;
#pragma unroll
    for (int d0 = 0; d0 < NQR; ++d0) qr[d0] = scale_bf16x8(qr[d0], QS); }
  char* qpe_l = lds + OFF_Q + wid * 4096;
  if constexpr (QLDS) {
#pragma unroll
    for (int d0 = 8; d0 < DQK / 16; ++d0) *(bf16x8*)(qpe_l + kswz<64>(r32, (d0 * 16 + hi * 8) * 2 - 256)) = ld8(Qw + d0 * 16);
  }
  constexpr bool SEED_IMG = SEED_MASK & (DQK == 64 ? 1 : (DQK == 128 ? 2 : 4));
  const int sr = tid >> 4, sc = (tid & 15) * 8, vst0 = SEED_IMG ? v_stn(sr, sc) : v_st(sr, sc), vst1 = SEED_IMG ? v_stn(32 + sr, sc) : v_st(32 + sr, sc);
  const int sr8 = tid >> 3, sc8 = (tid & 7) * 8;
  const int vb0 = (int)(uintptr_t)V_lds + v_rd_base(lane);
  bf16x8 vs0, vs1, ks0, ks1, kp;
  const unsigned vo0 = (unsigned)(sr * ldv + sc) * 2u, vo1 = (unsigned)((32 + sr) * ldv + sc) * 2u;
  const unsigned ko0 = DQK == 64 ? (unsigned)(sr8 * ldk + sc8) * 2u : (unsigned)(sr * ldk + sc) * 2u, ko1 = (unsigned)((32 + sr) * ldk + sc) * 2u;
  const unsigned kpo = DQK == 192 ? (unsigned)(sr8 * ldkp + sc8) * 2u : 0u;
  const __amdgpu_buffer_rsrc_t rV = __builtin_amdgcn_make_buffer_rsrc((void*)Vh, 0, 0x7fffffff, 0x00020000), rK = __builtin_amdgcn_make_buffer_rsrc((void*)Kh, 0, 0x7fffffff, 0x00020000);
  const __amdgpu_buffer_rsrc_t rP = __builtin_amdgcn_make_buffer_rsrc((void*)(DQK == 192 ? Kp : Kh), 0, 0x7fffffff, 0x00020000);
#define BLD(r, vo, so) __builtin_bit_cast(bf16x8, __builtin_amdgcn_raw_buffer_load_b128((r), (int)(vo), (int)(so), 0))
#define PLOAD(k0) do { const unsigned sv_ = (unsigned)(k0) * (unsigned)ldv * 2u, sk_ = (unsigned)(k0) * (unsigned)ldk * 2u; \
    vs0 = BLD(rV, vo0, sv_); vs1 = BLD(rV, vo1, sv_); ks0 = BLD(rK, ko0, sk_); \
    if constexpr (DQK != 64) { ks1 = BLD(rK, ko1, sk_); } \
    if constexpr (DQK == 192) { kp = BLD(rP, kpo, (unsigned)(k0) * (unsigned)ldkp * 2u); } } while (0)
#define PWRITE(koff, voff) do { *(bf16x8*)(V_lds + (voff) + vst0) = vs0; *(bf16x8*)(V_lds + (voff) + vst1) = vs1; \
    if constexpr (DQK == 64) { *(bf16x8*)(K_lds + (koff) + kswz<DQK>(sr8, sc8 * 2)) = ks0; } \
    else { *(bf16x8*)(K_lds + (koff) + kswz<DQK>(sr, sc * 2)) = ks0; *(bf16x8*)(K_lds + (koff) + kswz<DQK>(32 + sr, sc * 2)) = ks1; } \
    if constexpr (DQK == 192) { *(bf16x8*)(K_lds + (koff) + kswz<DQK>(sr8, 256 + sc8 * 2)) = kp; } } while (0)
#define PRESC(a) do { if (__any((a) < 1.f)) { if (hi == 0) al_l[r32] = (a); asm volatile("s_waitcnt lgkmcnt(0)" ::: "memory"); \
    _Pragma("unroll") for (int d = 0; d < 4; ++d) _Pragma("unroll") for (int r = 0; r < 16; ++r) o[d][r] *= al_l[crow(r, hi)]; } } while (0)
#define PBAR() do { __builtin_amdgcn_sched_barrier(0); asm volatile("s_waitcnt lgkmcnt(0)" ::: "memory"); __builtin_amdgcn_s_barrier(); asm volatile("" ::: "memory"); __builtin_amdgcn_sched_barrier(0); } while (0)
  f32x16 p0, p1; float al; bf16x8 pa0, pa1, pa2, pa3; const int NT = seq / KVBLK;
  constexpr bool SM = false;
  PLOAD(0); PWRITE(0, 0); PLOAD(KVBLK); PWRITE(SHM_K, SHM_V);
  if ((SM || grp == 1) && 2 < NT) PLOAD(2 * KVBLK);
  PBAR();
  if (grp == 1) PBAR();
  const int LD = 2 + grp;
  int vw = SM ? 2 * SHM_V : (LD - 1) * SHM_V;
  SBAR(); qkt<DQK, QLDS>(p0, p1, K_lds, qr, qpe_l, r32, hi);
  PBAR();
  if constexpr (SEED) softmax_first(p0, p1, m_reg, l_reg, al, minit, pa0, pa1, pa2, pa3); else softmax_tile<DQK>(p0, p1, m_reg, l_reg, al, pa0, pa1, pa2, pa3);
  if constexpr (!SM) { const int u = LD - 1; if (u >= 2 && u < NT) PWRITE((u & 1) * SHM_K, vw); if (u + 1 >= 2 && u + 1 < NT) PLOAD((u + 1) * KVBLK);
    vw += SHM_V; if (vw == 3 * SHM_V) vw = 0; }
  PBAR();
  int vr = 0;
  for (int t = 0; t < NT; ++t) {
    SBAR();
    static_assert(!QLDS, "the ping-pong MFMA segment keeps all of Q in registers");
    if constexpr (DQK == 192 && M192) {
      if (t + 1 < NT) mseg192<true, SEED>(o, p0, p1, minit, K_lds + ((t + 1) & 1) * SHM_K, vb0 + vr, qr, pa0, pa1, pa2, pa3, r32, hi);
      else mseg192<false, SEED>(o, p0, p1, minit, K_lds, vb0 + vr, qr, pa0, pa1, pa2, pa3, r32, hi);
    } else {
      if (t + 1 < NT) mseg<DQK, true, SEED>(o, p0, p1, minit, K_lds + ((t + 1) & 1) * SHM_K, vb0 + vr, qr, pa0, pa1, pa2, pa3, r32, hi);
      else mseg<DQK, false, SEED>(o, p0, p1, minit, K_lds, vb0 + vr, qr, pa0, pa1, pa2, pa3, r32, hi);
    }
    vr += SHM_V; if (vr == 3 * SHM_V) vr = 0;
    if constexpr (SM) { const int u = t + 2; if (u < NT) PWRITE((u & 1) * SHM_K, vw); if (u + 1 < NT) PLOAD((u + 1) * KVBLK);
      vw += SHM_V; if (vw == 3 * SHM_V) vw = 0; }
    PBAR();
    if (t + 1 < NT) { if constexpr (SEED) { if (softmax_seeded(p0, p1, m_reg, l_reg, al, minit, pa0, pa1, pa2, pa3)) PRESC(al); } else { softmax_tile<DQK>(p0, p1, m_reg, l_reg, al, pa0, pa1, pa2, pa3); PRESC(al); } }
    if constexpr (!SM) { const int u = t + LD; if (u < NT) PWRITE((u & 1) * SHM_K, vw); if (u + 1 < NT) PLOAD((u + 1) * KVBLK);
      vw += SHM_V; if (vw == 3 * SHM_V) vw = 0; }
    PBAR();
  }
  if (grp == 0) PBAR();
  if constexpr (SEED) { auto rr = __builtin_amdgcn_permlane32_swap(__float_as_uint(l_reg), __float_as_uint(l_reg), false, false); l_reg = __uint_as_float(rr[0]) + __uint_as_float(rr[1]); }
  if (hi == 0) li_l[r32] = l_reg; asm volatile("s_waitcnt lgkmcnt(0)" ::: "memory");
  float rli[16];
#pragma unroll
  for (int r = 0; r < 16; ++r) rli[r] = __builtin_amdgcn_rcpf(li_l[crow(r, hi)]);
  bf16* Ow = Ob + (long)(wid * QBLK) * ldo;
  if constexpr (COMB == 2) {
    const bf16* O0w = O0 + (long)(wid * QBLK) * ldo0; float g4[4];
#pragma unroll
    for (int d0 = 0; d0 < 4; ++d0) g4[d0] = sg[d0 * 32 + r32] * cscale;
#pragma unroll
    for (int r = 0; r < 16; ++r) { const int orow = crow(r, hi); float v[4]; float ss = 0.f;
#pragma unroll
      for (int d0 = 0; d0 < 4; ++d0) { v[d0] = bf2f(O0w[(long)orow * ldo0 + d0 * 32 + r32]) - lam * bf2f((bf16)f2bf(o[d0][r] * rli[r])); ss += v[d0] * v[d0]; }
#pragma unroll
      for (int sft = 1; sft < 32; sft <<= 1) ss += __shfl_xor(ss, sft);
      const float rstd = rsqrtf(ss * (1.0f / 128.0f) + EPS);
#pragma unroll
      for (int d0 = 0; d0 < 4; ++d0) Ow[(long)orow * ldo + d0 * 32 + r32] = (bf16)f2bf(v[d0] * rstd * g4[d0]); }
  } else {
#pragma unroll
    for (int r = 0; r < 16; ++r) { const int orow = crow(r, hi);
#pragma unroll
      for (int d0 = 0; d0 < 4; ++d0) Ow[(long)orow * ldo + d0 * 32 + r32] = (bf16)f2bf(o[d0][r] * rli[r]); }
  }
#undef PLOAD
#undef BLD
#undef PWRITE
#undef PRESC
#undef PBAR
}
}

#define GRID_BAR() xcd_barrier(bar)
#define GEMM_PHASE_E(EpiT, Einit, Aptr, Btptr, Mm, Nn, Kk) do { pg8::Gemm g_{(const bf16*)(Aptr), (const bf16*)(Btptr), (Mm), (Nn), (Kk), (Kk), (Kk)}; pg8::StaticOrder S_; S_.init((Mm), (Nn), (int)gridDim.x, (int)blockIdx.x); \
    const EpiT E_ Einit; pg8::gemm_phase<EpiT, pg8::StaticOrder, true, true>((LAS unsigned char*)lds, g_, S_, E_); } while (0)
#define GEMM_PHASE_EL(EpiT, Einit, Aptr, Lda, Btptr, Mm, Nn, Kk) do { pg8::Gemm g_{(const bf16*)(Aptr), (const bf16*)(Btptr), (Mm), (Nn), (Kk), (Lda), (Kk)}; pg8::StaticOrder S_; S_.init((Mm), (Nn), (int)gridDim.x, (int)blockIdx.x); \
    const EpiT E_ Einit; pg8::gemm_phase<EpiT, pg8::StaticOrder, true, true>((LAS unsigned char*)lds, g_, S_, E_); } while (0)
#define GEMM_PHASE(Aptr, Btptr, Mm, Nn, Kk, Optr) do { pg8::Gemm g_{(const bf16*)(Aptr), (const bf16*)(Btptr), (Mm), (Nn), (Kk), (Kk), (Kk)}; pg8::StaticOrder S_; S_.init((Mm), (Nn), (int)gridDim.x, (int)blockIdx.x); \
    pg8::EpiBf16 E_{(bf16*)(Optr), (Nn)}; pg8::gemm_phase<pg8::EpiBf16, pg8::StaticOrder, true, true>((LAS unsigned char*)lds, g_, S_, E_); } while (0)

#define GEMM2048_PHASE(Aptr, Btptr, Kk) do { \
    { pg8::Gemm g_{(const bf16*)(Aptr), (const bf16*)(Btptr), MSPLIT, 2048, (Kk), (Kk), (Kk)}; pg8::StaticOrder S_; S_.init(MSPLIT, 2048, (int)gridDim.x, (int)blockIdx.x); \
      pg8::EpiBf16 E_{(bf16*)(ws + WS_T), 2048, false, false}; pg8::gemm_phase<pg8::EpiBf16, pg8::StaticOrder, true, true>((LAS unsigned char*)lds, g_, S_, E_); } \
    { const int G_ = (int)gridDim.x, bx_ = (int)blockIdx.x; \
      for (int hu_ = (G_ % 8 == 0) ? (bx_ % 8) * (G_ / 8) + bx_ / 8 : bx_; hu_ < 2 * ((M - MSPLIT) / 256) * 8; hu_ += G_) { const int tile_ = hu_ >> 1, kh_ = hu_ & 1; \
        pg8::Gemm g_{(const bf16*)(Aptr) + kh_ * ((Kk) / 2), (const bf16*)(Btptr) + kh_ * ((Kk) / 2), M, 2048, (Kk) / 2, (Kk), (Kk)}; pg8::OneUnit S_{{MSPLIT / 256 + (tile_ >> 3), tile_ & 7}}; \
        pg8::EpiBf16 E_{(bf16*)(ws + WS_SLAB) + (size_t)kh_ * SLAB_ELEMS - (size_t)MSPLIT * 2048, 2048}; pg8::gemm_phase<pg8::EpiBf16, pg8::OneUnit, true, true>((LAS unsigned char*)lds, g_, S_, E_); } } } while (0)

#ifndef ATT_SD_A
#define ATT_SD_A 1
#endif
#ifndef ATT_QLDS_A
#define ATT_QLDS_A false
#endif
template <int KIND> __device__ __forceinline__ void attn_phase(const Params& P, unsigned char* ldsp) {
    const Frame F = make_frame(ldsp);
    unsigned char* R = P.ws + WS_R; bf16* AO = (bf16*)(P.ws + WS_AO); char* lds = (char*)ldsp;
    if constexpr (KIND == 0) {
        const bf16* Q = (const bf16*)(R + R_A_Q); const bf16* KV = (const bf16*)(R + R_A_KV); const bf16* KPEF = (const bf16*)(R + R_A_KPEF);
        for (int u = F.vcu; u < 1280; u += F.G) {
            int m0, kr0, seq, h;
            if (u < 1024) { const int mb = u >> 8, qb = u & 15; h = (u >> 4) & 15; m0 = MP + mb * DSEQ + qb * 256; kr0 = MP + mb * LSEQ; seq = LSEQ; }
            else { const int v = u - 1024, pb = v >> 4; h = v & 15; m0 = pb * 256; kr0 = pb * 256; seq = SEQ; }
            att::attn_unit_pp<192, false>(Q + (size_t)m0 * 3072 + h * 192, 3072, KV + (size_t)kr0 * 4096 + h * 256, 4096, KPEF + (size_t)kr0 * 64, 64,
                                KV + (size_t)kr0 * 4096 + h * 256 + 128, 4096, AO + (size_t)m0 * 2048 + h * 128, 2048, seq, lds);
            __syncthreads();
        }
    } else if constexpr (KIND == 1) {
        const bf16* QB = (const bf16*)(R + R_B_Q); const bf16* KF = (const bf16*)(R + R_B_KF); const bf16* VF = (const bf16*)(R + R_B_VF); bf16* OC = (bf16*)(R + R_B_OC);
        const float lam = ((const float*)(P.ws + WS_MISC))[0];
        for (int u = F.vcu; u < 1280; u += F.G) {
            int m0, kr0, seq, h;
            if (u < 1024) { const int mb = u >> 8, qb = u & 15; h = (u >> 4) & 15; m0 = MP + mb * DSEQ + qb * 256; kr0 = MP + mb * LSEQ; seq = LSEQ; }
            else { const int v = u - 1024, pb = v >> 4; h = v & 15; m0 = pb * 256; kr0 = pb * 256; seq = SEQ; }
            att::attn_unit_pp<64, false, 1>(QB + (size_t)m0 * 2048 + h * 128, 2048, KF + (size_t)kr0 * 2048 + h * 128, 2048, nullptr, 0,
                               VF + (size_t)kr0 * 2048 + h * 128, 2048, OC + (size_t)m0 * 2048 + h * 128, 2048, seq, lds);
            __syncthreads();
            att::attn_unit_pp<64, false, 2>(QB + (size_t)m0 * 2048 + h * 128 + 64, 2048, KF + (size_t)kr0 * 2048 + h * 128 + 64, 2048, nullptr, 0,
                               VF + (size_t)kr0 * 2048 + h * 128, 2048, AO + (size_t)m0 * 2048 + h * 128, 2048, seq, lds,
                               OC + (size_t)m0 * 2048 + h * 128, 2048, lam, P.in[I_BSUBLN], 1.0f - LAM_INIT_1);
            __syncthreads();
        }
    } else {
        const bf16* QC = (const bf16*)(R + R_C_Q); const bf16* KF = (const bf16*)(R + R_C_KF); const bf16* VF = (const bf16*)(R + R_C_VF);
        for (int u = F.vcu; u < 1280; u += F.G) {
            int m0, kr0, seq, h;
            if (u < 1024) { const int mb = u >> 8, qb = u & 15; h = (u >> 4) & 15; m0 = MP + mb * DSEQ + qb * 256; kr0 = MP + mb * LSEQ; seq = LSEQ; }
            else { const int v = u - 1024, pb = v >> 4; h = v & 15; m0 = pb * 256; kr0 = pb * 256; seq = SEQ; }
            att::attn_unit_pp<128, false>(QC + (size_t)m0 * 2048 + h * 128, 2048, KF + (size_t)kr0 * 512 + (h >> 2) * 128, 512, nullptr, 0,
                                VF + (size_t)kr0 * 512 + (h >> 2) * 128, 512, AO + (size_t)m0 * 2048 + h * 128, 2048, seq, lds);
            __syncthreads();
        }
    }
}

template <int L> __device__ __forceinline__ void layer(const Params& P, unsigned char* lds, const XcdBarrier& bar) {
    constexpr int KIND = L % 3, J = L / 3;
    unsigned char* ws = P.ws; unsigned char* R = ws + WS_R;
    bf16* H = (bf16*)(ws + WS_H); bf16* T = (bf16*)(ws + WS_T); bf16* AO = (bf16*)(ws + WS_AO);
    const float* MOD = (const float*)(ws + WS_MOD); const float* MODl = MOD + (size_t)L * 5 * 12288;
    const float* ng = P.in[I_NORMG] + (size_t)L * 4 * D;
    if constexpr (KIND == 0) {
        mla_cache_rows(P, lds, J);
        GEMM_PHASE_E(EpiMlaDown, ({(bf16*)(R + R_A_D1), (float*)(R + R_A_SSP), (bf16*)(R + R_A_CKVF), (bf16*)(R + R_A_KPEF), P.out + O_SA_CKV, P.out + O_SA_KPE, P.in[I_AKVN] + J * 256, (const float*)(ws + WS_MISC) + 256,
                      (LAS float*)((LAS unsigned char*)lds + EPI_LDS_OFF), J}), H, ws + WS_W_A_DOWN + (size_t)J * 4 * MiB, M, 1024, 2048); GRID_BAR();
        GEMM_PHASE_EL(EpiMlaQ, ({(bf16*)(R + R_A_Q), (const float*)(ws + WS_MISC) + 256, (const float*)(R + R_A_SSP), (LAS float*)((LAS unsigned char*)lds + EPI_LDS_OFF)}), R + R_A_D1, 1024, ws + WS_W_A_UQ + (size_t)J * 3 * MiB, M, 3072, 512);
        GEMM_PHASE(R + R_A_CKVF, ws + WS_W_A_UKV + (size_t)J * 2 * MiB, LKV, 4096, 256, R + R_A_KV); GRID_BAR();
        attn_phase<0>(P, lds); GRID_BAR();
        GEMM2048_PHASE(AO, ws + WS_W_A_O + (size_t)J * 8 * MiB, 2048); GRID_BAR();
    } else if constexpr (KIND == 1) {
        diff_cache_rows(P, lds);
        GEMM_PHASE_E(EpiDiffQKV, ({(bf16*)(R + R_B_Q), (bf16*)(R + R_B_KF), (bf16*)(R + R_B_VF), P.out + O_SB_K, P.out + O_SB_V, (const float*)(ws + WS_MISC) + 256}), H, ws + WS_W_B_QKV, M, 6144, 2048); GRID_BAR();
        attn_phase<1>(P, lds); GRID_BAR();
        GEMM2048_PHASE(AO, ws + WS_W_B_O, 2048); GRID_BAR();
    } else {
        gqa_cache_rows(P, lds);
        GEMM_PHASE_E(EpiGqaQKV, ({(bf16*)(R + R_C_Q), (bf16*)(R + R_C_KF), (bf16*)(R + R_C_VF), P.out + O_SC_K, P.out + O_SC_V, (const float*)(ws + WS_MISC) + 4096, P.in[I_CQN], P.in[I_CKN], (LAS float*)((LAS unsigned char*)lds + EPI_LDS_OFF)}), H, ws + WS_W_C_QKV, M, 3072, 2048); GRID_BAR();
        attn_phase<2>(P, lds); GRID_BAR();
        GEMM2048_PHASE(AO, ws + WS_W_C_O, 2048); GRID_BAR();
    }
    resnorm_phase<true, true, L == 0, false>(P, lds, T, ng + 1 * D, MODl, 2, ng + 2 * D, MODl, 3, 4, H); GRID_BAR();
    GEMM_PHASE_E(EpiConvGate, ({(bf16*)(R + R_G), (float*)(ws + WS_EDGE), P.in[I_FCW] + (size_t)L * 3 * NFF, P.in[I_FCB] + (size_t)L * NFF, (LAS float*)((LAS unsigned char*)lds + EPI_LDS_OFF)}), H, ws + WS_W_FIN + (size_t)L * 44 * MiB, M, NFF, 2048); GRID_BAR();
    conv_fix_phase(P, lds, L); GRID_BAR();
    GEMM2048_PHASE(R + R_G, ws + WS_W_FDN + (size_t)L * 22 * MiB, DFF); GRID_BAR();
    if constexpr (L < 3) { resnorm_phase<true, true, false, false>(P, lds, T, ng + 3 * D, MODl, 5, ng + 4 * D, MODl + 5 * 12288, 0, 1, H); GRID_BAR(); }
    else resnorm_phase<true, false, false, true>(P, lds, T, ng + 3 * D, MODl, 5, nullptr, nullptr, 0, 0, nullptr);
}

__global__ void __launch_bounds__(NWAVES * 64, 2) mk_fwd(Params P) {
    extern __shared__ __attribute__((aligned(16))) unsigned char lds[];
    volatile LAS unsigned* MISC = (volatile LAS unsigned*)((LAS unsigned char*)lds + MISC_OFF);
    for (int u = threadIdx.x; u < (LDS_BYTES - LDSCTL_OFF) / 4; u += NWAVES * 64) ((LAS unsigned*)((LAS unsigned char*)lds + LDSCTL_OFF))[u] = 0u;
    __syncthreads();
    unsigned* ctl = (unsigned*)(P.ws + WS_CTL);
    XcdBarrier bar = xcd_barrier_post(ctl + CW_BAR, MISC + 8);

    p0_prologue(P, lds); GRID_BAR();
    { const float* MOD = (const float*)(P.ws + WS_MOD); const float* ng = P.in[I_NORMG];
      resnorm_phase<false, true, true, false>(P, lds, nullptr, nullptr, nullptr, 0, ng, MOD, 0, 1, (bf16*)(P.ws + WS_H)); GRID_BAR(); }
    layer<0>(P, lds, bar);
    layer<1>(P, lds, bar);
    layer<2>(P, lds, bar);
    layer<3>(P, lds, bar);
}

extern "C" void kernel_launch(void* const* d_in, const int* in_sizes, int n_in, void* d_out, int out_size, void* d_ws, size_t ws_size, hipStream_t stream) {
    static int grid = 0;
    if (grid == 0) {
        if (n_in != 31 || (size_t)out_size != O_END || ws_size < WS_END) { fprintf(stderr, "kernel_launch: unexpected shapes: n_in %d out %d ws %zu (need >= %zu)\n", n_in, out_size, ws_size, (size_t)WS_END); grid = -1; return; }
        int dev = 0, cus = 0, per_cu = 0;
        if (hipGetDevice(&dev) != hipSuccess || hipDeviceGetAttribute(&cus, hipDeviceAttributeMultiprocessorCount, dev) != hipSuccess) { grid = -1; return; }
        if (hipFuncSetAttribute((const void*)mk_fwd, hipFuncAttributeMaxDynamicSharedMemorySize, LDS_BYTES) != hipSuccess) { fprintf(stderr, "kernel_launch: hipFuncSetAttribute failed\n"); grid = -1; return; }
        if (hipOccupancyMaxActiveBlocksPerMultiprocessor(&per_cu, (const void*)mk_fwd, NWAVES * 64, LDS_BYTES) != hipSuccess || per_cu < 1) { fprintf(stderr, "kernel_launch: occupancy query says %d\n", per_cu); }
        (void)hipGetLastError();
        grid = cus;
    }
    if (grid < 0) return;
    (void)hipMemsetAsync((char*)d_ws + WS_CTL, 0, CTL_ZERO_BYTES, stream);
    Params p{};
    for (int i = 0; i < 31; ++i) p.in[i] = (const float*)d_in[i];
    p.out = (float*)d_out; p.ws = (unsigned char*)d_ws;
    hipLaunchKernelGGL(mk_fwd, dim3(grid), dim3(NWAVES * 64), LDS_BYTES, stream, p);
    const hipError_t le = hipPeekAtLastError();
    if (le != hipSuccess) fprintf(stderr, "kernel_launch: launch failed: %s\n", hipGetErrorName(le));
}
```

```cpp
#include <hip/hip_runtime.h>
#include <cstdio>
#include <cstdint>

namespace pg8 {
#define PG8_LAS __attribute__((address_space(3)))
typedef unsigned short bf16_t;
typedef short bf16x8 __attribute__((ext_vector_type(8)));
typedef float f32x4 __attribute__((ext_vector_type(4)));
typedef unsigned u32x4 __attribute__((ext_vector_type(4)));
constexpr int BM = 256, BK = 64, HALF = 128, HTB = HALF * BK * 2  , STAGE_BYTES = 8 * HTB, NXCD = 8, WGM = 10;

__host__ __device__ __forceinline__ int lds_byte(int r, int c) { const int st = (r >> 4) * 2 + (c >> 5), rr = r & 15, cc = c & 31, ob = rr * 64 + cc * 2; return st * 1024 + (ob ^ (((ob >> 9) & 1) << 5)); }
__host__ __device__ __forceinline__ void stage_rc(int b, int& R, int& C) { const int st = b / 1024, sb = b % 1024, swz = sb ^ (((sb >> 9) & 1) << 5); R = (st >> 1) * 16 + swz / 64; C = (st & 1) * 32 + (swz % 64) / 2; }
__host__ __device__ __forceinline__ int perm32(int rho) { const int n = rho >> 4, i = rho & 15; return 8 * (i >> 2) + 4 * n + (i & 3); }

struct Unit { int pm, pn; };
struct Gemm { const bf16_t* A; const bf16_t* Bt; int M, N, K, lda, ldb; };

struct StaticOrder {
    int nM, nN, nwg, G, c;
    __host__ __device__ void init(int M, int N, int G_, int c_) { nM = M / BM; nN = N / BM; nwg = nM * nN; G = G_; c = c_; }
    __host__ __device__ bool next(int i, Unit& u) const {
        const long L = (long)i * G + c; if (L >= nwg) return false;
        int wgid = (int)L; { const int q = nwg / NXCD, r = nwg % NXCD, xcd = wgid % NXCD, off = wgid / NXCD; wgid = (xcd < r ? xcd * (q + 1) : r * (q + 1) + (xcd - r) * q) + off; }
        const int nig = WGM * nN, gid = wgid / nig, fm = gid * WGM, gsz = (nM - fm) < WGM ? (nM - fm) : WGM;
        u.pm = fm + ((wgid % nig) % gsz); u.pn = (wgid % nig) / gsz; return true;
    }
    __device__ __forceinline__ void a_ready(const Unit&) const {}
    __device__ __forceinline__ void done(const Unit&) const {}
};

struct OneUnit {
    Unit u;
    __device__ __forceinline__ bool next(int i, Unit& o) const { if (i) return false; o = u; return true; }
    __device__ __forceinline__ void a_ready(const Unit&) const {}
    __device__ __forceinline__ void done(const Unit&) const {}
};
__device__ __forceinline__ unsigned cvt_pk_bf16(float lo, float hi) { unsigned r; asm volatile("v_cvt_pk_bf16_f32 %0, %1, %2" : "=v"(r) : "v"(lo), "v"(hi)); return r; }

struct EpiBf16 {
    static constexpr bool PERM = true, AFTER_DRAIN = false, PREFETCH = false, AROWPERM = false;
    bf16_t* O; int ldc;
    __device__ __forceinline__ void operator()(const f32x4 (&acc)[2][2][4][2], const Unit& u, int wr, int wc, int fr, int fq) const {
        const int row0 = u.pm * BM + wr * 64 + fr; const int col0 = u.pn * BM + wc * 32 + 8 * fq;
#pragma unroll
        for (int ai = 0; ai < 2; ++ai)
#pragma unroll
            for (int m = 0; m < 4; ++m) { bf16_t* rowp = O + (size_t)(row0 + ai * HALF + m * 16) * ldc + col0;
#pragma unroll
                for (int bj = 0; bj < 2; ++bj) { const f32x4 v0 = acc[ai][bj][m][0], v1 = acc[ai][bj][m][1];
                    u32x4 w; w.x = cvt_pk_bf16(v0[0], v0[1]); w.y = cvt_pk_bf16(v0[2], v0[3]); w.z = cvt_pk_bf16(v1[0], v1[1]); w.w = cvt_pk_bf16(v1[2], v1[3]);
                    *(u32x4*)(rowp + bj * HALF) = w; } }
    }
};
struct EpiF32 {
    static constexpr bool PERM = false, AFTER_DRAIN = false, PREFETCH = false, AROWPERM = false;
    float* C; int ldc, row_off;
    __device__ __forceinline__ void operator()(const f32x4 (&acc)[2][2][4][2], const Unit& u, int wr, int wc, int fr, int fq) const {
        const int row0 = u.pm * BM - row_off + wr * 64 + fr, col0 = u.pn * BM + wc * 32 + 4 * fq;
#pragma unroll
        for (int ai = 0; ai < 2; ++ai)
#pragma unroll
            for (int m = 0; m < 4; ++m) { float* rowp = C + (size_t)(row0 + ai * HALF + m * 16) * ldc + col0;
#pragma unroll
                for (int bj = 0; bj < 2; ++bj)
#pragma unroll
                    for (int n = 0; n < 2; ++n) *(f32x4*)(rowp + bj * HALF + n * 16) = acc[ai][bj][m][n]; }
    }
};

template <class Epi, class Sched, bool ALIGN_EPI = false, bool SP2 = false>
__device__ __forceinline__ void gemm_phase(PG8_LAS unsigned char* lds, const Gemm g, const Sched& S, const Epi& E) {
    int tid_ = threadIdx.x; asm volatile("" : "+v"(tid_));
    const int tid = tid_, wid = __builtin_amdgcn_readfirstlane(tid >> 6), lane = tid & 63, wr = wid >> 2, wc = wid & 3, fr = lane & 15, fq = lane >> 4;
    const int K = g.K, nt = K / BK;
    unsigned voffA[2], voffB[2];
#pragma unroll
    for (int i = 0; i < 2; ++i) { int R, C; stage_rc(tid * 16 + i * 8192, R, C); const int Rb = Epi::PERM ? ((R & ~31) + perm32(R & 31)) : R;
        const int Ra = Epi::AROWPERM ? ((R & ~63) + 4 * (R & 15) + ((R >> 4) & 3)) : R;
        voffA[i] = (unsigned)(Ra * g.lda + C) * 2u; voffB[i] = (unsigned)(Rb * g.ldb + C) * 2u; }
    const size_t kstep = (size_t)(BK * 2);
    const size_t hstepA = (size_t)HALF * g.lda * 2, hstepB = (size_t)HALF * g.ldb * 2;
    const size_t tstepA = 2 * hstepA, tstepB = 2 * hstepB;
    const unsigned ldsw = (unsigned)wid * 1024u;
    const int aoff = lds_byte(wr * 64 + fr, fq * 8), boff = lds_byte(wc * 32 + fr, fq * 8);
#define PG8_SA(b, h) (((b) * 2 + (h)) * HTB)
#define PG8_SB(b, h) ((4 + (b) * 2 + (h)) * HTB)
    const __amdgpu_buffer_rsrc_t rsA = __builtin_amdgcn_make_buffer_rsrc((void*)g.A, 0, 0x7fffffff, 0x00020000), rsB = __builtin_amdgcn_make_buffer_rsrc((void*)g.Bt, 0, 0x7fffffff, 0x00020000);
#define PG8_RS_voffA rsA
#define PG8_RS_voffB rsB
#define PG8_B0_voffA ((const char*)g.A)
#define PG8_B0_voffB ((const char*)g.Bt)
#define PG8_STAGE(bufoff, gbase, voff) PG8_STAGE_(bufoff, gbase, voff, PG8_RS_##voff, PG8_B0_##voff)
#define PG8_STAGE_(bufoff, gbase, voff, rs, b0) do { const unsigned so_ = (unsigned)((const char*)(gbase) - (b0)); _Pragma("unroll") for (int _i = 0; _i < 2; ++_i) \
        __builtin_amdgcn_raw_ptr_buffer_load_lds(rs, (PG8_LAS unsigned*)(lds + (bufoff) + ldsw + _i * 8192), 16, (int)(voff)[_i], (int)so_, 0, 0); } while (0)
#define PG8_LDA(dst, b, h) do { _Pragma("unroll") for (int m = 0; m < 4; ++m) _Pragma("unroll") for (int k = 0; k < 2; ++k) dst[m][k] = *(const PG8_LAS bf16x8*)(lds + PG8_SA(b, h) + aoff + m * 2048 + k * 1024); } while (0)
#define PG8_LDB(dst, b, h) do { _Pragma("unroll") for (int n = 0; n < 2; ++n) _Pragma("unroll") for (int k = 0; k < 2; ++k) dst[n][k] = *(const PG8_LAS bf16x8*)(lds + PG8_SB(b, h) + boff + n * 2048 + k * 1024); } while (0)
#define PG8_MMA(ai, bj, At, Bt) do { __builtin_amdgcn_s_setprio(1); _Pragma("unroll") for (int m = 0; m < 4; ++m) _Pragma("unroll") for (int n = 0; n < 2; ++n) _Pragma("unroll") for (int k = 0; k < 2; ++k) \
        acc[ai][bj][m][n] = __builtin_amdgcn_mfma_f32_16x16x32_bf16(Bt[n][k], At[m][k], acc[ai][bj][m][n], 0, 0, 0); __builtin_amdgcn_s_setprio(0); } while (0)
#define PG8_WAIT_V(n) asm volatile("s_waitcnt vmcnt(" #n ")" ::: "memory")
#define PG8_WAIT_L(n) asm volatile("s_waitcnt lgkmcnt(" #n ")" ::: "memory")
#define PG8_BAR __builtin_amdgcn_s_barrier()
#define PG8_SCHED __builtin_amdgcn_sched_barrier(0)
    Unit cur, nxt; int ui = 0;
    if (!S.next(0, cur)) return;
    f32x4 acc[2][2][4][2];
#pragma unroll
    for (int a = 0; a < 2; ++a)
#pragma unroll
        for (int b = 0; b < 2; ++b)
#pragma unroll
            for (int m = 0; m < 4; ++m)
#pragma unroll
                for (int n = 0; n < 2; ++n) acc[a][b][m][n] = (f32x4){0.f, 0.f, 0.f, 0.f};
    bf16x8 At[4][2], B0[2][2], B1[2][2];
    const char* cA = (const char*)g.A + (size_t)cur.pm * tstepA; const char* cB = (const char*)g.Bt + (size_t)cur.pn * tstepB;
    float pf0 = 0.f, pf1 = 0.f;
    if constexpr (Epi::PREFETCH) E.prefetch(cur, tid, pf0, pf1);
    S.a_ready(cur);
    if constexpr (SP2) {
        PG8_STAGE(PG8_SB(0, 0), cB, voffB); PG8_STAGE(PG8_SB(0, 1), cB + hstepB, voffB); PG8_STAGE(PG8_SA(0, 0), cA, voffA); PG8_STAGE(PG8_SA(0, 1), cA + hstepA, voffA);
        if (wr == 1) PG8_BAR;
        PG8_WAIT_V(2); PG8_BAR;
        PG8_STAGE(PG8_SB(1, 0), cB + kstep, voffB); PG8_STAGE(PG8_SA(1, 0), cA + kstep, voffA); PG8_STAGE(PG8_SB(1, 1), cB + hstepB + kstep, voffB);
        PG8_WAIT_V(6); PG8_BAR;
    } else {
        PG8_STAGE(PG8_SB(0, 0), cB, voffB); PG8_STAGE(PG8_SA(0, 0), cA, voffA); PG8_STAGE(PG8_SB(0, 1), cB + hstepB, voffB); PG8_STAGE(PG8_SA(0, 1), cA + hstepA, voffA);
        if (wr == 1) PG8_BAR;
        PG8_WAIT_V(4); PG8_BAR;
        PG8_STAGE(PG8_SB(1, 0), cB + kstep, voffB); PG8_STAGE(PG8_SA(1, 0), cA + kstep, voffA); PG8_STAGE(PG8_SB(1, 1), cB + hstepB + kstep, voffB);
        PG8_WAIT_V(6); PG8_BAR;
    }
    for (;;) {
        const bool has_next = S.next(ui + 1, nxt);
        const char* nA = has_next ? (const char*)g.A + (size_t)nxt.pm * tstepA : cA; const char* nB = has_next ? (const char*)g.Bt + (size_t)nxt.pn * tstepB : cB;
        for (int t = 0; t < nt; t += 2) {
            const bool last = (t == nt - 2);
            const char* a1 = cA + (size_t)(t + 1) * kstep;
            const char* a2 = last ? nA : cA + (size_t)(t + 2) * kstep; const char* b2 = last ? nB : cB + (size_t)(t + 2) * kstep;
            const char* a3 = a2 + kstep; const char* b3 = b2 + kstep;
            if (last && has_next) S.a_ready(nxt);
            if constexpr (SP2) {
            PG8_LDB(B0, 0, 0); PG8_LDB(B1, 0, 1); PG8_SCHED; PG8_LDA(At, 0, 0); PG8_STAGE(PG8_SA(1, 1), a1 + hstepA, voffA);
            PG8_WAIT_V(8); PG8_WAIT_L(0); PG8_BAR; PG8_MMA(0, 0, At, B0); PG8_MMA(0, 1, At, B1); PG8_BAR; PG8_SCHED;
            PG8_LDA(At, 0, 1); PG8_STAGE(PG8_SB(0, 0), b2, voffB); PG8_STAGE(PG8_SB(0, 1), b2 + hstepB, voffB); PG8_STAGE(PG8_SA(0, 0), a2, voffA);
            PG8_WAIT_V(8); PG8_WAIT_L(0); PG8_BAR; PG8_MMA(1, 0, At, B0); PG8_MMA(1, 1, At, B1); PG8_BAR; PG8_SCHED;
            PG8_LDB(B0, 1, 0); PG8_LDB(B1, 1, 1); PG8_SCHED; PG8_LDA(At, 1, 0); PG8_STAGE(PG8_SA(0, 1), a2 + hstepA, voffA);
            PG8_WAIT_V(8); PG8_WAIT_L(0); PG8_BAR; PG8_MMA(0, 0, At, B0); PG8_MMA(0, 1, At, B1); PG8_BAR; PG8_SCHED;
            PG8_LDA(At, 1, 1); PG8_STAGE(PG8_SB(1, 0), b3, voffB); PG8_STAGE(PG8_SB(1, 1), b3 + hstepB, voffB); PG8_STAGE(PG8_SA(1, 0), a3, voffA);
            PG8_WAIT_V(8); PG8_WAIT_L(0); PG8_BAR; PG8_MMA(1, 0, At, B0); PG8_MMA(1, 1, At, B1); PG8_BAR; PG8_SCHED;
            } else {
            PG8_LDB(B0, 0, 0); PG8_SCHED; PG8_LDA(At, 0, 0); PG8_STAGE(PG8_SA(1, 1), a1 + hstepA, voffA);
            PG8_WAIT_L(8); PG8_BAR; PG8_WAIT_L(0); PG8_MMA(0, 0, At, B0); PG8_BAR; PG8_SCHED;
            PG8_LDB(B1, 0, 1); PG8_STAGE(PG8_SB(0, 0), b2, voffB);
            PG8_BAR; PG8_WAIT_L(0); PG8_MMA(0, 1, At, B1); PG8_BAR;
            PG8_LDA(At, 0, 1); PG8_STAGE(PG8_SA(0, 0), a2, voffA);
            PG8_BAR; PG8_WAIT_L(0); PG8_MMA(1, 0, At, B0); PG8_BAR; PG8_SCHED;
            PG8_STAGE(PG8_SB(0, 1), b2 + hstepB, voffB);
            PG8_WAIT_V(6); PG8_BAR; PG8_MMA(1, 1, At, B1); PG8_BAR;
            PG8_LDB(B0, 1, 0); PG8_SCHED; PG8_LDA(At, 1, 0); PG8_STAGE(PG8_SA(0, 1), a2 + hstepA, voffA);
            PG8_WAIT_L(8); PG8_BAR; PG8_WAIT_L(0); PG8_MMA(0, 0, At, B0); PG8_BAR; PG8_SCHED;
            PG8_LDB(B1, 1, 1); PG8_STAGE(PG8_SB(1, 0), b3, voffB);
            PG8_BAR; PG8_WAIT_L(0); PG8_MMA(0, 1, At, B1); PG8_BAR;
            PG8_LDA(At, 1, 1); PG8_STAGE(PG8_SA(1, 0), a3, voffA);
            PG8_BAR; PG8_WAIT_L(0); PG8_MMA(1, 0, At, B0); PG8_BAR; PG8_SCHED;
            PG8_STAGE(PG8_SB(1, 1), b3 + hstepB, voffB);
            PG8_WAIT_V(6); PG8_BAR; PG8_MMA(1, 1, At, B1); PG8_BAR;
            }
        }
        if constexpr (ALIGN_EPI) { if (wr == 0) PG8_BAR; }
        if constexpr (!Epi::AFTER_DRAIN) { if constexpr (Epi::PREFETCH) E.stash(tid, pf0, pf1); E(acc, cur, wr, wc, fr, fq); S.done(cur); }
        if (!has_next) break;
#pragma unroll
        for (int a = 0; a < 2; ++a)
#pragma unroll
            for (int b = 0; b < 2; ++b)
#pragma unroll
                for (int m = 0; m < 4; ++m)
#pragma unroll
                    for (int n = 0; n < 2; ++n) acc[a][b][m][n] = (f32x4){0.f, 0.f, 0.f, 0.f};
        cur = nxt; cA = nA; cB = nB; ++ui;
        if constexpr (Epi::PREFETCH) E.prefetch(cur, tid, pf0, pf1);
        if constexpr (ALIGN_EPI) { if (wr == 1) PG8_BAR; }
    }
    PG8_WAIT_V(0);
    if constexpr (!ALIGN_EPI) { if (wr == 0) PG8_BAR; }
    PG8_BAR;
    if constexpr (Epi::AFTER_DRAIN) { E.fused(acc, cur, wr, wc, fr, fq, lds, wid, lane); S.done(cur); }
#undef PG8_SA
#undef PG8_SB
#undef PG8_STAGE
#undef PG8_STAGE_
#undef PG8_RS_voffA
#undef PG8_RS_voffB
#undef PG8_B0_voffA
#undef PG8_B0_voffB
#undef PG8_LDA
#undef PG8_LDB
#undef PG8_MMA
#undef PG8_WAIT_V
#undef PG8_WAIT_L
#undef PG8_BAR
#undef PG8_SCHED
}
}


#define GAS __attribute__((address_space(1)))
#define LAS __attribute__((address_space(3)))
typedef unsigned short bf16;
typedef unsigned v4u __attribute__((ext_vector_type(4)));
typedef unsigned v2u __attribute__((ext_vector_type(2)));
typedef float f32x4 __attribute__((ext_vector_type(4)));
typedef float f32x2 __attribute__((ext_vector_type(2)));
typedef short bf16x8 __attribute__((ext_vector_type(8)));
typedef short s16x4 __attribute__((ext_vector_type(4)));
typedef float f32x16 __attribute__((ext_vector_type(16)));
#define LDS_WAIT() asm volatile("s_waitcnt lgkmcnt(0)" ::: "memory")
#define VM_WAIT() asm volatile("s_waitcnt vmcnt(0)" ::: "memory")

constexpr int D = 2048, NB = 16, SEQ = 256, DB = 4, DSEQ = 4096, PAST = 512;
constexpr int MP = NB * SEQ, MS = DB * DSEQ, M = MP + MS;
constexpr int LSEQ = PAST + DSEQ;
constexpr int LKV = MP + DB * LSEQ;
constexpr int DFF = 5632, NFF = 2 * DFF;
constexpr float EPS = 1e-6f;
constexpr float LAM_INIT_1 = 0.35550906758f;
constexpr int NWAVES = 8;

constexpr size_t O_YP = 0, O_YS = (size_t)MP * D, O_SA_CKV = (size_t)M * D, O_SA_KPE = O_SA_CKV + (size_t)NB * 2 * SEQ * 256,
                 O_SB_K = O_SA_KPE + (size_t)NB * 2 * SEQ * 64, O_SB_V = O_SB_K + (size_t)NB * SEQ * 2048, O_SC_K = O_SB_V + (size_t)NB * SEQ * 2048,
                 O_SC_V = O_SC_K + (size_t)NB * SEQ * 512, O_END = O_SC_V + (size_t)NB * SEQ * 512;
static_assert(O_END == 65536000, "out size");

constexpr size_t MiB = 1u << 20;
constexpr size_t WS_CTL = 0, CTL_ZERO_BYTES = 1 * MiB;
constexpr size_t WS_MOD = 1 * MiB;
constexpr size_t WS_MISC = 2 * MiB;
constexpr size_t WS_W_A_DOWN = 3 * MiB, WS_W_A_UQ = 11 * MiB, WS_W_A_UKV = 17 * MiB, WS_W_A_O = 21 * MiB;
constexpr size_t WS_W_B_QKV = 37 * MiB, WS_W_B_O = 61 * MiB, WS_W_C_QKV = 69 * MiB, WS_W_C_O = 81 * MiB;
constexpr size_t WS_W_FIN = 89 * MiB, WS_W_FDN = 265 * MiB;
constexpr size_t WS_H = 353 * MiB, WS_T = 433 * MiB, WS_AO = 513 * MiB, WS_R = 593 * MiB, WS_SLAB = 1256 * MiB, WS_X16 = 1320 * MiB, WS_EDGE = 1400 * MiB, WS_END = 1416 * MiB;
constexpr int MSPLIT = 16384;
constexpr size_t SLAB_ELEMS = (size_t)(M - MSPLIT) * D;
constexpr size_t R_U = 0, R_G = 440 * MiB;
constexpr size_t R_A_D1 = 0, R_A_SSP = 40 * MiB  , R_A_CKVF = 60 * MiB, R_A_KPEF = 72 * MiB, R_A_Q = 76 * MiB, R_A_KV = 196 * MiB;
constexpr size_t R_B_Q = 0, R_B_KF = 240 * MiB, R_B_VF = 328 * MiB, R_B_OC = 416 * MiB;
constexpr size_t R_C_Q = 0, R_C_KF = 120 * MiB, R_C_VF = 142 * MiB;
static_assert(R_G + (size_t)M * DFF * 2 <= WS_SLAB - WS_R && R_A_KV + (size_t)LKV * 4096 * 2 <= WS_SLAB - WS_R && R_B_OC + (size_t)M * 4096 * 2 <= WS_SLAB - WS_R, "scratch overlays");
constexpr int CW_BAR = 4096;

constexpr int RING_BYTES = 131072;
constexpr int LDSCTL_OFF = RING_BYTES, MISC_OFF = LDSCTL_OFF + 320;
constexpr int LDS_BYTES = 147456;
constexpr int EPI_LDS_OFF = RING_BYTES + 1024;
static_assert(EPI_LDS_OFF + 12288 <= LDS_BYTES, "LDS map");

struct Params { const float* in[31]; float* out; unsigned char* ws; };
enum { I_XP = 0, I_XS, I_C, I_CA_CKV, I_CA_KPE, I_CB_K, I_CB_V, I_CC_K, I_CC_V, I_CCTX, I_NORMG, I_WMOD, I_BMOD, I_FWIN, I_FCW, I_FCB, I_FWDN,
       I_AWD, I_AQN, I_AKVN, I_AWUQ, I_AWUKV, I_AWO, I_BWQKV, I_BLAM, I_BSUBLN, I_BWO, I_CWQKV, I_CQN, I_CKN, I_CWO };

__device__ __forceinline__ unsigned f2bf(float f) { unsigned u = __builtin_bit_cast(unsigned, f); return (u + 0x7fffu + ((u >> 16) & 1u)) >> 16; }
__device__ __forceinline__ unsigned pk2(float lo, float hi) { return f2bf(lo) | (f2bf(hi) << 16); }
__device__ __forceinline__ float bf2f(unsigned short b) { return __builtin_bit_cast(float, (unsigned)b << 16); }
__device__ __forceinline__ float bflo(unsigned w) { return __builtin_bit_cast(float, w << 16); }
__device__ __forceinline__ float bfhi(unsigned w) { return __builtin_bit_cast(float, w & 0xffff0000u); }
__device__ __forceinline__ float wave_sum(float v) {
#pragma unroll
    for (int o = 1; o < 64; o <<= 1) v += __shfl_xor(v, o);
    return v;
}

#define XB_TMO      128
#define XB_XCNT(j)  (256  + 64 * (j))
#define XB_XSUB(j)  (1280 + 64 * (j))
#define XB_XGEN(j)  (2304 + 64 * (j))
#define XB_TOP      3328
#define XB_TOPGEN   3392
#define XCD_BAR_WORDS 3456
#define XB_SPIN_CAP (1u << 22)

__device__ __forceinline__ unsigned xb_ld(unsigned* p)              { return __hip_atomic_load(p, __ATOMIC_RELAXED, __HIP_MEMORY_SCOPE_AGENT); }
__device__ __forceinline__ unsigned xb_add(unsigned* p, unsigned v) { return __hip_atomic_fetch_add(p, v, __ATOMIC_RELAXED, __HIP_MEMORY_SCOPE_AGENT); }
__device__ __forceinline__ unsigned xb_xcc_id() { return (unsigned)__builtin_amdgcn_s_getreg((3 << 11) | 20) & 0xFu; }
#define XB_SPIN(cond, bar) do { unsigned _sp = 0; while (cond) { __builtin_amdgcn_s_sleep(1); \
    if ((++_sp & 255u) == 0u) { if (xb_ld(&(bar)[XB_TMO])) break; if (_sp > XB_SPIN_CAP) { atomicAdd(&(bar)[XB_TMO], 1u); break; } } } } while (0)

struct XcdBarrier { unsigned* bar; unsigned x; volatile LAS unsigned* st; };

__device__ __forceinline__ XcdBarrier xcd_barrier_post(unsigned* bar, volatile LAS unsigned* st) {
    XcdBarrier b; b.bar = bar; b.x = xb_xcc_id(); b.st = st;
    if (threadIdx.x == 0) (void)xb_add(&bar[XB_XCNT(b.x)], 1u);
    return b;
}
__device__ __forceinline__ void xcd_barrier_complete(unsigned* bar, unsigned x, unsigned& nloc, unsigned& nx) {
    const unsigned G = gridDim.x * gridDim.y * gridDim.z;
    unsigned sum, cnt, mine, sp = 0u;
    for (;;) {
        sum = 0u; cnt = 0u; mine = 0u;
#pragma unroll
        for (unsigned j = 0; j < 16; ++j) { const unsigned c = xb_ld(&bar[XB_XCNT(j)]); sum += c; cnt += (c > 0u) ? 1u : 0u; mine = (j == x) ? c : mine; }
        if (sum == G) break;
        __builtin_amdgcn_s_sleep(1);
        if ((++sp & 255u) == 0u) { if (xb_ld(&bar[XB_TMO])) break; if (sp > XB_SPIN_CAP) { atomicAdd(&bar[XB_TMO], 1u); break; } }
    }
    nloc = mine > 0u ? mine : 1u; nx = cnt > 0u ? cnt : 1u;
}
__device__ __forceinline__ void xcd_barrier(const XcdBarrier& b) {
    asm volatile("s_waitcnt vmcnt(0)" ::: "memory");
    __syncthreads();
    if (threadIdx.x == 0) {
        unsigned* bar = b.bar;
        __builtin_amdgcn_s_waitcnt(0);
        unsigned nloc = b.st[0], nx = b.st[1];
        if (nloc == 0u) { xcd_barrier_complete(bar, b.x, nloc, nx); b.st[0] = nloc; b.st[1] = nx; }
        const unsigned old = xb_add(&bar[XB_XSUB(b.x)], 1u);
        const unsigned gen = old / nloc;
        if (old + 1u == (gen + 1u) * nloc) {
            __builtin_amdgcn_fence(__ATOMIC_RELEASE, "agent");
            asm volatile("s_waitcnt vmcnt(0)" ::: "memory");
            const unsigned og = xb_add(&bar[XB_TOP], 1u);
            const unsigned tg = og / nx;
            if (og + 1u == (tg + 1u) * nx) xb_add(&bar[XB_TOPGEN], 1u);
            else XB_SPIN(xb_ld(&bar[XB_TOPGEN]) == tg, bar);
            __builtin_amdgcn_fence(__ATOMIC_ACQUIRE, "agent");
            xb_add(&bar[XB_XGEN(b.x)], 1u);
            asm volatile("s_waitcnt vmcnt(0)" ::: "memory");
        } else {
            XB_SPIN(xb_ld(&bar[XB_XGEN(b.x)]) == gen, bar);
            __builtin_amdgcn_fence(__ATOMIC_ACQUIRE, "agent");
            asm volatile("s_waitcnt vmcnt(0)" ::: "memory");
        }
    }
    __syncthreads();
}

struct Frame {
    unsigned char* lds;
    LAS unsigned char* ldsl;
    int tid, lane, wave, vcu, G, gw, NGW;
};
__device__ __forceinline__ Frame make_frame(unsigned char* lds) {
    Frame F; F.lds = lds; F.ldsl = (LAS unsigned char*)lds;
    int t = threadIdx.x; asm volatile("" : "+v"(t));
    F.tid = t; F.lane = t & 63; F.wave = __builtin_amdgcn_readfirstlane(t >> 6);
    int bx = blockIdx.x; asm volatile("" : "+s"(bx));
    F.G = gridDim.x; F.vcu = (F.G % 8 == 0) ? (bx % 8) * (F.G / 8) + bx / 8 : bx;
    F.gw = F.vcu * NWAVES + F.wave; F.NGW = F.G * NWAVES;
    return F;
}

__device__ __forceinline__ int wrow_perm(int n, int mode) {
    if (mode == 1) { if (n >= 2560) return n; const int h = n >> 7, d = n & 127; const int wc = 2 * (d >> 6) + ((d >> 4) & 1), nn = (d >> 5) & 1; return (h << 7) + 32 * wc + 16 * nn + (d & 15); }
    if (mode == 2) { const int isval = n >= DFF ? 1 : 0, c = n - isval * DFF; return (c >> 7) * 256 + isval * 128 + (c & 127); }
    return n;
}
__device__ __forceinline__ void p0_transpose_item(const float* __restrict__ W, int K, int N, bf16* __restrict__ WT, LAS float* scr, int item, int lane, int mode, const float* kscale) {
    const int nblk = N / 32, kb = item / nblk, nb = item % nblk, k0 = 64 * kb, n0 = 32 * nb;
    { float tv[32]; const float* wp = W + (size_t)(k0 + (lane >> 5)) * N + n0 + (lane & 31);
#pragma unroll
      for (int i = 0; i < 32; ++i) tv[i] = wp[(size_t)(2 * i) * N];
#pragma unroll
      for (int i = 0; i < 32; ++i) scr[(2 * i + (lane >> 5)) * 33 + (lane & 31)] = tv[i]; }
    LDS_WAIT(); asm volatile("" ::: "memory");
    const int c = lane & 7;
    float ks[8] = {1.f, 1.f, 1.f, 1.f, 1.f, 1.f, 1.f, 1.f};
    if (kscale) {
#pragma unroll
        for (int q = 0; q < 8; ++q) ks[q] = kscale[k0 + 8 * c + q]; }
#pragma unroll
    for (int j = 0; j < 4; ++j) { const int n = (lane >> 3) + 8 * j; const LAS float* s = scr + (8 * c) * 33 + n;
        v4u o; o.x = pk2(s[0 * 33] * ks[0], s[1 * 33] * ks[1]); o.y = pk2(s[2 * 33] * ks[2], s[3 * 33] * ks[3]); o.z = pk2(s[4 * 33] * ks[4], s[5 * 33] * ks[5]); o.w = pk2(s[6 * 33] * ks[6], s[7 * 33] * ks[7]);
        *(v4u*)(WT + (size_t)wrow_perm(n0 + n, mode) * K + k0 + 8 * c) = o; }
    LDS_WAIT(); asm volatile("" ::: "memory");
}

__device__ __forceinline__ float silu_f(float x) { return x / (1.0f + __expf(-x)); }

__device__ __forceinline__ void p0_prologue(const Params& P, unsigned char* ldsp) {
    const Frame F = make_frame(ldsp);
    unsigned char* ws = P.ws;
    {
        LAS float* scr = (LAS float*)(F.ldsl + F.wave * 16384);
        constexpr int IT_AWD = (2048 / 64) * (832 / 32), IT_AWUQ = (512 / 64) * (3072 / 32), IT_AWUKV = (256 / 64) * (4096 / 32), IT_WO = (2048 / 64) * (2048 / 32);
        constexpr int IT_BQKV = (2048 / 64) * (6144 / 32), IT_CQKV = (2048 / 64) * (3072 / 32), IT_FIN = (2048 / 64) * (NFF / 32), IT_FDN = (DFF / 64) * (2048 / 32);
        constexpr int NITEMS = 2 * (IT_AWD + IT_AWUQ + IT_AWUKV + IT_WO) + IT_BQKV + IT_WO + IT_CQKV + IT_WO + 4 * IT_FIN + 4 * IT_FDN;
        for (int it = F.gw; it < NITEMS; it += F.NGW) {
            int r = it; const float* W; bf16* WT; int K, N, mode = 0; const float* kscale = nullptr;
            if (r < 4 * IT_FIN) { const int l = r / IT_FIN; r -= l * IT_FIN; W = P.in[I_FWIN] + (size_t)l * 2048 * NFF; WT = (bf16*)(ws + WS_W_FIN + (size_t)l * 44 * MiB); K = 2048; N = NFF; mode = 2; }
            else if ((r -= 4 * IT_FIN) < 4 * IT_FDN) { const int l = r / IT_FDN; r -= l * IT_FDN; W = P.in[I_FWDN] + (size_t)l * DFF * 2048; WT = (bf16*)(ws + WS_W_FDN + (size_t)l * 22 * MiB); K = DFF; N = 2048; }
            else if ((r -= 4 * IT_FDN) < IT_BQKV) { W = P.in[I_BWQKV]; WT = (bf16*)(ws + WS_W_B_QKV); K = 2048; N = 6144; }
            else if ((r -= IT_BQKV) < IT_CQKV) { W = P.in[I_CWQKV]; WT = (bf16*)(ws + WS_W_C_QKV); K = 2048; N = 3072; mode = 1; }
            else if ((r -= IT_CQKV) < IT_WO) { W = P.in[I_BWO]; WT = (bf16*)(ws + WS_W_B_O); K = 2048; N = 2048; }
            else if ((r -= IT_WO) < IT_WO) { W = P.in[I_CWO]; WT = (bf16*)(ws + WS_W_C_O); K = 2048; N = 2048; }
            else if ((r -= IT_WO) < 2 * IT_WO) { const int j = r / IT_WO; r -= j * IT_WO; W = P.in[I_AWO] + (size_t)j * 2048 * 2048; WT = (bf16*)(ws + WS_W_A_O + (size_t)j * 8 * MiB); K = 2048; N = 2048; }
            else if ((r -= 2 * IT_WO) < 2 * IT_AWD) { const int j = r / IT_AWD; r -= j * IT_AWD; W = P.in[I_AWD] + (size_t)j * 2048 * 832; WT = (bf16*)(ws + WS_W_A_DOWN + (size_t)j * 4 * MiB); K = 2048; N = 832; }
            else if ((r -= 2 * IT_AWD) < 2 * IT_AWUQ) { const int j = r / IT_AWUQ; r -= j * IT_AWUQ; W = P.in[I_AWUQ] + (size_t)j * 512 * 3072; WT = (bf16*)(ws + WS_W_A_UQ + (size_t)j * 3 * MiB); K = 512; N = 3072; kscale = P.in[I_AQN] + j * 512; }
            else { r -= 2 * IT_AWUQ; const int j = r / IT_AWUKV; r -= j * IT_AWUKV; W = P.in[I_AWUKV] + (size_t)j * 256 * 4096; WT = (bf16*)(ws + WS_W_A_UKV + (size_t)j * 2 * MiB); K = 256; N = 4096; }
            p0_transpose_item(W, K, N, WT, scr, r, F.lane, mode, kscale);
        }
    }
    {
        const size_t n16 = (size_t)(1024 - 832) * 2048 * 2 / 16;
        for (size_t i = (size_t)F.gw * 64 + F.lane; i < 2 * n16; i += (size_t)F.NGW * 64) { const size_t j = i / n16, o = i % n16;
            *(v4u*)(ws + WS_W_A_DOWN + j * 4 * MiB + (size_t)832 * 2048 * 2 + o * 16) = (v4u){0u, 0u, 0u, 0u}; }
    }
    {
        float* misc = (float*)(ws + WS_MISC);
        const int e = F.gw * 64 + F.lane;
        if (e < 1024 + 2048) {
            const bool t16 = e < 1024; const int ee = t16 ? e : e - 1024; const int half = t16 ? 16 : 32; const int pos = ee / half, i = ee % half;
            const float fr = exp2f(-(float)i / (float)half * 13.287712379549449f);
            const float ang = (float)pos * fr;
            const double a = (double)ang;
            float* dst = misc + (t16 ? 256 : 4096) + 2 * ee;
            dst[0] = (float)cos(a); dst[1] = (float)sin(a);
        }
        if (F.gw == F.NGW - 1) {
            const float* lv = P.in[I_BLAM];
            const float s0 = wave_sum(lv[F.lane] * lv[64 + F.lane]), s1 = wave_sum(lv[128 + F.lane] * lv[192 + F.lane]);
            if (F.lane == 0) misc[0] = expf(s0) - expf(s1) + LAM_INIT_1;
        }
    }
    {
        LAS float* sl = (LAS float*)F.ldsl;
        LAS float* red = sl + 5 * 2048;
        __syncthreads();
        for (int i = F.tid; i < 5 * 2048; i += 512) { const float x = i < 2048 ? P.in[I_CCTX][i] : P.in[I_C][i - 2048]; sl[i] = silu_f(x); }
        __syncthreads();
        float* MOD = (float*)(ws + WS_MOD);
        for (int u = F.vcu; u < 4 * 96; u += F.G) {
            const int l = u / 96, n0 = (u % 96) * 128;
            const float* wm = P.in[I_WMOD] + (size_t)l * 2048 * 12288 + n0 + 2 * F.lane;
            float a0[5] = {0.f, 0.f, 0.f, 0.f, 0.f}, a1[5] = {0.f, 0.f, 0.f, 0.f, 0.f};
            const int k0 = F.wave * 256;
#pragma unroll 8
            for (int k = k0; k < k0 + 256; ++k) { const f32x2 w = *(const f32x2*)(wm + (size_t)k * 12288);
#pragma unroll
                for (int j = 0; j < 5; ++j) { const float s = sl[j * 2048 + k]; a0[j] += s * w.x; a1[j] += s * w.y; } }
#pragma unroll
            for (int j = 0; j < 5; ++j) { red[(F.wave * 5 + j) * 128 + 2 * F.lane] = a0[j]; red[(F.wave * 5 + j) * 128 + 2 * F.lane + 1] = a1[j]; }
            __syncthreads();
            for (int o = F.tid; o < 5 * 128; o += 512) { const int j = o / 128, n = o % 128; float s = 0.f;
#pragma unroll
                for (int w = 0; w < 8; ++w) s += red[(w * 5 + j) * 128 + n];
                MOD[((size_t)l * 5 + j) * 12288 + n0 + n] = s + P.in[I_BMOD][(size_t)l * 12288 + n0 + n]; }
            __syncthreads();
        }
    }
}

__device__ __forceinline__ int mod_index(int m) { return m < MP ? 0 : 1 + ((m - MP) >> 12); }

template <bool RES, bool NORM, bool XIN, bool XOUT32>
__device__ __forceinline__ void rn_process(int m, int lane, const f32x4 (&xa)[8], const v4u (&xh)[4], const v4u (&ta)[4], const bf16* slab, bf16* X16, float* Xout, const float* ga, const float* gt, const float* gb, const float* sh, const float* sc, bf16* H) {
    float x[4][8];
#pragma unroll
    for (int jj = 0; jj < 4; ++jj) {
        if constexpr (XIN) { const f32x4 a = xa[2 * jj], b = xa[2 * jj + 1];
            x[jj][0] = a.x; x[jj][1] = a.y; x[jj][2] = a.z; x[jj][3] = a.w; x[jj][4] = b.x; x[jj][5] = b.y; x[jj][6] = b.z; x[jj][7] = b.w; }
        else { const v4u w = xh[jj];
            x[jj][0] = bflo(w.x); x[jj][1] = bfhi(w.x); x[jj][2] = bflo(w.y); x[jj][3] = bfhi(w.y); x[jj][4] = bflo(w.z); x[jj][5] = bfhi(w.z); x[jj][6] = bflo(w.w); x[jj][7] = bfhi(w.w); } }
    if constexpr (RES) {
        float t[4][8]; float ss = 0.f;
        if (m >= MSPLIT) {
            const bf16* s0 = slab + (size_t)(m - MSPLIT) * D; const bf16* s1 = s0 + SLAB_ELEMS;
#pragma unroll
            for (int jj = 0; jj < 4; ++jj) { const int c = 8 * (64 * jj + lane); const v4u a = *(const v4u*)(s0 + c), b = *(const v4u*)(s1 + c);
                t[jj][0] = bflo(a.x) + bflo(b.x); t[jj][1] = bfhi(a.x) + bfhi(b.x); t[jj][2] = bflo(a.y) + bflo(b.y); t[jj][3] = bfhi(a.y) + bfhi(b.y);
                t[jj][4] = bflo(a.z) + bflo(b.z); t[jj][5] = bfhi(a.z) + bfhi(b.z); t[jj][6] = bflo(a.w) + bflo(b.w); t[jj][7] = bfhi(a.w) + bfhi(b.w); }
        } else {
#pragma unroll
            for (int jj = 0; jj < 4; ++jj) { const v4u w = ta[jj];
                t[jj][0] = bflo(w.x); t[jj][1] = bfhi(w.x); t[jj][2] = bflo(w.y); t[jj][3] = bfhi(w.y); t[jj][4] = bflo(w.z); t[jj][5] = bfhi(w.z); t[jj][6] = bflo(w.w); t[jj][7] = bfhi(w.w); }
        }
#pragma unroll
        for (int jj = 0; jj < 4; ++jj)
#pragma unroll
            for (int e = 0; e < 8; ++e) ss += t[jj][e] * t[jj][e];
        const float rstd = rsqrtf(wave_sum(ss) * (1.0f / D) + EPS);
#pragma unroll
        for (int jj = 0; jj < 4; ++jj) { const int c = 8 * (64 * jj + lane);
            const f32x4 g0 = *(const f32x4*)(ga + c), g1 = *(const f32x4*)(ga + c + 4), q0 = *(const f32x4*)(gt + c), q1 = *(const f32x4*)(gt + c + 4);
            const float gg[8] = {g0.x, g0.y, g0.z, g0.w, g1.x, g1.y, g1.z, g1.w}, qq[8] = {q0.x, q0.y, q0.z, q0.w, q1.x, q1.y, q1.z, q1.w};
#pragma unroll
            for (int e = 0; e < 8; ++e) x[jj][e] += qq[e] * (t[jj][e] * rstd * gg[e]);
            if constexpr (XOUT32) { float* xr = Xout + (size_t)m * D; *(f32x4*)(xr + c) = (f32x4){x[jj][0], x[jj][1], x[jj][2], x[jj][3]}; *(f32x4*)(xr + c + 4) = (f32x4){x[jj][4], x[jj][5], x[jj][6], x[jj][7]}; }
            else { v4u o; o.x = pk2(x[jj][0], x[jj][1]); o.y = pk2(x[jj][2], x[jj][3]); o.z = pk2(x[jj][4], x[jj][5]); o.w = pk2(x[jj][6], x[jj][7]); *(v4u*)(X16 + (size_t)m * D + c) = o;
                if constexpr (NORM) {
#pragma unroll
                    for (int e = 0; e < 8; e += 2) { const unsigned w = e == 0 ? o.x : (e == 2 ? o.y : (e == 4 ? o.z : o.w)); x[jj][e] = bflo(w); x[jj][e + 1] = bfhi(w); } } }
        }
    }
    if constexpr (NORM) {
        float ss = 0.f;
#pragma unroll
        for (int jj = 0; jj < 4; ++jj)
#pragma unroll
            for (int e = 0; e < 8; ++e) ss += x[jj][e] * x[jj][e];
        const float rstd = rsqrtf(wave_sum(ss) * (1.0f / D) + EPS);
#pragma unroll
        for (int jj = 0; jj < 4; ++jj) { const int c = 8 * (64 * jj + lane);
            const f32x4 g0 = *(const f32x4*)(gb + c), g1 = *(const f32x4*)(gb + c + 4), h0 = *(const f32x4*)(sh + c), h1 = *(const f32x4*)(sh + c + 4), s0 = *(const f32x4*)(sc + c), s1 = *(const f32x4*)(sc + c + 4);
            const float gg[8] = {g0.x, g0.y, g0.z, g0.w, g1.x, g1.y, g1.z, g1.w}, hh[8] = {h0.x, h0.y, h0.z, h0.w, h1.x, h1.y, h1.z, h1.w}, cc[8] = {s0.x, s0.y, s0.z, s0.w, s1.x, s1.y, s1.z, s1.w};
            float y[8];
#pragma unroll
            for (int e = 0; e < 8; ++e) y[e] = (x[jj][e] * rstd * gg[e]) * (1.0f + cc[e]) + hh[e];
            v4u o; o.x = pk2(y[0], y[1]); o.y = pk2(y[2], y[3]); o.z = pk2(y[4], y[5]); o.w = pk2(y[6], y[7]);
            *(v4u*)(H + (size_t)m * D + c) = o; }
    }
}
template <bool RES, bool NORM, bool XIN, bool XOUT32>
__device__ __forceinline__ void resnorm_phase(const Params& P, unsigned char* ldsp, const bf16* T, const float* ga, const float* modv  , int gate_idx,
                                              const float* gb, const float* modn  , int shift_idx, int scale_idx, bf16* H) {
    const Frame F = make_frame(ldsp);
    const float* xin_p = P.in[I_XP]; const float* xin_s = P.in[I_XS]; bf16* X16 = (bf16*)(P.ws + WS_X16);
#define RN_LOAD(m_, XA, XH, TA) do { \
        if constexpr (XIN) { const float* xs_ = (m_) < MP ? xin_p + (size_t)(m_) * D : xin_s + (size_t)((m_) - MP) * D; \
            _Pragma("unroll") for (int jj = 0; jj < 4; ++jj) { const int c = 8 * (64 * jj + F.lane); XA[2 * jj] = *(const f32x4*)(xs_ + c); XA[2 * jj + 1] = *(const f32x4*)(xs_ + c + 4); } } \
        else { _Pragma("unroll") for (int jj = 0; jj < 4; ++jj) XH[jj] = *(const v4u*)(X16 + (size_t)(m_) * D + 8 * (64 * jj + F.lane)); } \
        if constexpr (RES) { if ((m_) < MSPLIT) { _Pragma("unroll") for (int jj = 0; jj < 4; ++jj) TA[jj] = *(const v4u*)(T + (size_t)(m_) * D + 8 * (64 * jj + F.lane)); } } } while (0)
#define RN_PROC(m_, XA, XH, TA) do { const int mi_ = mod_index(m_); \
        rn_process<RES, NORM, XIN, XOUT32>((m_), F.lane, XA, XH, TA, (const bf16*)(P.ws + WS_SLAB), X16, P.out, ga, RES ? modv + (size_t)mi_ * 12288 + (size_t)gate_idx * D : nullptr, gb, \
                              NORM ? modn + (size_t)mi_ * 12288 + (size_t)shift_idx * D : nullptr, NORM ? modn + (size_t)mi_ * 12288 + (size_t)scale_idx * D : nullptr, H); } while (0)
    f32x4 xa[8] = {}, xb[8] = {}; v4u xha[4] = {}, xhb[4] = {}, xhc[4] = {}, ta[4] = {}, tb[4] = {}, tc[4] = {};
    int m = F.gw; if (m >= M) return;
    const int S = F.NGW;
    if constexpr (XIN) {
        RN_LOAD(m, xa, xha, ta);
        for (;;) {
            if (m + S < M) RN_LOAD(m + S, xb, xhb, tb);
            RN_PROC(m, xa, xha, ta); m += S; if (m >= M) break;
            if (m + S < M) RN_LOAD(m + S, xa, xha, ta);
            RN_PROC(m, xb, xhb, tb); m += S; if (m >= M) break;
        }
    } else {
        RN_LOAD(m, xa, xha, ta); if (m + S < M) RN_LOAD(m + S, xa, xhb, tb);
        for (;;) {
            if (m + 2 * S < M) RN_LOAD(m + 2 * S, xa, xhc, tc);
            RN_PROC(m, xa, xha, ta); m += S; if (m >= M) break;
            if (m + 2 * S < M) RN_LOAD(m + 2 * S, xa, xha, ta);
            RN_PROC(m, xa, xhb, tb); m += S; if (m >= M) break;
            if (m + 2 * S < M) RN_LOAD(m + 2 * S, xa, xhb, tb);
            RN_PROC(m, xa, xhc, tc); m += S; if (m >= M) break;
        }
    }
#undef RN_LOAD
#undef RN_PROC
}

__device__ __forceinline__ float rope64(float v, int lane, int trow, int tcol, const f32x2* T16) {
    const int g = lane >> 5, w = lane & 31, i = w & 15;
    const float other = __shfl_xor(v, 16);
    const f32x2 cs = T16[(g ? tcol : trow) * 16 + i];
    return (w < 16) ? v * cs.x - other * cs.y : other * cs.y + v * cs.x;
}
__device__ __forceinline__ float rope_h64(float v, int lane, int pos, const f32x2* T32) {
    const int i = lane & 31;
    const float other = __shfl_xor(v, 32);
    const f32x2 cs = T32[pos * 32 + i];
    return (lane < 32) ? v * cs.x - other * cs.y : other * cs.y + v * cs.x;
}
__device__ __forceinline__ int key_row(int m) { return m < MP ? m : MP + ((m - MP) >> 12) * LSEQ + PAST + ((m - MP) & 4095); }

__device__ __forceinline__ void mla_cache_rows(const Params& P, unsigned char* ldsp, int j) {
    const Frame F = make_frame(ldsp);
    unsigned char* R = P.ws + WS_R; bf16* CKVF = (bf16*)(R + R_A_CKVF); bf16* KPEF = (bf16*)(R + R_A_KPEF);
    for (int r = F.gw; r < DB * PAST; r += F.NGW) {
        const int mb = r >> 9, p = r & 511; const int kr = MP + mb * LSEQ + p;
        const f32x4 c = *(const f32x4*)(P.in[I_CA_CKV] + ((size_t)(mb * 2 + j) * PAST + p) * 256 + 4 * F.lane);
        v2u o; o.x = pk2(c.x, c.y); o.y = pk2(c.z, c.w);
        *(v2u*)(CKVF + (size_t)kr * 256 + 4 * F.lane) = o;
        KPEF[(size_t)kr * 64 + F.lane] = (bf16)f2bf(P.in[I_CA_KPE][((size_t)(mb * 2 + j) * PAST + p) * 64 + F.lane]);
    }
}
__device__ __forceinline__ void diff_cache_rows(const Params& P, unsigned char* ldsp) {
    const Frame F = make_frame(ldsp);
    unsigned char* R = P.ws + WS_R; bf16* KF = (bf16*)(R + R_B_KF); bf16* VF = (bf16*)(R + R_B_VF);
    for (int r = F.gw; r < DB * PAST; r += F.NGW) {
        const int mb = r >> 9, p = r & 511; const int kr = MP + mb * LSEQ + p;
        const float* ck = P.in[I_CB_K] + (size_t)r * 2048; const float* cv = P.in[I_CB_V] + (size_t)r * 2048;
#pragma unroll
        for (int jj = 0; jj < 4; ++jj) { const int c = 8 * (64 * jj + F.lane);
            const f32x4 a = *(const f32x4*)(ck + c), b = *(const f32x4*)(ck + c + 4), e = *(const f32x4*)(cv + c), f = *(const f32x4*)(cv + c + 4);
            v4u o; o.x = pk2(a.x, a.y); o.y = pk2(a.z, a.w); o.z = pk2(b.x, b.y); o.w = pk2(b.z, b.w); *(v4u*)(KF + (size_t)kr * 2048 + c) = o;
            v4u q; q.x = pk2(e.x, e.y); q.y = pk2(e.z, e.w); q.z = pk2(f.x, f.y); q.w = pk2(f.z, f.w); *(v4u*)(VF + (size_t)kr * 2048 + c) = q; }
    }
}
__device__ __forceinline__ void diff_combine_phase(const Params& P, unsigned char* ldsp) {
    const Frame F = make_frame(ldsp);
    const bf16* OC = (const bf16*)(P.ws + WS_R + R_B_OC); bf16* AO = (bf16*)(P.ws + WS_AO);
    const float lam = ((const float*)(P.ws + WS_MISC))[0];
    const f32x2 sg = *(const f32x2*)(P.in[I_BSUBLN] + 2 * F.lane);
    for (int m = F.gw; m < M; m += F.NGW) {
        const unsigned* oc = (const unsigned*)(OC + (size_t)m * 4096) + F.lane; unsigned* ao = (unsigned*)(AO + (size_t)m * 2048) + F.lane;
#pragma unroll 4
        for (int h = 0; h < 16; ++h) { const unsigned w0 = oc[h * 128], w1 = oc[h * 128 + 64];
            const float a = bflo(w0) - lam * bflo(w1), b = bfhi(w0) - lam * bfhi(w1);
            const float rstd = rsqrtf(wave_sum(a * a + b * b) * (1.0f / 128.0f) + EPS) * (1.0f - LAM_INIT_1);
            ao[h * 64] = pk2(a * rstd * sg.x, b * rstd * sg.y); }
    }
}

__device__ __forceinline__ void gqa_cache_rows(const Params& P, unsigned char* ldsp) {
    const Frame F = make_frame(ldsp);
    unsigned char* R = P.ws + WS_R; bf16* KF = (bf16*)(R + R_C_KF); bf16* VF = (bf16*)(R + R_C_VF);
    for (int r = F.gw; r < DB * PAST; r += F.NGW) {
        const int mb = r >> 9, p = r & 511; const int kr = MP + mb * LSEQ + p;
        const float* ck = P.in[I_CC_K] + (size_t)r * 512 + 8 * F.lane; const float* cv = P.in[I_CC_V] + (size_t)r * 512 + 8 * F.lane;
        const f32x4 a = *(const f32x4*)ck, b = *(const f32x4*)(ck + 4), e = *(const f32x4*)cv, f = *(const f32x4*)(cv + 4);
        v4u o; o.x = pk2(a.x, a.y); o.y = pk2(a.z, a.w); o.z = pk2(b.x, b.y); o.w = pk2(b.z, b.w); *(v4u*)(KF + (size_t)kr * 512 + 8 * F.lane) = o;
        v4u q; q.x = pk2(e.x, e.y); q.y = pk2(e.z, e.w); q.z = pk2(f.x, f.y); q.w = pk2(f.z, f.w); *(v4u*)(VF + (size_t)kr * 512 + 8 * F.lane) = q;
    }
}

__device__ __forceinline__ v2u pack4(const f32x4 v) { v2u w; w.x = pg8::cvt_pk_bf16(v[0], v[1]); w.y = pg8::cvt_pk_bf16(v[2], v[3]); return w; }
__device__ __forceinline__ void rot4(f32x4& v0, f32x4& v1, const f32x4 cs01, const f32x4 cs23) {
    const f32x4 c = {cs01.x, cs01.z, cs23.x, cs23.z}, s = {cs01.y, cs01.w, cs23.y, cs23.w};
    const f32x4 a = v0 * c - v1 * s, b = v0 * s + v1 * c; v0 = a; v1 = b;
}
struct EpiMlaDown {
    static constexpr bool PERM = false, AFTER_DRAIN = false, PREFETCH = false, AROWPERM = false;
    bf16* D1; float* SSP; bf16* CKVF; bf16* KPEF; float* SCKV; float* SKPE; const float* kvn; const float* T16; LAS float* Pl; int j;
    __device__ __forceinline__ void operator()(const pg8::f32x4 (&acc)[2][2][4][2], const pg8::Unit& u, int wr, int wc, int fr_, int fq_) const {
        int fr = fr_, fq = fq_; asm volatile("" : "+v"(fr), "+v"(fq));
        const bool smp = u.pm >= MP / 256;
        if (u.pn < 2) {
#pragma unroll
            for (int ai = 0; ai < 2; ++ai)
#pragma unroll
                for (int m = 0; m < 4; ++m) { const int row = u.pm * 256 + ai * 128 + wr * 64 + m * 16 + fr; float ss = 0.f;
#pragma unroll
                    for (int bj = 0; bj < 2; ++bj) { const f32x4 a = acc[ai][bj][m][0], b = acc[ai][bj][m][1];
                        ss += ((a.x * a.x + a.y * a.y) + (a.z * a.z + a.w * a.w)) + ((b.x * b.x + b.y * b.y) + (b.z * b.z + b.w * b.w));
                        bf16* dst = D1 + (size_t)row * 1024 + u.pn * 256 + bj * 128 + wc * 32 + 4 * fq; *(v2u*)dst = pack4(a); *(v2u*)(dst + 16) = pack4(b); }
                    ss += __shfl_xor(ss, 16); ss += __shfl_xor(ss, 32);
                    if (fq == 0) SSP[(size_t)(u.pn * 4 + wc) * M + row] = ss; }
        } else if (u.pn == 2) {
#pragma unroll
            for (int ai = 0; ai < 2; ++ai)
#pragma unroll
                for (int m = 0; m < 4; ++m) { float ss = 0.f;
#pragma unroll
                    for (int bj = 0; bj < 2; ++bj) { const f32x4 a = acc[ai][bj][m][0], b = acc[ai][bj][m][1];
                        ss += ((a.x * a.x + a.y * a.y) + (a.z * a.z + a.w * a.w)) + ((b.x * b.x + b.y * b.y) + (b.z * b.z + b.w * b.w)); }
                    ss += __shfl_xor(ss, 16); ss += __shfl_xor(ss, 32);
                    if (fq == 0) Pl[(ai * 128 + wr * 64 + m * 16 + fr) * 4 + wc] = ss; }
            asm volatile("s_waitcnt lgkmcnt(0)" ::: "memory"); __builtin_amdgcn_s_barrier(); asm volatile("" ::: "memory");
#pragma unroll
            for (int ai = 0; ai < 2; ++ai)
#pragma unroll
                for (int m = 0; m < 4; ++m) { const int rl = ai * 128 + wr * 64 + m * 16 + fr, row = u.pm * 256 + rl; const int t = (row - MP) & 4095;
                    const int kr = smp ? MP + ((row - MP) >> 12) * LSEQ + PAST + t : row;
                    const f32x4 pp = *(const LAS f32x4*)(Pl + rl * 4); const float rstd = rsqrtf(((pp.x + pp.y) + (pp.z + pp.w)) * (1.0f / 256.0f) + EPS);
#pragma unroll
                    for (int bj = 0; bj < 2; ++bj) { const int c = bj * 128 + wc * 32 + 4 * fq;
                        const f32x4 y0 = acc[ai][bj][m][0] * rstd * *(const f32x4*)(kvn + c), y1 = acc[ai][bj][m][1] * rstd * *(const f32x4*)(kvn + c + 16);
                        bf16* dst = CKVF + (size_t)kr * 256 + c; *(v2u*)dst = pack4(y0); *(v2u*)(dst + 16) = pack4(y1);
                        if (!smp) { float* s = SCKV + ((size_t)((row >> 8) * 2 + j) * SEQ + (row & 255)) * 256 + c; *(f32x4*)s = y0; *(f32x4*)(s + 16) = y1; } } }
        } else if (wc < 2) {
#pragma unroll
            for (int ai = 0; ai < 2; ++ai)
#pragma unroll
                for (int m = 0; m < 4; ++m) { const int row = u.pm * 256 + ai * 128 + wr * 64 + m * 16 + fr; const int t = (row - MP) & 4095;
                    const int kr = smp ? MP + ((row - MP) >> 12) * LSEQ + PAST + t : row; const int c = wc * 32 + 4 * fq;
                    f32x4 v0 = acc[ai][0][m][0], v1 = acc[ai][0][m][1];
                    if (smp) { const int pos = wc ? (t & 63) : (t >> 6); const float* tp = T16 + (pos * 16 + 4 * fq) * 2; rot4(v0, v1, *(const f32x4*)tp, *(const f32x4*)(tp + 4)); }
                    else { float* s = SKPE + ((size_t)((row >> 8) * 2 + j) * SEQ + (row & 255)) * 64 + c; *(f32x4*)s = v0; *(f32x4*)(s + 16) = v1; }
                    bf16* dst = KPEF + (size_t)kr * 64 + c; *(v2u*)dst = pack4(v0); *(v2u*)(dst + 16) = pack4(v1); }
        }
    }
};
struct EpiMlaQ {
    static constexpr bool PERM = false, AFTER_DRAIN = false, PREFETCH = false, AROWPERM = false;
    bf16* Q; const float* T16; const float* SSP; LAS float* RSL;
    __device__ __forceinline__ void operator()(const pg8::f32x4 (&acc)[2][2][4][2], const pg8::Unit& u, int wr, int wc, int fr, int fq) const {
        const bool smp = u.pm >= MP / 256;
        { const int tid = (wr * 4 + wc) * 64 + fq * 16 + fr;
          if (tid < 256) { const int row = u.pm * 256 + tid; float s = 0.f;
#pragma unroll
              for (int q = 0; q < 8; ++q) s += SSP[(size_t)q * M + row];
              RSL[tid] = rsqrtf(s * (1.0f / 512.0f) + EPS); }
          asm volatile("s_waitcnt lgkmcnt(0)" ::: "memory"); __builtin_amdgcn_s_barrier(); asm volatile("" ::: "memory"); }
#pragma unroll
        for (int ai = 0; ai < 2; ++ai)
#pragma unroll
            for (int m = 0; m < 4; ++m) {
                const int rl = ai * 128 + wr * 64 + m * 16 + fr, row = u.pm * 256 + rl; const int t = (row - MP) & 4095;
                const float rs = RSL[rl];
#pragma unroll
                for (int bj = 0; bj < 2; ++bj) {
                    const int colb = u.pn * 256 + bj * 128 + wc * 32; const int g6 = (colb >> 5) % 6;
                    f32x4 v0 = acc[ai][bj][m][0] * rs, v1 = acc[ai][bj][m][1] * rs;
                    if (smp && g6 >= 4) { const int pos = g6 == 4 ? (t >> 6) : (t & 63); const float* tp = T16 + (pos * 16 + 4 * fq) * 2; rot4(v0, v1, *(const f32x4*)tp, *(const f32x4*)(tp + 4)); }
                    bf16* dst = Q + (size_t)row * 3072 + colb + 4 * fq;
                    *(v2u*)dst = pack4(v0); *(v2u*)(dst + 16) = pack4(v1);
                }
            }
    }
};
struct EpiDiffQKV {
    static constexpr bool PERM = false, AFTER_DRAIN = false, PREFETCH = false, AROWPERM = false;
    bf16* Q; bf16* KF; bf16* VF; float* SK; float* SV; const float* T16;
    __device__ __forceinline__ void operator()(const pg8::f32x4 (&acc)[2][2][4][2], const pg8::Unit& u, int wr, int wc, int fr, int fq) const {
        const int region = u.pn >> 3; const bool smp = u.pm >= MP / 256;
#pragma unroll
        for (int ai = 0; ai < 2; ++ai)
#pragma unroll
            for (int m = 0; m < 4; ++m) {
                const int row = u.pm * 256 + ai * 128 + wr * 64 + m * 16 + fr; const int t = (row - MP) & 4095;
                const int kr = smp ? MP + ((row - MP) >> 12) * LSEQ + PAST + t : row;
#pragma unroll
                for (int bj = 0; bj < 2; ++bj) {
                    const int colr = (u.pn & 7) * 256 + bj * 128 + wc * 32 + 4 * fq;
                    f32x4 v0 = acc[ai][bj][m][0], v1 = acc[ai][bj][m][1];
                    if (region < 2 && smp) { const int pos = (wc & 1) ? (t & 63) : (t >> 6); const float* tp = T16 + (pos * 16 + 4 * fq) * 2; rot4(v0, v1, *(const f32x4*)tp, *(const f32x4*)(tp + 4)); }
                    bf16* dst = region == 0 ? Q + (size_t)row * 2048 + colr : (region == 1 ? KF : VF) + (size_t)kr * 2048 + colr;
                    *(v2u*)dst = pack4(v0); *(v2u*)(dst + 16) = pack4(v1);
                    if (region >= 1 && !smp) { float* s = (region == 1 ? SK : SV) + (size_t)row * 2048 + colr; *(f32x4*)s = v0; *(f32x4*)(s + 16) = v1; }
                }
            }
    }
};
struct EpiGqaQKV {
    static constexpr bool PERM = false, AFTER_DRAIN = false, PREFETCH = false, AROWPERM = false;
    bf16* Q; bf16* KF; bf16* VF; float* SK; float* SV; const float* T32; const float* qn; const float* kn; LAS float* Pl;
    __device__ __forceinline__ void operator()(const pg8::f32x4 (&acc)[2][2][4][2], const pg8::Unit& u, int wr, int wc, int fr, int fq) const {
        const bool smp = u.pm >= MP / 256; const bool isv = u.pn >= 10, isk = u.pn >= 8 && !isv;
        if (!isv) {
#pragma unroll
            for (int ai = 0; ai < 2; ++ai)
#pragma unroll
                for (int m = 0; m < 4; ++m)
#pragma unroll
                    for (int bj = 0; bj < 2; ++bj) { const f32x4 a = acc[ai][bj][m][0], b = acc[ai][bj][m][1];
                        float ss = ((a.x * a.x + a.y * a.y) + (a.z * a.z + a.w * a.w)) + ((b.x * b.x + b.y * b.y) + (b.z * b.z + b.w * b.w));
                        ss += __shfl_xor(ss, 16); ss += __shfl_xor(ss, 32);
                        if (fq == 0) Pl[((ai * 128 + wr * 64 + m * 16 + fr) * 2 + bj) * 4 + wc] = ss; }
            asm volatile("s_waitcnt lgkmcnt(0)" ::: "memory"); __builtin_amdgcn_s_barrier(); asm volatile("" ::: "memory");
        }
#pragma unroll
        for (int ai = 0; ai < 2; ++ai)
#pragma unroll
            for (int m = 0; m < 4; ++m) {
                const int row = u.pm * 256 + ai * 128 + wr * 64 + m * 16 + fr; const int t = (row - MP) & 4095;
                const int kr = smp ? MP + ((row - MP) >> 12) * LSEQ + PAST + t : row;
#pragma unroll
                for (int bj = 0; bj < 2; ++bj) {
                    const int head = u.pn * 2 + bj;
                    f32x4 v0 = acc[ai][bj][m][0], v1 = acc[ai][bj][m][1];
                    if (isv) { const int c = (head - 20) * 128 + wc * 32 + 4 * fq; bf16* dst = VF + (size_t)kr * 512 + c; *(v2u*)dst = pack4(v0); *(v2u*)(dst + 16) = pack4(v1);
                        if (!smp) { float* s = SV + (size_t)row * 512 + c; *(f32x4*)s = v0; *(f32x4*)(s + 16) = v1; } }
                    else {
                        const f32x4 pp = *(const LAS f32x4*)(Pl + ((ai * 128 + wr * 64 + m * 16 + fr) * 2 + bj) * 4);
                        const float rstd = rsqrtf(((pp.x + pp.y) + (pp.z + pp.w)) * (1.0f / 128.0f) + EPS);
                        const int d0 = 64 * (wc >> 1) + 16 * (wc & 1) + 4 * fq;
                        const float* gn = isk ? kn : qn;
                        v0 = v0 * rstd * *(const f32x4*)(gn + d0); v1 = v1 * rstd * *(const f32x4*)(gn + d0 + 32);
                        if (isk && !smp) { float* s = SK + (size_t)row * 512 + (head - 16) * 128 + d0; *(f32x4*)s = v0; *(f32x4*)(s + 32) = v1; }
                        if (smp) { const int pos = (wc >> 1) ? (t & 63) : (t >> 6); const float* tp = T32 + (pos * 32 + 16 * (wc & 1) + 4 * fq) * 2; rot4(v0, v1, *(const f32x4*)tp, *(const f32x4*)(tp + 4)); }
                        bf16* dst = isk ? KF + (size_t)kr * 512 + (head - 16) * 128 + d0 : Q + (size_t)row * 2048 + head * 128 + d0;
                        *(v2u*)dst = pack4(v0); *(v2u*)(dst + 32) = pack4(v1);
                    }
                }
            }
    }
};

template <int CTRL> __device__ __forceinline__ float dppf(float old, float src) { return __builtin_bit_cast(float, __builtin_amdgcn_update_dpp(__builtin_bit_cast(int, old), __builtin_bit_cast(int, src), CTRL, 0xf, 0xf, false)); }
constexpr int DPP_SHL1 = 0x101, DPP_SHR1 = 0x111, DPP_ROR1 = 0x121, DPP_ROR15 = 0x12F;
__device__ __forceinline__ void fmac_shr1(float& y, float src, float wv) { asm("v_fmac_f32_dpp %0, %1, %2 row_shr:1 row_mask:0xf bank_mask:0xf" : "+v"(y) : "v"(src), "v"(wv)); }
__device__ __forceinline__ void fmac_shl1(float& y, float src, float wv) { asm("v_fmac_f32_dpp %0, %1, %2 row_shl:1 row_mask:0xf bank_mask:0xf" : "+v"(y) : "v"(src), "v"(wv)); }
__device__ __forceinline__ void fmac_ror1(float& y, float src, float wv) { asm("v_fmac_f32_dpp %0, %1, %2 row_ror:1 row_mask:0xf bank_mask:0xf" : "+v"(y) : "v"(src), "v"(wv)); }
__device__ __forceinline__ void fmac_ror15(float& y, float src, float wv) { asm("v_fmac_f32_dpp %0, %1, %2 row_ror:15 row_mask:0xf bank_mask:0xf" : "+v"(y) : "v"(src), "v"(wv)); }
__device__ __forceinline__ float silu_gate(float g, float v) { return g * v * __builtin_amdgcn_rcpf(1.0f + __builtin_amdgcn_exp2f(-1.4426950408889634f * g)); }
struct EpiConvGate {
    static constexpr bool PERM = true, AFTER_DRAIN = false, PREFETCH = true, AROWPERM = true;
    bf16* G; float* EDGE; const float* cw; const float* cb; LAS float* EX;
    __device__ __forceinline__ void prefetch(const pg8::Unit& u, int tid, float& p0, float& p1) const {
        const int idx = tid * 2, k = idx >> 8, bjl = (idx >> 7) & 1, cl = idx & 127;
        const float* src = (k < 3 ? cw + (size_t)k * NFF : cb) + bjl * DFF + u.pn * 128 + cl; const f32x2 v = *(const f32x2*)src; p0 = v.x; p1 = v.y; }
    __device__ __forceinline__ void stash(int tid, float p0, float p1) const { *(LAS f32x2*)(EX + 2048 + tid * 2) = (f32x2){p0, p1}; }
    __device__ __forceinline__ void operator()(const pg8::f32x4 (&acc)[2][2][4][2], const pg8::Unit& u, int wr, int wc, int fr, int fq) const {
        const int ch = wc * 32 + 8 * fq;
        LAS float* WL = EX + 2048;
#pragma unroll
        for (int ai = 0; ai < 2; ++ai) { const int b = 2 * ai + wr;
#pragma unroll
            for (int bj = 0; bj < 2; ++bj)
#pragma unroll
                for (int n = 0; n < 2; ++n) {
                    if (fr == 0)  *(LAS f32x4*)(EX + ((b * 2 + 0) * 2 + bj) * 128 + ch + 4 * n) = acc[ai][bj][0][n];
                    if (fr == 15) *(LAS f32x4*)(EX + ((b * 2 + 1) * 2 + bj) * 128 + ch + 4 * n) = acc[ai][bj][3][n];
                } }
        if (u.pm >= MP / 256) {
            float* ed = EDGE + ((size_t)u.pm * 44 + u.pn) * 1024;
#pragma unroll
            for (int bj = 0; bj < 2; ++bj)
#pragma unroll
                for (int n = 0; n < 2; ++n) {
                    if (wr == 0 && fr == 0)  { *(f32x4*)(ed + 0 * 256 + bj * 128 + ch + 4 * n) = acc[0][bj][0][n]; *(f32x4*)(ed + 1 * 256 + bj * 128 + ch + 4 * n) = acc[0][bj][1][n]; }
                    if (wr == 1 && fr == 15) { *(f32x4*)(ed + 2 * 256 + bj * 128 + ch + 4 * n) = acc[1][bj][2][n]; *(f32x4*)(ed + 3 * 256 + bj * 128 + ch + 4 * n) = acc[1][bj][3][n]; }
                }
        }
        asm volatile("s_waitcnt lgkmcnt(0)" ::: "memory"); __builtin_amdgcn_s_barrier(); asm volatile("" ::: "memory");
        v2u keep[2][4];
#pragma unroll
        for (int n = 0; n < 2; ++n) {
            f32x4 w0[2], w1[2], w2[2], bb[2], w0e[2], w2e[2];
#pragma unroll
            for (int bj = 0; bj < 2; ++bj) { const int c = bj * 128 + ch + 4 * n; const f32x4 z = {0.f, 0.f, 0.f, 0.f};
                w0[bj] = *(const LAS f32x4*)(WL + c); w1[bj] = *(const LAS f32x4*)(WL + 256 + c); w2[bj] = *(const LAS f32x4*)(WL + 512 + c); bb[bj] = *(const LAS f32x4*)(WL + 768 + c);
                w0e[bj] = fr == 0 ? w0[bj] : z; w2e[bj] = fr == 15 ? w2[bj] : z; }
#pragma unroll
            for (int ai = 0; ai < 2; ++ai) { const int b = 2 * ai + wr;
                f32x4 y[2][4];
#pragma unroll
                for (int bj = 0; bj < 2; ++bj) {
                    const f32x4 z = {0.f, 0.f, 0.f, 0.f};
                    const f32x4 ht = b > 0 ? *(const LAS f32x4*)(EX + (((b - 1) * 2 + 1) * 2 + bj) * 128 + ch + 4 * n) : z;
                    const f32x4 hb = b < 3 ? *(const LAS f32x4*)(EX + (((b + 1) * 2 + 0) * 2 + bj) * 128 + ch + 4 * n) : z;
                    const f32x4 v0 = acc[ai][bj][0][n], v1 = acc[ai][bj][1][n], v2 = acc[ai][bj][2][n], v3 = acc[ai][bj][3][n];
                    f32x4 y0 = w1[bj] * v0 + bb[bj] + w2[bj] * v1 + w0e[bj] * ht;
                    const f32x4 y1 = w1[bj] * v1 + bb[bj] + w0[bj] * v0 + w2[bj] * v2;
                    const f32x4 y2 = w1[bj] * v2 + bb[bj] + w0[bj] * v1 + w2[bj] * v3;
                    f32x4 y3 = w1[bj] * v3 + bb[bj] + w0[bj] * v2 + w2e[bj] * hb;
#pragma unroll
                    for (int e = 0; e < 4; ++e) { float a0 = y0[e], a3 = y3[e];
                        fmac_shr1(a0, v3[e], w0[bj][e]);
                        fmac_shl1(a3, v0[e], w2[bj][e]);
                        y0[e] = a0; y3[e] = a3; }
                    y[bj][0] = y0; y[bj][1] = y1; y[bj][2] = y2; y[bj][3] = y3;
                }
#pragma unroll
                for (int m = 0; m < 4; ++m) { f32x4 g;
#pragma unroll
                    for (int e = 0; e < 4; ++e) g[e] = silu_gate(y[0][m][e], y[1][m][e]);
                    const int row = u.pm * 256 + ai * 128 + wr * 64 + 4 * fr + m;
                    const v2u pk = pack4(g);
                    if (n == 0) keep[ai][m] = pk;
                    else { v4u o; o.x = keep[ai][m].x; o.y = keep[ai][m].y; o.z = pk.x; o.w = pk.y; *(v4u*)(G + (size_t)row * DFF + u.pn * 128 + ch) = o; } }
            }
        }
    }
};
__device__ __forceinline__ void conv_fix_phase(const Params& P, unsigned char* ldsp, int l) {
    const Frame F = make_frame(ldsp);
    bf16* G = (bf16*)(P.ws + WS_R + R_G); const float* EDGE = (const float*)(P.ws + WS_EDGE);
    const float* cw = P.in[I_FCW] + (size_t)l * 3 * NFF; const float* cb = P.in[I_FCB] + (size_t)l * NFF;
    for (int it = F.gw; it < DB * 15 * 44; it += F.NGW) {
        const int pn = it % 44, eb = it / 44, mb = eb / 15, k = eb % 15, pm = MP / 256 + mb * 16 + k;
        const float* e0 = EDGE + ((size_t)pm * 44 + pn) * 1024; const float* e1 = EDGE + ((size_t)(pm + 1) * 44 + pn) * 1024;
        const int c2 = 2 * F.lane;
        f32x2 ua[2], ub[2], uc[2], ud[2], w0[2], w1[2], w2[2], bb[2];
#pragma unroll
        for (int bj = 0; bj < 2; ++bj) { ua[bj] = *(const f32x2*)(e0 + 2 * 256 + bj * 128 + c2); ub[bj] = *(const f32x2*)(e0 + 3 * 256 + bj * 128 + c2); uc[bj] = *(const f32x2*)(e1 + bj * 128 + c2); ud[bj] = *(const f32x2*)(e1 + 256 + bj * 128 + c2);
            const int c = bj * DFF + pn * 128 + c2; w0[bj] = *(const f32x2*)(cw + c); w1[bj] = *(const f32x2*)(cw + NFF + c); w2[bj] = *(const f32x2*)(cw + 2 * NFF + c); bb[bj] = *(const f32x2*)(cb + c); }
        f32x2 ya[2], yb[2];
#pragma unroll
        for (int bj = 0; bj < 2; ++bj) { ya[bj] = w0[bj] * ua[bj] + w1[bj] * ub[bj] + w2[bj] * uc[bj] + bb[bj]; yb[bj] = w0[bj] * ub[bj] + w1[bj] * uc[bj] + w2[bj] * ud[bj] + bb[bj]; }
        const int rlast = pm * 256 + 255;
        *(unsigned*)(G + (size_t)rlast * DFF + pn * 128 + c2) = pg8::cvt_pk_bf16(silu_gate(ya[0].x, ya[1].x), silu_gate(ya[0].y, ya[1].y));
        *(unsigned*)(G + (size_t)(rlast + 1) * DFF + pn * 128 + c2) = pg8::cvt_pk_bf16(silu_gate(yb[0].x, yb[1].x), silu_gate(yb[0].y, yb[1].y));
    }
}

__device__ __forceinline__ void cg_row(const v4u pg, const v4u cg, const v4u ng, const v4u pv, const v4u cv, const v4u nv, const float (&wg)[3][8], const float (&wv)[3][8], const float (&bg)[8], const float (&bv)[8], bf16* dst) {
    const unsigned pgw[4] = {pg.x, pg.y, pg.z, pg.w}, cgw[4] = {cg.x, cg.y, cg.z, cg.w}, ngw[4] = {ng.x, ng.y, ng.z, ng.w};
    const unsigned pvw[4] = {pv.x, pv.y, pv.z, pv.w}, cvw[4] = {cv.x, cv.y, cv.z, cv.w}, nvw[4] = {nv.x, nv.y, nv.z, nv.w};
    float y[8];
#pragma unroll
    for (int e = 0; e < 8; ++e) { const int w = e >> 1;
        const float gp = (e & 1) ? bfhi(pgw[w]) : bflo(pgw[w]), gc = (e & 1) ? bfhi(cgw[w]) : bflo(cgw[w]), gn = (e & 1) ? bfhi(ngw[w]) : bflo(ngw[w]);
        const float vp = (e & 1) ? bfhi(pvw[w]) : bflo(pvw[w]), vc = (e & 1) ? bfhi(cvw[w]) : bflo(cvw[w]), vn = (e & 1) ? bfhi(nvw[w]) : bflo(nvw[w]);
        const float gt = gp * wg[0][e] + gc * wg[1][e] + gn * wg[2][e] + bg[e];
        const float vl = vp * wv[0][e] + vc * wv[1][e] + vn * wv[2][e] + bv[e];
        y[e] = silu_f(gt) * vl; }
    v4u o; o.x = pk2(y[0], y[1]); o.y = pk2(y[2], y[3]); o.z = pk2(y[4], y[5]); o.w = pk2(y[6], y[7]);
    *(v4u*)dst = o;
}
__device__ __forceinline__ void conv_gate_phase(const Params& P, unsigned char* ldsp, int l) {
    const Frame F = make_frame(ldsp);
    const bf16* U = (const bf16*)(P.ws + WS_R + R_U); bf16* G = (bf16*)(P.ws + WS_R + R_G);
    const float* cw = P.in[I_FCW] + (size_t)l * 3 * NFF; const float* cb = P.in[I_FCB] + (size_t)l * NFF;
    constexpr int RC = 32, NRC = M / RC, NCC = DFF / 512;
    for (int u = F.gw; u < NRC * NCC; u += F.NGW) {
        const int rc = u / NCC, cc = u % NCC, r0 = rc * RC, c0 = cc * 512 + 8 * F.lane;
        float wg[3][8], wv[3][8], bg[8], bv[8];
#pragma unroll
        for (int k = 0; k < 3; ++k) { const f32x4 a = *(const f32x4*)(cw + (size_t)k * NFF + c0), b = *(const f32x4*)(cw + (size_t)k * NFF + c0 + 4), c = *(const f32x4*)(cw + (size_t)k * NFF + DFF + c0), d = *(const f32x4*)(cw + (size_t)k * NFF + DFF + c0 + 4);
            wg[k][0] = a.x; wg[k][1] = a.y; wg[k][2] = a.z; wg[k][3] = a.w; wg[k][4] = b.x; wg[k][5] = b.y; wg[k][6] = b.z; wg[k][7] = b.w;
            wv[k][0] = c.x; wv[k][1] = c.y; wv[k][2] = c.z; wv[k][3] = c.w; wv[k][4] = d.x; wv[k][5] = d.y; wv[k][6] = d.z; wv[k][7] = d.w; }
        { const f32x4 a = *(const f32x4*)(cb + c0), b = *(const f32x4*)(cb + c0 + 4), c = *(const f32x4*)(cb + DFF + c0), d = *(const f32x4*)(cb + DFF + c0 + 4);
            bg[0] = a.x; bg[1] = a.y; bg[2] = a.z; bg[3] = a.w; bg[4] = b.x; bg[5] = b.y; bg[6] = b.z; bg[7] = b.w;
            bv[0] = c.x; bv[1] = c.y; bv[2] = c.z; bv[3] = c.w; bv[4] = d.x; bv[5] = d.y; bv[6] = d.z; bv[7] = d.w; }
        const int spos = r0 < MP ? (r0 & 255) : ((r0 - MP) & 4095), slen = r0 < MP ? 256 : 4096;
        const bool has_prev = spos > 0, has_next = spos + RC < slen;
        const v4u z = {0u, 0u, 0u, 0u};
        const bf16* Ug = U + (size_t)r0 * NFF + c0; const bf16* Uv = Ug + DFF; bf16* Go = G + (size_t)r0 * DFF + c0;
        v4u pg = has_prev ? *(const v4u*)(Ug - NFF) : z, pv = has_prev ? *(const v4u*)(Uv - NFF) : z;
        v4u cg = *(const v4u*)Ug, cv = *(const v4u*)Uv;
        v4u ag[4], av[4], bgq[4], bvq[4];
#define CG_LOAD(XG, XV, r_) do { _Pragma("unroll") for (int q = 0; q < 4; ++q) { const int rr = (r_) + 1 + q; const bool ok = rr < RC || (rr == RC && has_next); \
            XG[q] = ok ? *(const v4u*)(Ug + (size_t)rr * NFF) : z; XV[q] = ok ? *(const v4u*)(Uv + (size_t)rr * NFF) : z; } } while (0)
#define CG_STEP(XG, XV, r_) do { cg_row(pg, cg, XG[0], pv, cv, XV[0], wg, wv, bg, bv, Go + (size_t)(r_) * DFF); cg_row(cg, XG[0], XG[1], cv, XV[0], XV[1], wg, wv, bg, bv, Go + (size_t)((r_) + 1) * DFF); \
            cg_row(XG[0], XG[1], XG[2], XV[0], XV[1], XV[2], wg, wv, bg, bv, Go + (size_t)((r_) + 2) * DFF); cg_row(XG[1], XG[2], XG[3], XV[1], XV[2], XV[3], wg, wv, bg, bv, Go + (size_t)((r_) + 3) * DFF); \
            pg = XG[2]; pv = XV[2]; cg = XG[3]; cv = XV[3]; } while (0)
        CG_LOAD(ag, av, 0);
        for (int r = 0; r < RC; r += 8) {
            CG_LOAD(bgq, bvq, r + 4);
            CG_STEP(ag, av, r);
            if (r + 8 < RC) CG_LOAD(ag, av, r + 8);
            CG_STEP(bgq, bvq, r + 4);
        }
#undef CG_LOAD
#undef CG_STEP
    }
}

#ifndef SEED_MASK
#define SEED_MASK 7
#endif
#ifndef M192
#define M192 true
#endif
namespace att {
constexpr int NW = 8, QBLK = 32, KVBLK = 64;
constexpr float THR = 8.f;
#define SBAR() __builtin_amdgcn_sched_barrier(0)
__device__ __forceinline__ int crow(int r, int hi) { return (r & 3) + 8 * (r >> 2) + 4 * hi; }
__device__ __forceinline__ unsigned cvtpk(float lo, float hi) { unsigned r; asm volatile("v_cvt_pk_bf16_f32 %0, %1, %2" : "=v"(r) : "v"(lo), "v"(hi)); return r; }
__device__ __forceinline__ bf16x8 ld8(const bf16* p) { return *reinterpret_cast<const bf16x8*>(p); }

template <int DQK> __device__ __forceinline__ void partialSM(f32x16& p0, f32x16& p1, float& m_reg, float& mn, float& alpha) {
  constexpr float SCALE = DQK == 64 ? 0.125f : (DQK == 128 ? 0.088388347648318440f : 0.072168783648703220f);
  constexpr float C = SCALE * 1.4426950408889634f;
  float pmax = p0[0];
#pragma unroll
  for (int r = 1; r < 16; ++r) pmax = fmaxf(pmax, p0[r]);
#pragma unroll
  for (int r = 0; r < 16; ++r) pmax = fmaxf(pmax, p1[r]);
  { auto rr = __builtin_amdgcn_permlane32_swap(__float_as_uint(pmax), __float_as_uint(pmax), false, false);
    pmax = fmaxf(__uint_as_float(rr[0]), __uint_as_float(rr[1])); }
  if (__builtin_expect(__all(pmax - m_reg <= THR / SCALE), 1)) { mn = m_reg; alpha = 1.f; }
  else { mn = fmaxf(m_reg, pmax); alpha = __builtin_amdgcn_exp2f((m_reg - mn) * C); m_reg = mn; }
  const float mnC = -mn * C;
#pragma unroll
  for (int r = 0; r < 16; ++r) p0[r] = fmaf(p0[r], C, mnC);
#pragma unroll
  for (int r = 0; r < 16; ++r) p1[r] = fmaf(p1[r], C, mnC);
#pragma unroll
  for (int r = 0; r < 16; ++r) p0[r] = __builtin_amdgcn_exp2f(p0[r]);
}
__device__ __forceinline__ void finishSM(f32x16& p0, f32x16& p1, float alpha, float& l_reg, bf16x8& pa0, bf16x8& pa1, bf16x8& pa2, bf16x8& pa3) {
#pragma unroll
  for (int r = 0; r < 16; ++r) p1[r] = __builtin_amdgcn_exp2f(p1[r]);
  float ps = 0;
#pragma unroll
  for (int r = 0; r < 16; ++r) ps += p0[r];
#pragma unroll
  for (int r = 0; r < 16; ++r) ps += p1[r];
  { auto rr = __builtin_amdgcn_permlane32_swap(__float_as_uint(ps), __float_as_uint(ps), false, false);
    ps = __uint_as_float(rr[0]) + __uint_as_float(rr[1]); }
  l_reg = l_reg * alpha + ps;
#define PK4(P, BASE, OUT) do { unsigned a0 = cvtpk(P[BASE + 0], P[BASE + 1]), a1 = cvtpk(P[BASE + 2], P[BASE + 3]);   \
    unsigned b0 = cvtpk(P[BASE + 4], P[BASE + 5]), b1 = cvtpk(P[BASE + 6], P[BASE + 7]);                              \
    auto r0 = __builtin_amdgcn_permlane32_swap(a0, b0, false, false); auto r1 = __builtin_amdgcn_permlane32_swap(a1, b1, false, false); \
    v4u w = {r0[0], r1[0], r0[1], r1[1]}; OUT = *reinterpret_cast<bf16x8*>(&w); } while (0)
  PK4(p0, 0, pa0); PK4(p0, 8, pa1); PK4(p1, 0, pa2); PK4(p1, 8, pa3);
#undef PK4
}
template <int DQK> __device__ __forceinline__ int kswz(int row, int colB) { return row * (DQK * 2) + (colB ^ ((DQK == 128 ? (row & 15) : ((row >> 1) & 7)) << 4)); }
template <int DQK, bool QLDS> __device__ __forceinline__ void qkt(f32x16& p0, f32x16& p1, const char* Ks, const bf16x8* qr, const char* qpe, int r32, int hi) {
  p0 = f32x16{}; p1 = f32x16{};
#pragma unroll
  for (int d0 = 0; d0 < DQK / 16; ++d0) { const int cb = (d0 * 16 + hi * 8) * 2;
    const bf16x8 b0 = *reinterpret_cast<const bf16x8*>(Ks + kswz<DQK>(r32, cb));
    const bf16x8 b1 = *reinterpret_cast<const bf16x8*>(Ks + kswz<DQK>(32 + r32, cb));
    bf16x8 q;
    if constexpr (QLDS) { if (d0 >= 8) q = *reinterpret_cast<const bf16x8*>(qpe + kswz<64>(r32, cb - 256)); else q = qr[d0]; } else q = qr[d0];
    p0 = __builtin_amdgcn_mfma_f32_32x32x16_bf16(b0, q, p0, 0, 0, 0);
    p1 = __builtin_amdgcn_mfma_f32_32x32x16_bf16(b1, q, p1, 0, 0, 0); }
}
__device__ __forceinline__ int v_st(int k, int c) { const int kk = (k & ~0xC) | ((k & 4) << 1) | ((k & 8) >> 1); return ((kk >> 3) * 4 + (c >> 5)) * 512 + ((kk & 7) * 32 + (c & 31)) * 2; }
__device__ __forceinline__ int v_stn(int k, int c) { return ((k >> 3) * 4 + (c >> 5)) * 512 + ((k & 7) * 32 + (c & 31)) * 2; }
__device__ __forceinline__ int v_rd_base(int lane) { return ((lane & 3) << 3) | (((lane >> 2) & 3) << 6) | (((lane >> 4) & 1) << 5) | (((lane >> 5) & 1) << 8); }
constexpr int v_rd_off(int d0, int ks, int half) { return d0 * 512 + ks * 4096 + half * 2048; }
template <int OFF> __device__ __forceinline__ s16x4 tr_read(int vb) {
  s16x4 r; asm volatile("ds_read_b64_tr_b16 %0, %1 offset:%2" : "=&v"(r) : "v"(vb), "i"(OFF) : "memory"); return r;
}
template <int D0> __device__ __forceinline__ void pv_one(f32x16& od, int vb, bf16x8 pa0, bf16x8 pa1, bf16x8 pa2, bf16x8 pa3) {
  const s16x4 l0 = tr_read<v_rd_off(D0, 0, 0)>(vb), h0 = tr_read<v_rd_off(D0, 0, 1)>(vb), l1 = tr_read<v_rd_off(D0, 1, 0)>(vb), h1 = tr_read<v_rd_off(D0, 1, 1)>(vb);
  const s16x4 l2 = tr_read<v_rd_off(D0, 2, 0)>(vb), h2 = tr_read<v_rd_off(D0, 2, 1)>(vb), l3 = tr_read<v_rd_off(D0, 3, 0)>(vb), h3 = tr_read<v_rd_off(D0, 3, 1)>(vb);
  asm volatile("s_waitcnt lgkmcnt(0)" ::: "memory"); SBAR();
#define PK(L, H) (bf16x8){L[0], L[1], L[2], L[3], H[0], H[1], H[2], H[3]}
  od = __builtin_amdgcn_mfma_f32_32x32x16_bf16(pa0, PK(l0, h0), od, 0, 0, 0);
  od = __builtin_amdgcn_mfma_f32_32x32x16_bf16(pa1, PK(l1, h1), od, 0, 0, 0);
  od = __builtin_amdgcn_mfma_f32_32x32x16_bf16(pa2, PK(l2, h2), od, 0, 0, 0);
  od = __builtin_amdgcn_mfma_f32_32x32x16_bf16(pa3, PK(l3, h3), od, 0, 0, 0);
#undef PK
}
__device__ __forceinline__ void pv_d0(f32x16* o, int vb, bf16x8 pa0, bf16x8 pa1, bf16x8 pa2, bf16x8 pa3) {
  pv_one<0>(o[0], vb, pa0, pa1, pa2, pa3); pv_one<1>(o[1], vb, pa0, pa1, pa2, pa3); pv_one<2>(o[2], vb, pa0, pa1, pa2, pa3); pv_one<3>(o[3], vb, pa0, pa1, pa2, pa3);
}

template <int DQK, int SDEPTH, bool QLDS>
__device__ __forceinline__ void attn_unit(const bf16* __restrict__ Qb, int ldq, const bf16* __restrict__ Kh, int ldk, const bf16* __restrict__ Kp, int ldkp,
                                          const bf16* __restrict__ Vh, int ldv, bf16* __restrict__ Ob, int ldo, int seq, char* lds) {
  constexpr int SHM_V = KVBLK * 128 * 2, SHM_K = KVBLK * DQK * 2;
  int tid_ = threadIdx.x; asm volatile("" : "+v"(tid_));
  const int tid = tid_, wid = tid >> 6, lane = tid & 63, r32 = lane & 31, hi = lane >> 5;
  char* V_lds = lds; char* K_lds = lds + 2 * SHM_V;
  float* wsf = (float*)(lds + 2 * SHM_V + 2 * SHM_K) + wid * 64; float* li_l = wsf; float* al_l = wsf + 32;
  constexpr int NQR = QLDS ? 8 : DQK / 16;
  float m_reg = -1e30f, l_reg = 0; f32x16 o[4] = {}; bf16x8 qr[NQR];
  const bf16* Qw = Qb + (long)(wid * QBLK + r32) * ldq + hi * 8;
#pragma unroll
  for (int d0 = 0; d0 < NQR; ++d0) qr[d0] = ld8(Qw + d0 * 16);
  char* qpe_l = lds + 2 * SHM_V + 2 * SHM_K + 2048 + wid * 4096;
  if constexpr (QLDS) {
#pragma unroll
    for (int d0 = 8; d0 < DQK / 16; ++d0) *(bf16x8*)(qpe_l + kswz<64>(r32, (d0 * 16 + hi * 8) * 2 - 256)) = ld8(Qw + d0 * 16);
    asm volatile("s_waitcnt lgkmcnt(0)" ::: "memory");
  }
  const int sr = tid >> 4, sc = (tid & 15) * 8, vst0 = v_st(sr, sc), vst1 = v_st(32 + sr, sc);
  const int sr8 = tid >> 3, sc8 = (tid & 7) * 8;
  const int vb0 = (int)(uintptr_t)V_lds + v_rd_base(lane);
  struct Slot { bf16x8 vs0, vs1, ks0, ks1, kp; } sr_[SDEPTH];
  constexpr int SE = 0, SO = SDEPTH - 1;
#define SLOAD(i, k0) do { sr_[i].vs0 = ld8(&Vh[(long)((k0) + sr) * ldv + sc]); sr_[i].vs1 = ld8(&Vh[(long)((k0) + 32 + sr) * ldv + sc]); \
    if constexpr (DQK == 64) { sr_[i].ks0 = ld8(&Kh[(long)((k0) + sr8) * ldk + sc8]); } \
    else { sr_[i].ks0 = ld8(&Kh[(long)((k0) + sr) * ldk + sc]); sr_[i].ks1 = ld8(&Kh[(long)((k0) + 32 + sr) * ldk + sc]); } \
    if constexpr (DQK == 192) { sr_[i].kp = ld8(&Kp[(long)((k0) + sr8) * ldkp + sc8]); } } while (0)
#define SWRITE(b, i) do { *(bf16x8*)(V_lds + (b) * SHM_V + vst0) = sr_[i].vs0; *(bf16x8*)(V_lds + (b) * SHM_V + vst1) = sr_[i].vs1; \
    if constexpr (DQK == 64) { *(bf16x8*)(K_lds + (b) * SHM_K + kswz<DQK>(sr8, sc8 * 2)) = sr_[i].ks0; } \
    else { *(bf16x8*)(K_lds + (b) * SHM_K + kswz<DQK>(sr, sc * 2)) = sr_[i].ks0; *(bf16x8*)(K_lds + (b) * SHM_K + kswz<DQK>(32 + sr, sc * 2)) = sr_[i].ks1; } \
    if constexpr (DQK == 192) { *(bf16x8*)(K_lds + (b) * SHM_K + kswz<DQK>(sr8, 256 + sc8 * 2)) = sr_[i].kp; } } while (0)
  constexpr int LPT = DQK == 64 ? 3 : (DQK == 128 ? 4 : 5);
#define SWAIT() do { if constexpr (SDEPTH == 1) asm volatile("s_waitcnt vmcnt(0)" ::: "memory"); else if constexpr (LPT == 3) asm volatile("s_waitcnt vmcnt(3)" ::: "memory"); else if constexpr (LPT == 4) asm volatile("s_waitcnt vmcnt(4)" ::: "memory"); else asm volatile("s_waitcnt vmcnt(5)" ::: "memory"); } while (0)
#define RESC(a) do { if (__any((a) < 1.f)) { if (hi == 0) al_l[r32] = (a); asm volatile("s_waitcnt lgkmcnt(0)" ::: "memory"); \
    _Pragma("unroll") for (int d = 0; d < 4; ++d) _Pragma("unroll") for (int r = 0; r < 16; ++r) o[d][r] *= al_l[crow(r, hi)]; } } while (0)
  f32x16 pA0, pA1, pB0, pB1; float mnA, mnB, alA, alB; bf16x8 pa0, pa1, pa2, pa3; const int NT = seq / KVBLK;
  SLOAD(SE, 0); asm volatile("s_waitcnt vmcnt(0)" ::: "memory"); SWRITE(0, SE); __syncthreads();
  qkt<DQK, QLDS>(pA0, pA1, K_lds, qr, qpe_l, r32, hi); partialSM<DQK>(pA0, pA1, m_reg, mnA, alA);
  SLOAD(SO, KVBLK); if constexpr (SDEPTH == 2) { if (2 < NT) SLOAD(SE, 2 * KVBLK); }
  SWAIT(); SWRITE(1, SO); __syncthreads();
  for (int j = 1; j + 1 < NT; j += 2) {
    SBAR(); qkt<DQK, QLDS>(pB0, pB1, K_lds + SHM_K, qr, qpe_l, r32, hi);
    finishSM(pA0, pA1, alA, l_reg, pa0, pa1, pa2, pa3); SBAR();
    SLOAD(SO, (j + SDEPTH) * KVBLK); SBAR();
    pv_d0(o, vb0, pa0, pa1, pa2, pa3); partialSM<DQK>(pB0, pB1, m_reg, mnB, alB);
    __syncthreads(); SWAIT(); SWRITE(0, SE);
    RESC(alB); __syncthreads();
    SBAR(); qkt<DQK, QLDS>(pA0, pA1, K_lds, qr, qpe_l, r32, hi);
    finishSM(pB0, pB1, alB, l_reg, pa0, pa1, pa2, pa3); SBAR();
    if (SDEPTH == 1 || j + 3 < NT) SLOAD(SE, (j + 1 + SDEPTH) * KVBLK); SBAR();
    pv_d0(o, vb0 + SHM_V, pa0, pa1, pa2, pa3); partialSM<DQK>(pA0, pA1, m_reg, mnA, alA);
    __syncthreads(); SWAIT(); SWRITE(1, SO);
    RESC(alA); __syncthreads();
  }
  SBAR(); qkt<DQK, QLDS>(pB0, pB1, K_lds + SHM_K, qr, qpe_l, r32, hi);
  finishSM(pA0, pA1, alA, l_reg, pa0, pa1, pa2, pa3); SBAR();
  pv_d0(o, vb0, pa0, pa1, pa2, pa3); partialSM<DQK>(pB0, pB1, m_reg, mnB, alB);
  __syncthreads(); RESC(alB);
  finishSM(pB0, pB1, alB, l_reg, pa0, pa1, pa2, pa3); SBAR();
  pv_d0(o, vb0 + SHM_V, pa0, pa1, pa2, pa3);
  if (hi == 0) li_l[r32] = l_reg; asm volatile("s_waitcnt lgkmcnt(0)" ::: "memory");
  float rli[16];
#pragma unroll
  for (int r = 0; r < 16; ++r) rli[r] = __builtin_amdgcn_rcpf(li_l[crow(r, hi)]);
  bf16* Ow = Ob + (long)(wid * QBLK) * ldo;
#pragma unroll
  for (int r = 0; r < 16; ++r) { const int orow = crow(r, hi);
#pragma unroll
    for (int d0 = 0; d0 < 4; ++d0) Ow[(long)orow * ldo + d0 * 32 + r32] = (bf16)f2bf(o[d0][r] * rli[r]); }
#undef SLOAD
#undef SWRITE
#undef SWAIT
#undef RESC
}

template <int DQK, bool QLDS>
__device__ __forceinline__ void attn_unit_s(const bf16* __restrict__ Qb, int ldq, const bf16* __restrict__ Kh, int ldk, const bf16* __restrict__ Kp, int ldkp,
                                            const bf16* __restrict__ Vh, int ldv, bf16* __restrict__ Ob, int ldo, int seq, char* lds) {
  constexpr int SHM_V = KVBLK * 128 * 2, SHM_K = KVBLK * DQK * 2;
  int tid_ = threadIdx.x; asm volatile("" : "+v"(tid_));
  const int tid = tid_, wid = tid >> 6, lane = tid & 63, r32 = lane & 31, hi = lane >> 5;
  char* V_lds = lds; char* K_lds = lds + 2 * SHM_V;
  float* wsf = (float*)(lds + 2 * SHM_V + 2 * SHM_K) + wid * 64; float* li_l = wsf; float* al_l = wsf + 32;
  constexpr int NQR = QLDS ? 8 : DQK / 16;
  float m_reg = -1e30f, l_reg = 0; f32x16 o[4] = {}; bf16x8 qr[NQR];
  const bf16* Qw = Qb + (long)(wid * QBLK + r32) * ldq + hi * 8;
#pragma unroll
  for (int d0 = 0; d0 < NQR; ++d0) qr[d0] = ld8(Qw + d0 * 16);
  char* qpe_l = lds + 2 * SHM_V + 2 * SHM_K + 2048 + wid * 4096;
  if constexpr (QLDS) {
#pragma unroll
    for (int d0 = 8; d0 < DQK / 16; ++d0) *(bf16x8*)(qpe_l + kswz<64>(r32, (d0 * 16 + hi * 8) * 2 - 256)) = ld8(Qw + d0 * 16);
    asm volatile("s_waitcnt lgkmcnt(0)" ::: "memory");
  }
  const int sr = tid >> 4, sc = (tid & 15) * 8, vst0 = v_st(sr, sc), vst1 = v_st(32 + sr, sc);
  const int sr8 = tid >> 3, sc8 = (tid & 7) * 8;
  const int vb0 = (int)(uintptr_t)V_lds + v_rd_base(lane);
  bf16x8 vs0, vs1, ks0, ks1, kp;
#define SLOAD1(k0) do { vs0 = ld8(&Vh[(long)((k0) + sr) * ldv + sc]); vs1 = ld8(&Vh[(long)((k0) + 32 + sr) * ldv + sc]); \
    if constexpr (DQK == 64) { ks0 = ld8(&Kh[(long)((k0) + sr8) * ldk + sc8]); } \
    else { ks0 = ld8(&Kh[(long)((k0) + sr) * ldk + sc]); ks1 = ld8(&Kh[(long)((k0) + 32 + sr) * ldk + sc]); } \
    if constexpr (DQK == 192) { kp = ld8(&Kp[(long)((k0) + sr8) * ldkp + sc8]); } } while (0)
#define SWRITE1(b) do { *(bf16x8*)(V_lds + (b) * SHM_V + vst0) = vs0; *(bf16x8*)(V_lds + (b) * SHM_V + vst1) = vs1; \
    if constexpr (DQK == 64) { *(bf16x8*)(K_lds + (b) * SHM_K + kswz<DQK>(sr8, sc8 * 2)) = ks0; } \
    else { *(bf16x8*)(K_lds + (b) * SHM_K + kswz<DQK>(sr, sc * 2)) = ks0; *(bf16x8*)(K_lds + (b) * SHM_K + kswz<DQK>(32 + sr, sc * 2)) = ks1; } \
    if constexpr (DQK == 192) { *(bf16x8*)(K_lds + (b) * SHM_K + kswz<DQK>(sr8, 256 + sc8 * 2)) = kp; } } while (0)
#define RESC1(a) do { if (__any((a) < 1.f)) { if (hi == 0) al_l[r32] = (a); asm volatile("s_waitcnt lgkmcnt(0)" ::: "memory"); \
    _Pragma("unroll") for (int d = 0; d < 4; ++d) _Pragma("unroll") for (int r = 0; r < 16; ++r) o[d][r] *= al_l[crow(r, hi)]; } } while (0)
  f32x16 p0, p1; float mn, al; bf16x8 pa0, pa1, pa2, pa3; const int NT = seq / KVBLK;
  SLOAD1(0); asm volatile("s_waitcnt vmcnt(0)" ::: "memory"); SWRITE1(0); SLOAD1(KVBLK); __syncthreads();
  for (int j = 0; j < NT; j += 2) {
    SWRITE1(1);
    if (j + 2 < NT) SLOAD1((j + 2) * KVBLK);
    SBAR(); qkt<DQK, QLDS>(p0, p1, K_lds, qr, qpe_l, r32, hi); partialSM<DQK>(p0, p1, m_reg, mn, al);
    RESC1(al); finishSM(p0, p1, al, l_reg, pa0, pa1, pa2, pa3); SBAR();
    pv_d0(o, vb0, pa0, pa1, pa2, pa3);
    __syncthreads();
    if (j + 2 < NT) SWRITE1(0);
    if (j + 3 < NT) SLOAD1((j + 3) * KVBLK);
    SBAR(); qkt<DQK, QLDS>(p0, p1, K_lds + SHM_K, qr, qpe_l, r32, hi); partialSM<DQK>(p0, p1, m_reg, mn, al);
    RESC1(al); finishSM(p0, p1, al, l_reg, pa0, pa1, pa2, pa3); SBAR();
    pv_d0(o, vb0 + SHM_V, pa0, pa1, pa2, pa3);
    __syncthreads();
  }
  if (hi == 0) li_l[r32] = l_reg; asm volatile("s_waitcnt lgkmcnt(0)" ::: "memory");
  float rli[16];
#pragma unroll
  for (int r = 0; r < 16; ++r) rli[r] = __builtin_amdgcn_rcpf(li_l[crow(r, hi)]);
  bf16* Ow = Ob + (long)(wid * QBLK) * ldo;
#pragma unroll
  for (int r = 0; r < 16; ++r) { const int orow = crow(r, hi);
#pragma unroll
    for (int d0 = 0; d0 < 4; ++d0) Ow[(long)orow * ldo + d0 * 32 + r32] = (bf16)f2bf(o[d0][r] * rli[r]); }
#undef SLOAD1
#undef SWRITE1
#undef RESC1
}

template <int DQK> __device__ __forceinline__ void softmax_tile(f32x16& p0, f32x16& p1, float& m_reg, float& l_reg, float& alpha, bf16x8& pa0, bf16x8& pa1, bf16x8& pa2, bf16x8& pa3) {
  float mn; partialSM<DQK>(p0, p1, m_reg, mn, alpha); finishSM(p0, p1, alpha, l_reg, pa0, pa1, pa2, pa3);
}
#define PK4S(P, BASE, OUT) do { v4u w = {cvtpk(P[BASE + 0], P[BASE + 1]), cvtpk(P[BASE + 2], P[BASE + 3]), cvtpk(P[BASE + 4], P[BASE + 5]), cvtpk(P[BASE + 6], P[BASE + 7])}; \
    OUT = *reinterpret_cast<bf16x8*>(&w); } while (0)
__device__ __forceinline__ float xhalf_max(float v) {
  auto rr = __builtin_amdgcn_permlane32_swap(__float_as_uint(v), __float_as_uint(v), false, false);
  float mx_; asm("v_max_f32 %0, %1, %2" : "=v"(mx_) : "v"(rr[0]), "v"(rr[1]));
  return mx_;
}
__device__ __forceinline__ float ownmax32(const f32x16& p0, const f32x16& p1) {
  float pmax = p0[0];
#pragma unroll
  for (int r = 1; r < 16; ++r) pmax = fmaxf(pmax, p0[r]);
#pragma unroll
  for (int r = 0; r < 16; ++r) pmax = fmaxf(pmax, p1[r]);
  return pmax;
}
__device__ __forceinline__ float rowmax32(const f32x16& p0, const f32x16& p1) {
  float pmax = p0[0];
#pragma unroll
  for (int r = 1; r < 16; ++r) pmax = fmaxf(pmax, p0[r]);
#pragma unroll
  for (int r = 0; r < 16; ++r) pmax = fmaxf(pmax, p1[r]);
  return xhalf_max(pmax);
}
__device__ __forceinline__ float expsum32(f32x16& p0, f32x16& p1) {
#pragma unroll
  for (int r = 0; r < 16; ++r) p0[r] = __builtin_amdgcn_exp2f(p0[r]);
#pragma unroll
  for (int r = 0; r < 16; ++r) p1[r] = __builtin_amdgcn_exp2f(p1[r]);
  float ps = p0[0];
#pragma unroll
  for (int r = 1; r < 16; ++r) ps += p0[r];
#pragma unroll
  for (int r = 0; r < 16; ++r) ps += p1[r];
  return ps;
}
__device__ __forceinline__ void softmax_first(f32x16& p0, f32x16& p1, float& m_reg, float& l_reg, float& alpha, f32x16& minit, bf16x8& pa0, bf16x8& pa1, bf16x8& pa2, bf16x8& pa3) {
  const float pmax = rowmax32(p0, p1);
  m_reg = pmax; alpha = 1.f;
#pragma unroll
  for (int r = 0; r < 16; ++r) { minit[r] = -pmax; p0[r] -= pmax; p1[r] -= pmax; }
  l_reg = expsum32(p0, p1);
  PK4S(p0, 0, pa0); PK4S(p0, 8, pa1); PK4S(p1, 0, pa2); PK4S(p1, 8, pa3);
}
__device__ __forceinline__ bool softmax_seeded(f32x16& p0, f32x16& p1, float& m_reg, float& l_reg, float& alpha, f32x16& minit, bf16x8& pa0, bf16x8& pa1, bf16x8& pa2, bf16x8& pa3) {
  const float pown = ownmax32(p0, p1); bool moved = false;
  if (__builtin_expect(__all(pown <= THR * 1.4426950408889634f), 1)) { alpha = 1.f; }
  else { moved = true; const float pmax = xhalf_max(pown); const float d = fmaxf(pmax, 0.f); alpha = __builtin_amdgcn_exp2f(-d); m_reg += d;
#pragma unroll
    for (int r = 0; r < 16; ++r) { p0[r] -= d; p1[r] -= d; minit[r] = -m_reg; } }
  const float ps = expsum32(p0, p1);
  l_reg = l_reg * alpha + ps;
  PK4S(p0, 0, pa0); PK4S(p0, 8, pa1); PK4S(p1, 0, pa2); PK4S(p1, 8, pa3);
  return moved;
}
#undef PK4S
__device__ __forceinline__ bf16x8 scale_bf16x8(bf16x8 v, float c) {
  v4u u = *reinterpret_cast<v4u*>(&v), w;
#pragma unroll
  for (int i = 0; i < 4; ++i) { const float lo = __uint_as_float(u[i] << 16) * c, hi = __uint_as_float(u[i] & 0xffff0000u) * c; w[i] = cvtpk(lo, hi); }
  return *reinterpret_cast<bf16x8*>(&w);
}
typedef short v4i16_t __attribute__((ext_vector_type(4)));
__device__ __forceinline__ s16x4 vtr(int addr) { return __builtin_bit_cast(s16x4, __builtin_amdgcn_ds_read_tr16_b64_v4i16((__attribute__((address_space(3))) v4i16_t*)(uintptr_t)(unsigned)addr)); }
template <int DQK, bool HAVE_QK, bool SEED>
__device__ __forceinline__ void mseg(f32x16* o, f32x16& p0, f32x16& p1, const f32x16& minit, const char* Ks, int vb, const bf16x8* qr, bf16x8 pa0, bf16x8 pa1, bf16x8 pa2, bf16x8 pa3, int r32, int hi) {
  constexpr int CH = DQK == 192 ? 2 : DQK / 64;
  s16x4 va[8], vbq[8]; bf16x8 ka[2 * CH], kb[2 * CH];
#define VRD(dst, D0) do { _Pragma("unroll") for (int ks = 0; ks < 4; ++ks) { dst[2 * ks] = vtr(vb + v_rd_off(D0, ks, 0)); dst[2 * ks + 1] = vtr(vb + v_rd_off(D0, ks, 1)); } } while (0)
#define KRD(dst, C) do { _Pragma("unroll") for (int i = 0; i < CH; ++i) { const int cb = (((C) * CH + i) * 16 + hi * 8) * 2; \
    dst[2 * i] = *reinterpret_cast<const bf16x8*>(Ks + kswz<DQK>(r32, cb)); dst[2 * i + 1] = *reinterpret_cast<const bf16x8*>(Ks + kswz<DQK>(32 + r32, cb)); } } while (0)
#define PKV(L, H) (bf16x8){L[0], L[1], L[2], L[3], H[0], H[1], H[2], H[3]}
#define PVM(src, D0) do { o[D0] = __builtin_amdgcn_mfma_f32_32x32x16_bf16(pa0, PKV(src[0], src[1]), o[D0], 0, 0, 0); o[D0] = __builtin_amdgcn_mfma_f32_32x32x16_bf16(pa1, PKV(src[2], src[3]), o[D0], 0, 0, 0); \
    o[D0] = __builtin_amdgcn_mfma_f32_32x32x16_bf16(pa2, PKV(src[4], src[5]), o[D0], 0, 0, 0); o[D0] = __builtin_amdgcn_mfma_f32_32x32x16_bf16(pa3, PKV(src[6], src[7]), o[D0], 0, 0, 0); } while (0)
#define QKM(src, C) do { _Pragma("unroll") for (int i = 0; i < CH; ++i) { p0 = __builtin_amdgcn_mfma_f32_32x32x16_bf16(src[2 * i], qr[(C) * CH + i], p0, 0, 0, 0); \
    p1 = __builtin_amdgcn_mfma_f32_32x32x16_bf16(src[2 * i + 1], qr[(C) * CH + i], p1, 0, 0, 0); } } while (0)
  if constexpr (HAVE_QK) { if constexpr (SEED) { p0 = minit; p1 = minit; } else { p0 = f32x16{}; p1 = f32x16{}; } }
#define IL_PV() do { _Pragma("unroll") for (int g_ = 0; g_ < 4; ++g_) { __builtin_amdgcn_sched_group_barrier(0x008, 1, 0); __builtin_amdgcn_sched_group_barrier(0x100, 2, 0); } } while (0)
#define IL_QK() do { _Pragma("unroll") for (int g_ = 0; g_ < 2 * CH; ++g_) { __builtin_amdgcn_sched_group_barrier(0x008, 1, 0); __builtin_amdgcn_sched_group_barrier(0x100, 1, 0); } } while (0)
  __builtin_amdgcn_s_setprio(1);
  if constexpr (DQK != 192) {
    VRD(va, 0); if constexpr (HAVE_QK) KRD(ka, 0); SBAR();
    VRD(vbq, 1); PVM(va, 0); IL_PV(); SBAR();
    if constexpr (HAVE_QK) { KRD(kb, 1); QKM(ka, 0); IL_QK(); SBAR(); }
    VRD(va, 2); PVM(vbq, 1); IL_PV(); SBAR();
    if constexpr (HAVE_QK) { KRD(ka, 2); QKM(kb, 1); IL_QK(); SBAR(); }
    VRD(vbq, 3); PVM(va, 2); IL_PV(); SBAR();
    if constexpr (HAVE_QK) { KRD(kb, 3); QKM(ka, 2); IL_QK(); SBAR(); }
    PVM(vbq, 3); SBAR();
    if constexpr (HAVE_QK) { QKM(kb, 3); SBAR(); }
  } else {
    VRD(va, 0); if constexpr (HAVE_QK) KRD(ka, 0); SBAR();
    VRD(vbq, 1); PVM(va, 0); IL_PV(); SBAR();
    if constexpr (HAVE_QK) { KRD(kb, 1); QKM(ka, 0); IL_QK(); SBAR(); }
    VRD(va, 2); PVM(vbq, 1); IL_PV(); SBAR();
    if constexpr (HAVE_QK) { KRD(ka, 2); QKM(kb, 1); IL_QK(); SBAR(); KRD(kb, 3); QKM(ka, 2); IL_QK(); SBAR(); }
    VRD(vbq, 3); PVM(va, 2); IL_PV(); SBAR();
    if constexpr (HAVE_QK) { KRD(ka, 4); QKM(kb, 3); IL_QK(); SBAR(); KRD(kb, 5); QKM(ka, 4); IL_QK(); SBAR(); }
    PVM(vbq, 3); SBAR();
    if constexpr (HAVE_QK) { QKM(kb, 5); SBAR(); }
  }
  __builtin_amdgcn_s_setprio(0);
#undef IL_PV
#undef IL_QK
#undef VRD
#undef KRD
#undef PKV
#undef PVM
#undef QKM
}
template <bool HAVE_QK, bool SEED>
__device__ __forceinline__ void mseg192(f32x16* o, f32x16& p0, f32x16& p1, const f32x16& minit, const char* Ks, int vb, const bf16x8* qr, bf16x8 pa0, bf16x8 pa1, bf16x8 pa2, bf16x8 pa3, int r32, int hi) {
  bf16x8 b0x, b0y, b1x, b1y, b2x, b2y;
#define PKV(L, H) (bf16x8){L[0], L[1], L[2], L[3], H[0], H[1], H[2], H[3]}
#define MF32(a, b, c) __builtin_amdgcn_mfma_f32_32x32x16_bf16(a, b, c, 0, 0, 0)
#define SGB(m, n) __builtin_amdgcn_sched_group_barrier(m, n, 0)
  if constexpr (HAVE_QK) { if constexpr (SEED) { p0 = minit; p1 = minit; } else { p0 = f32x16{}; p1 = f32x16{}; } }
  __builtin_amdgcn_s_setprio(1);
  if constexpr (HAVE_QK) {
    b0x = PKV(vtr(vb + v_rd_off(0, 0, 0)), vtr(vb + v_rd_off(0, 0, 1))); b0y = PKV(vtr(vb + v_rd_off(0, 1, 0)), vtr(vb + v_rd_off(0, 1, 1)));
    { const int cb = (0 * 16 + hi * 8) * 2; b1x = *reinterpret_cast<const bf16x8*>(Ks + kswz<192>(r32, cb)); b1y = *reinterpret_cast<const bf16x8*>(Ks + kswz<192>(32 + r32, cb)); }
    SBAR();
    b2x = PKV(vtr(vb + v_rd_off(0, 2, 0)), vtr(vb + v_rd_off(0, 2, 1))); b2y = PKV(vtr(vb + v_rd_off(0, 3, 0)), vtr(vb + v_rd_off(0, 3, 1))); o[0] = MF32(pa0, b0x, o[0]); o[0] = MF32(pa1, b0y, o[0]); SGB(0x008, 1); SGB(0x100, 2); SGB(0x008, 1); SGB(0x100, 2); SBAR();
    { const int cb = (1 * 16 + hi * 8) * 2; b0x = *reinterpret_cast<const bf16x8*>(Ks + kswz<192>(r32, cb)); b0y = *reinterpret_cast<const bf16x8*>(Ks + kswz<192>(32 + r32, cb)); } p0 = MF32(b1x, qr[0], p0); p1 = MF32(b1y, qr[0], p1); SGB(0x008, 1); SGB(0x100, 1); SGB(0x008, 1); SGB(0x100, 1); SBAR();
    { const int cb = (2 * 16 + hi * 8) * 2; b1x = *reinterpret_cast<const bf16x8*>(Ks + kswz<192>(r32, cb)); b1y = *reinterpret_cast<const bf16x8*>(Ks + kswz<192>(32 + r32, cb)); } o[0] = MF32(pa2, b2x, o[0]); o[0] = MF32(pa3, b2y, o[0]); SGB(0x008, 1); SGB(0x100, 1); SGB(0x008, 1); SGB(0x100, 1); SBAR();
    b2x = PKV(vtr(vb + v_rd_off(1, 0, 0)), vtr(vb + v_rd_off(1, 0, 1))); b2y = PKV(vtr(vb + v_rd_off(1, 1, 0)), vtr(vb + v_rd_off(1, 1, 1))); p0 = MF32(b0x, qr[1], p0); p1 = MF32(b0y, qr[1], p1); SGB(0x008, 1); SGB(0x100, 2); SGB(0x008, 1); SGB(0x100, 2); SBAR();
    { const int cb = (3 * 16 + hi * 8) * 2; b0x = *reinterpret_cast<const bf16x8*>(Ks + kswz<192>(r32, cb)); b0y = *reinterpret_cast<const bf16x8*>(Ks + kswz<192>(32 + r32, cb)); } p0 = MF32(b1x, qr[2], p0); p1 = MF32(b1y, qr[2], p1); SGB(0x008, 1); SGB(0x100, 1); SGB(0x008, 1); SGB(0x100, 1); SBAR();
    b1x = PKV(vtr(vb + v_rd_off(1, 2, 0)), vtr(vb + v_rd_off(1, 2, 1))); b1y = PKV(vtr(vb + v_rd_off(1, 3, 0)), vtr(vb + v_rd_off(1, 3, 1))); o[1] = MF32(pa0, b2x, o[1]); o[1] = MF32(pa1, b2y, o[1]); SGB(0x008, 1); SGB(0x100, 2); SGB(0x008, 1); SGB(0x100, 2); SBAR();
    { const int cb = (4 * 16 + hi * 8) * 2; b2x = *reinterpret_cast<const bf16x8*>(Ks + kswz<192>(r32, cb)); b2y = *reinterpret_cast<const bf16x8*>(Ks + kswz<192>(32 + r32, cb)); } p0 = MF32(b0x, qr[3], p0); p1 = MF32(b0y, qr[3], p1); SGB(0x008, 1); SGB(0x100, 1); SGB(0x008, 1); SGB(0x100, 1); SBAR();
    { const int cb = (5 * 16 + hi * 8) * 2; b0x = *reinterpret_cast<const bf16x8*>(Ks + kswz<192>(r32, cb)); b0y = *reinterpret_cast<const bf16x8*>(Ks + kswz<192>(32 + r32, cb)); } o[1] = MF32(pa2, b1x, o[1]); o[1] = MF32(pa3, b1y, o[1]); SGB(0x008, 1); SGB(0x100, 1); SGB(0x008, 1); SGB(0x100, 1); SBAR();
    b1x = PKV(vtr(vb + v_rd_off(2, 0, 0)), vtr(vb + v_rd_off(2, 0, 1))); b1y = PKV(vtr(vb + v_rd_off(2, 1, 0)), vtr(vb + v_rd_off(2, 1, 1))); p0 = MF32(b2x, qr[4], p0); p1 = MF32(b2y, qr[4], p1); SGB(0x008, 1); SGB(0x100, 2); SGB(0x008, 1); SGB(0x100, 2); SBAR();
    { const int cb = (6 * 16 + hi * 8) * 2; b2x = *reinterpret_cast<const bf16x8*>(Ks + kswz<192>(r32, cb)); b2y = *reinterpret_cast<const bf16x8*>(Ks + kswz<192>(32 + r32, cb)); } p0 = MF32(b0x, qr[5], p0); p1 = MF32(b0y, qr[5], p1); SGB(0x008, 1); SGB(0x100, 1); SGB(0x008, 1); SGB(0x100, 1); SBAR();
    b0x = PKV(vtr(vb + v_rd_off(2, 2, 0)), vtr(vb + v_rd_off(2, 2, 1))); b0y = PKV(vtr(vb + v_rd_off(2, 3, 0)), vtr(vb + v_rd_off(2, 3, 1))); o[2] = MF32(pa0, b1x, o[2]); o[2] = MF32(pa1, b1y, o[2]); SGB(0x008, 1); SGB(0x100, 2); SGB(0x008, 1); SGB(0x100, 2); SBAR();
    { const int cb = (7 * 16 + hi * 8) * 2; b1x = *reinterpret_cast<const bf16x8*>(Ks + kswz<192>(r32, cb)); b1y = *reinterpret_cast<const bf16x8*>(Ks + kswz<192>(32 + r32, cb)); } p0 = MF32(b2x, qr[6], p0); p1 = MF32(b2y, qr[6], p1); SGB(0x008, 1); SGB(0x100, 1); SGB(0x008, 1); SGB(0x100, 1); SBAR();
    { const int cb = (8 * 16 + hi * 8) * 2; b2x = *reinterpret_cast<const bf16x8*>(Ks + kswz<192>(r32, cb)); b2y = *reinterpret_cast<const bf16x8*>(Ks + kswz<192>(32 + r32, cb)); } o[2] = MF32(pa2, b0x, o[2]); o[2] = MF32(pa3, b0y, o[2]); SGB(0x008, 1); SGB(0x100, 1); SGB(0x008, 1); SGB(0x100, 1); SBAR();
    b0x = PKV(vtr(vb + v_rd_off(3, 0, 0)), vtr(vb + v_rd_off(3, 0, 1))); b0y = PKV(vtr(vb + v_rd_off(3, 1, 0)), vtr(vb + v_rd_off(3, 1, 1))); p0 = MF32(b1x, qr[7], p0); p1 = MF32(b1y, qr[7], p1); SGB(0x008, 1); SGB(0x100, 2); SGB(0x008, 1); SGB(0x100, 2); SBAR();
    { const int cb = (9 * 16 + hi * 8) * 2; b1x = *reinterpret_cast<const bf16x8*>(Ks + kswz<192>(r32, cb)); b1y = *reinterpret_cast<const bf16x8*>(Ks + kswz<192>(32 + r32, cb)); } p0 = MF32(b2x, qr[8], p0); p1 = MF32(b2y, qr[8], p1); SGB(0x008, 1); SGB(0x100, 1); SGB(0x008, 1); SGB(0x100, 1); SBAR();
    b2x = PKV(vtr(vb + v_rd_off(3, 2, 0)), vtr(vb + v_rd_off(3, 2, 1))); b2y = PKV(vtr(vb + v_rd_off(3, 3, 0)), vtr(vb + v_rd_off(3, 3, 1))); o[3] = MF32(pa0, b0x, o[3]); o[3] = MF32(pa1, b0y, o[3]); SGB(0x008, 1); SGB(0x100, 2); SGB(0x008, 1); SGB(0x100, 2); SBAR();
    { const int cb = (10 * 16 + hi * 8) * 2; b0x = *reinterpret_cast<const bf16x8*>(Ks + kswz<192>(r32, cb)); b0y = *reinterpret_cast<const bf16x8*>(Ks + kswz<192>(32 + r32, cb)); } p0 = MF32(b1x, qr[9], p0); p1 = MF32(b1y, qr[9], p1); SGB(0x008, 1); SGB(0x100, 1); SGB(0x008, 1); SGB(0x100, 1); SBAR();
    { const int cb = (11 * 16 + hi * 8) * 2; b1x = *reinterpret_cast<const bf16x8*>(Ks + kswz<192>(r32, cb)); b1y = *reinterpret_cast<const bf16x8*>(Ks + kswz<192>(32 + r32, cb)); } o[3] = MF32(pa2, b2x, o[3]); o[3] = MF32(pa3, b2y, o[3]); SGB(0x008, 1); SGB(0x100, 1); SGB(0x008, 1); SGB(0x100, 1); SBAR();
    p0 = MF32(b0x, qr[10], p0); p1 = MF32(b0y, qr[10], p1); SBAR();
    p0 = MF32(b1x, qr[11], p0); p1 = MF32(b1y, qr[11], p1); SBAR();
  } else {
    b0x = PKV(vtr(vb + v_rd_off(0, 0, 0)), vtr(vb + v_rd_off(0, 0, 1))); b0y = PKV(vtr(vb + v_rd_off(0, 1, 0)), vtr(vb + v_rd_off(0, 1, 1)));
    b1x = PKV(vtr(vb + v_rd_off(0, 2, 0)), vtr(vb + v_rd_off(0, 2, 1))); b1y = PKV(vtr(vb + v_rd_off(0, 3, 0)), vtr(vb + v_rd_off(0, 3, 1)));
    SBAR();
    b2x = PKV(vtr(vb + v_rd_off(1, 0, 0)), vtr(vb + v_rd_off(1, 0, 1))); b2y = PKV(vtr(vb + v_rd_off(1, 1, 0)), vtr(vb + v_rd_off(1, 1, 1))); o[0] = MF32(pa0, b0x, o[0]); o[0] = MF32(pa1, b0y, o[0]); SGB(0x008, 1); SGB(0x100, 2); SGB(0x008, 1); SGB(0x100, 2); SBAR();
    b0x = PKV(vtr(vb + v_rd_off(1, 2, 0)), vtr(vb + v_rd_off(1, 2, 1))); b0y = PKV(vtr(vb + v_rd_off(1, 3, 0)), vtr(vb + v_rd_off(1, 3, 1))); o[0] = MF32(pa2, b1x, o[0]); o[0] = MF32(pa3, b1y, o[0]); SGB(0x008, 1); SGB(0x100, 2); SGB(0x008, 1); SGB(0x100, 2); SBAR();
    b1x = PKV(vtr(vb + v_rd_off(2, 0, 0)), vtr(vb + v_rd_off(2, 0, 1))); b1y = PKV(vtr(vb + v_rd_off(2, 1, 0)), vtr(vb + v_rd_off(2, 1, 1))); o[1] = MF32(pa0, b2x, o[1]); o[1] = MF32(pa1, b2y, o[1]); SGB(0x008, 1); SGB(0x100, 2); SGB(0x008, 1); SGB(0x100, 2); SBAR();
    b2x = PKV(vtr(vb + v_rd_off(2, 2, 0)), vtr(vb + v_rd_off(2, 2, 1))); b2y = PKV(vtr(vb + v_rd_off(2, 3, 0)), vtr(vb + v_rd_off(2, 3, 1))); o[1] = MF32(pa2, b0x, o[1]); o[1] = MF32(pa3, b0y, o[1]); SGB(0x008, 1); SGB(0x100, 2); SGB(0x008, 1); SGB(0x100, 2); SBAR();
    b0x = PKV(vtr(vb + v_rd_off(3, 0, 0)), vtr(vb + v_rd_off(3, 0, 1))); b0y = PKV(vtr(vb + v_rd_off(3, 1, 0)), vtr(vb + v_rd_off(3, 1, 1))); o[2] = MF32(pa0, b1x, o[2]); o[2] = MF32(pa1, b1y, o[2]); SGB(0x008, 1); SGB(0x100, 2); SGB(0x008, 1); SGB(0x100, 2); SBAR();
    b1x = PKV(vtr(vb + v_rd_off(3, 2, 0)), vtr(vb + v_rd_off(3, 2, 1))); b1y = PKV(vtr(vb + v_rd_off(3, 3, 0)), vtr(vb + v_rd_off(3, 3, 1))); o[2] = MF32(pa2, b2x, o[2]); o[2] = MF32(pa3, b2y, o[2]); SGB(0x008, 1); SGB(0x100, 2); SGB(0x008, 1); SGB(0x100, 2); SBAR();
    o[3] = MF32(pa0, b0x, o[3]); o[3] = MF32(pa1, b0y, o[3]); SBAR();
    o[3] = MF32(pa2, b1x, o[3]); o[3] = MF32(pa3, b1y, o[3]); SBAR();
  }
  __builtin_amdgcn_s_setprio(0);
#undef PKV
#undef MF32
#undef SGB
}
template <int DQK, bool QLDS, int COMB = 0>
__device__ __forceinline__ void attn_unit_pp(const bf16* __restrict__ Qb, int ldq, const bf16* __restrict__ Kh, int ldk, const bf16* __restrict__ Kp, int ldkp,
                                             const bf16* __restrict__ Vh, int ldv, bf16* __restrict__ Ob, int ldo, int seq, char* lds,
                                             const bf16* O0 = nullptr, int ldo0 = 0, float lam = 0.f, const float* sg = nullptr, float cscale = 1.f) {
  constexpr int SHM_V = KVBLK * 128 * 2, SHM_K = KVBLK * DQK * 2, OFF_K = 3 * SHM_V, OFF_W = OFF_K + 2 * SHM_K, OFF_Q = OFF_W + 2048;
  int tid_ = threadIdx.x; asm volatile("" : "+v"(tid_));
  const int tid = tid_, wid = tid >> 6, lane = tid & 63, r32 = lane & 31, hi = lane >> 5;
  const int grp = __builtin_amdgcn_readfirstlane(wid >> 2);
  char* V_lds = lds; char* K_lds = lds + OFF_K;
  float* wsf = (float*)(lds + OFF_W) + wid * 64; float* li_l = wsf; float* al_l = wsf + 32;
  constexpr int NQR = QLDS ? 8 : DQK / 16;
  float m_reg = -1e30f, l_reg = 0; f32x16 o[4] = {}; bf16x8 qr[NQR];
  const bf16* Qw = Qb + (long)(wid * QBLK + r32) * ldq + hi * 8;
#pragma unroll
  for (int d0 = 0; d0 < NQR; ++d0) qr[d0] = ld8(Qw + d0 * 16);
  constexpr bool SEED = SEED_MASK & (DQK == 64 ? 1 : (DQK == 128 ? 2 : 4));
  f32x16 minit = {};
  if constexpr (SEED) { constexpr float QS = (DQK == 64 ? 0.125f : (DQK == 128 ? 0.088388347648318440f : 0.072168783648703220f)) * 1.4426950408889634f;
#pragma unroll
    for (int d0 = 0; d0 < NQR; ++d0) qr[d0] = scale_bf16x8(qr[d0], QS); }
  char* qpe_l = lds + OFF_Q + wid * 4096;
  if constexpr (QLDS) {
#pragma unroll
    for (int d0 = 8; d0 < DQK / 16; ++d0) *(bf16x8*)(qpe_l + kswz<64>(r32, (d0 * 16 + hi * 8) * 2 - 256)) = ld8(Qw + d0 * 16);
  }
  constexpr bool SEED_IMG = SEED_MASK & (DQK == 64 ? 1 : (DQK == 128 ? 2 : 4));
  const int sr = tid >> 4, sc = (tid & 15) * 8, vst0 = SEED_IMG ? v_stn(sr, sc) : v_st(sr, sc), vst1 = SEED_IMG ? v_stn(32 + sr, sc) : v_st(32 + sr, sc);
  const int sr8 = tid >> 3, sc8 = (tid & 7) * 8;
  const int vb0 = (int)(uintptr_t)V_lds + v_rd_base(lane);
  bf16x8 vs0, vs1, ks0, ks1, kp;
  const unsigned vo0 = (unsigned)(sr * ldv + sc) * 2u, vo1 = (unsigned)((32 + sr) * ldv + sc) * 2u;
  const unsigned ko0 = DQK == 64 ? (unsigned)(sr8 * ldk + sc8) * 2u : (unsigned)(sr * ldk + sc) * 2u, ko1 = (unsigned)((32 + sr) * ldk + sc) * 2u;
  const unsigned kpo = DQK == 192 ? (unsigned)(sr8 * ldkp + sc8) * 2u : 0u;
  const __amdgpu_buffer_rsrc_t rV = __builtin_amdgcn_make_buffer_rsrc((void*)Vh, 0, 0x7fffffff, 0x00020000), rK = __builtin_amdgcn_make_buffer_rsrc((void*)Kh, 0, 0x7fffffff, 0x00020000);
  const __amdgpu_buffer_rsrc_t rP = __builtin_amdgcn_make_buffer_rsrc((void*)(DQK == 192 ? Kp : Kh), 0, 0x7fffffff, 0x00020000);
#define BLD(r, vo, so) __builtin_bit_cast(bf16x8, __builtin_amdgcn_raw_buffer_load_b128((r), (int)(vo), (int)(so), 0))
#define PLOAD(k0) do { const unsigned sv_ = (unsigned)(k0) * (unsigned)ldv * 2u, sk_ = (unsigned)(k0) * (unsigned)ldk * 2u; \
    vs0 = BLD(rV, vo0, sv_); vs1 = BLD(rV, vo1, sv_); ks0 = BLD(rK, ko0, sk_); \
    if constexpr (DQK != 64) { ks1 = BLD(rK, ko1, sk_); } \
    if constexpr (DQK == 192) { kp = BLD(rP, kpo, (unsigned)(k0) * (unsigned)ldkp * 2u); } } while (0)
#define PWRITE(koff, voff) do { *(bf16x8*)(V_lds + (voff) + vst0) = vs0; *(bf16x8*)(V_lds + (voff) + vst1) = vs1; \
    if constexpr (DQK == 64) { *(bf16x8*)(K_lds + (koff) + kswz<DQK>(sr8, sc8 * 2)) = ks0; } \
    else { *(bf16x8*)(K_lds + (koff) + kswz<DQK>(sr, sc * 2)) = ks0; *(bf16x8*)(K_lds + (koff) + kswz<DQK>(32 + sr, sc * 2)) = ks1; } \
    if constexpr (DQK == 192) { *(bf16x8*)(K_lds + (koff) + kswz<DQK>(sr8, 256 + sc8 * 2)) = kp; } } while (0)
#define PRESC(a) do { if (__any((a) < 1.f)) { if (hi == 0) al_l[r32] = (a); asm volatile("s_waitcnt lgkmcnt(0)" ::: "memory"); \
    _Pragma("unroll") for (int d = 0; d < 4; ++d) _Pragma("unroll") for (int r = 0; r < 16; ++r) o[d][r] *= al_l[crow(r, hi)]; } } while (0)
#define PBAR() do { __builtin_amdgcn_sched_barrier(0); asm volatile("s_waitcnt lgkmcnt(0)" ::: "memory"); __builtin_amdgcn_s_barrier(); asm volatile("" ::: "memory"); __builtin_amdgcn_sched_barrier(0); } while (0)
  f32x16 p0, p1; float al; bf16x8 pa0, pa1, pa2, pa3; const int NT = seq / KVBLK;
  constexpr bool SM = false;
  PLOAD(0); PWRITE(0, 0); PLOAD(KVBLK); PWRITE(SHM_K, SHM_V);
  if ((SM || grp == 1) && 2 < NT) PLOAD(2 * KVBLK);
  PBAR();
  if (grp == 1) PBAR();
  const int LD = 2 + grp;
  int vw = SM ? 2 * SHM_V : (LD - 1) * SHM_V;
  SBAR(); qkt<DQK, QLDS>(p0, p1, K_lds, qr, qpe_l, r32, hi);
  PBAR();
  if constexpr (SEED) softmax_first(p0, p1, m_reg, l_reg, al, minit, pa0, pa1, pa2, pa3); else softmax_tile<DQK>(p0, p1, m_reg, l_reg, al, pa0, pa1, pa2, pa3);
  if constexpr (!SM) { const int u = LD - 1; if (u >= 2 && u < NT) PWRITE((u & 1) * SHM_K, vw); if (u + 1 >= 2 && u + 1 < NT) PLOAD((u + 1) * KVBLK);
    vw += SHM_V; if (vw == 3 * SHM_V) vw = 0; }
  PBAR();
  int vr = 0;
  for (int t = 0; t < NT; ++t) {
    SBAR();
    static_assert(!QLDS, "the ping-pong MFMA segment keeps all of Q in registers");
    if constexpr (DQK == 192 && M192) {
      if (t + 1 < NT) mseg192<true, SEED>(o, p0, p1, minit, K_lds + ((t + 1) & 1) * SHM_K, vb0 + vr, qr, pa0, pa1, pa2, pa3, r32, hi);
      else mseg192<false, SEED>(o, p0, p1, minit, K_lds, vb0 + vr, qr, pa0, pa1, pa2, pa3, r32, hi);
    } else {
      if (t + 1 < NT) mseg<DQK, true, SEED>(o, p0, p1, minit, K_lds + ((t + 1) & 1) * SHM_K, vb0 + vr, qr, pa0, pa1, pa2, pa3, r32, hi);
      else mseg<DQK, false, SEED>(o, p0, p1, minit, K_lds, vb0 + vr, qr, pa0, pa1, pa2, pa3, r32, hi);
    }
    vr += SHM_V; if (vr == 3 * SHM_V) vr = 0;
    if constexpr (SM) { const int u = t + 2; if (u < NT) PWRITE((u & 1) * SHM_K, vw); if (u + 1 < NT) PLOAD((u + 1) * KVBLK);
      vw += SHM_V; if (vw == 3 * SHM_V) vw = 0; }
    PBAR();
    if (t + 1 < NT) { if constexpr (SEED) { if (softmax_seeded(p0, p1, m_reg, l_reg, al, minit, pa0, pa1, pa2, pa3)) PRESC(al); } else { softmax_tile<DQK>(p0, p1, m_reg, l_reg, al, pa0, pa1, pa2, pa3); PRESC(al); } }
    if constexpr (!SM) { const int u = t + LD; if (u < NT) PWRITE((u & 1) * SHM_K, vw); if (u + 1 < NT) PLOAD((u + 1) * KVBLK);
      vw += SHM_V; if (vw == 3 * SHM_V) vw = 0; }
    PBAR();
  }
  if (grp == 0) PBAR();
  if constexpr (SEED) { auto rr = __builtin_amdgcn_permlane32_swap(__float_as_uint(l_reg), __float_as_uint(l_reg), false, false); l_reg = __uint_as_float(rr[0]) + __uint_as_float(rr[1]); }
  if (hi == 0) li_l[r32] = l_reg; asm volatile("s_waitcnt lgkmcnt(0)" ::: "memory");
  float rli[16];
#pragma unroll
  for (int r = 0; r < 16; ++r) rli[r] = __builtin_amdgcn_rcpf(li_l[crow(r, hi)]);
  bf16* Ow = Ob + (long)(wid * QBLK) * ldo;
  if constexpr (COMB == 2) {
    const bf16* O0w = O0 + (long)(wid * QBLK) * ldo0; float g4[4];
#pragma unroll
    for (int d0 = 0; d0 < 4; ++d0) g4[d0] = sg[d0 * 32 + r32] * cscale;
#pragma unroll
    for (int r = 0; r < 16; ++r) { const int orow = crow(r, hi); float v[4]; float ss = 0.f;
#pragma unroll
      for (int d0 = 0; d0 < 4; ++d0) { v[d0] = bf2f(O0w[(long)orow * ldo0 + d0 * 32 + r32]) - lam * bf2f((bf16)f2bf(o[d0][r] * rli[r])); ss += v[d0] * v[d0]; }
#pragma unroll
      for (int sft = 1; sft < 32; sft <<= 1) ss += __shfl_xor(ss, sft);
      const float rstd = rsqrtf(ss * (1.0f / 128.0f) + EPS);
#pragma unroll
      for (int d0 = 0; d0 < 4; ++d0) Ow[(long)orow * ldo + d0 * 32 + r32] = (bf16)f2bf(v[d0] * rstd * g4[d0]); }
  } else {
#pragma unroll
    for (int r = 0; r < 16; ++r) { const int orow = crow(r, hi);
#pragma unroll
      for (int d0 = 0; d0 < 4; ++d0) Ow[(long)orow * ldo + d0 * 32 + r32] = (bf16)f2bf(o[d0][r] * rli[r]); }
  }
#undef PLOAD
#undef BLD
#undef PWRITE
#undef PRESC
#undef PBAR
}
}

#define GRID_BAR() xcd_barrier(bar)
#define GEMM_PHASE_E(EpiT, Einit, Aptr, Btptr, Mm, Nn, Kk) do { pg8::Gemm g_{(const bf16*)(Aptr), (const bf16*)(Btptr), (Mm), (Nn), (Kk), (Kk), (Kk)}; pg8::StaticOrder S_; S_.init((Mm), (Nn), (int)gridDim.x, (int)blockIdx.x); \
    const EpiT E_ Einit; pg8::gemm_phase<EpiT, pg8::StaticOrder, true, true>((LAS unsigned char*)lds, g_, S_, E_); } while (0)
#define GEMM_PHASE_EL(EpiT, Einit, Aptr, Lda, Btptr, Mm, Nn, Kk) do { pg8::Gemm g_{(const bf16*)(Aptr), (const bf16*)(Btptr), (Mm), (Nn), (Kk), (Lda), (Kk)}; pg8::StaticOrder S_; S_.init((Mm), (Nn), (int)gridDim.x, (int)blockIdx.x); \
    const EpiT E_ Einit; pg8::gemm_phase<EpiT, pg8::StaticOrder, true, true>((LAS unsigned char*)lds, g_, S_, E_); } while (0)
#define GEMM_PHASE(Aptr, Btptr, Mm, Nn, Kk, Optr) do { pg8::Gemm g_{(const bf16*)(Aptr), (const bf16*)(Btptr), (Mm), (Nn), (Kk), (Kk), (Kk)}; pg8::StaticOrder S_; S_.init((Mm), (Nn), (int)gridDim.x, (int)blockIdx.x); \
    pg8::EpiBf16 E_{(bf16*)(Optr), (Nn)}; pg8::gemm_phase<pg8::EpiBf16, pg8::StaticOrder, true, true>((LAS unsigned char*)lds, g_, S_, E_); } while (0)

#define GEMM2048_PHASE(Aptr, Btptr, Kk) do { \
    { pg8::Gemm g_{(const bf16*)(Aptr), (const bf16*)(Btptr), MSPLIT, 2048, (Kk), (Kk), (Kk)}; pg8::StaticOrder S_; S_.init(MSPLIT, 2048, (int)gridDim.x, (int)blockIdx.x); \
      pg8::EpiBf16 E_{(bf16*)(ws + WS_T), 2048}; pg8::gemm_phase<pg8::EpiBf16, pg8::StaticOrder, true, true>((LAS unsigned char*)lds, g_, S_, E_); } \
    { const int G_ = (int)gridDim.x, bx_ = (int)blockIdx.x; \
      for (int hu_ = (G_ % 8 == 0) ? (bx_ % 8) * (G_ / 8) + bx_ / 8 : bx_; hu_ < 2 * ((M - MSPLIT) / 256) * 8; hu_ += G_) { const int tile_ = hu_ >> 1, kh_ = hu_ & 1; \
        pg8::Gemm g_{(const bf16*)(Aptr) + kh_ * ((Kk) / 2), (const bf16*)(Btptr) + kh_ * ((Kk) / 2), M, 2048, (Kk) / 2, (Kk), (Kk)}; pg8::OneUnit S_{{MSPLIT / 256 + (tile_ >> 3), tile_ & 7}}; \
        pg8::EpiBf16 E_{(bf16*)(ws + WS_SLAB) + (size_t)kh_ * SLAB_ELEMS - (size_t)MSPLIT * 2048, 2048}; pg8::gemm_phase<pg8::EpiBf16, pg8::OneUnit, true, true>((LAS unsigned char*)lds, g_, S_, E_); } } } while (0)

#ifndef ATT_SD_A
#define ATT_SD_A 1
#endif
#ifndef ATT_QLDS_A
#define ATT_QLDS_A false
#endif
template <int KIND> __device__ __forceinline__ void attn_phase(const Params& P, unsigned char* ldsp) {
    const Frame F = make_frame(ldsp);
    unsigned char* R = P.ws + WS_R; bf16* AO = (bf16*)(P.ws + WS_AO); char* lds = (char*)ldsp;
    if constexpr (KIND == 0) {
        const bf16* Q = (const bf16*)(R + R_A_Q); const bf16* KV = (const bf16*)(R + R_A_KV); const bf16* KPEF = (const bf16*)(R + R_A_KPEF);
        for (int u = F.vcu; u < 1280; u += F.G) {
            int m0, kr0, seq, h;
            if (u < 1024) { const int mb = u >> 8, qb = u & 15; h = (u >> 4) & 15; m0 = MP + mb * DSEQ + qb * 256; kr0 = MP + mb * LSEQ; seq = LSEQ; }
            else { const int v = u - 1024, pb = v >> 4; h = v & 15; m0 = pb * 256; kr0 = pb * 256; seq = SEQ; }
            att::attn_unit_pp<192, false>(Q + (size_t)m0 * 3072 + h * 192, 3072, KV + (size_t)kr0 * 4096 + h * 256, 4096, KPEF + (size_t)kr0 * 64, 64,
                                KV + (size_t)kr0 * 4096 + h * 256 + 128, 4096, AO + (size_t)m0 * 2048 + h * 128, 2048, seq, lds);
            __syncthreads();
        }
    } else if constexpr (KIND == 1) {
        const bf16* QB = (const bf16*)(R + R_B_Q); const bf16* KF = (const bf16*)(R + R_B_KF); const bf16* VF = (const bf16*)(R + R_B_VF); bf16* OC = (bf16*)(R + R_B_OC);
        const float lam = ((const float*)(P.ws + WS_MISC))[0];
        for (int u = F.vcu; u < 1280; u += F.G) {
            int m0, kr0, seq, h;
            if (u < 1024) { const int mb = u >> 8, qb = u & 15; h = (u >> 4) & 15; m0 = MP + mb * DSEQ + qb * 256; kr0 = MP + mb * LSEQ; seq = LSEQ; }
            else { const int v = u - 1024, pb = v >> 4; h = v & 15; m0 = pb * 256; kr0 = pb * 256; seq = SEQ; }
            att::attn_unit_pp<64, false, 1>(QB + (size_t)m0 * 2048 + h * 128, 2048, KF + (size_t)kr0 * 2048 + h * 128, 2048, nullptr, 0,
                               VF + (size_t)kr0 * 2048 + h * 128, 2048, OC + (size_t)m0 * 2048 + h * 128, 2048, seq, lds);
            __syncthreads();
            att::attn_unit_pp<64, false, 2>(QB + (size_t)m0 * 2048 + h * 128 + 64, 2048, KF + (size_t)kr0 * 2048 + h * 128 + 64, 2048, nullptr, 0,
                               VF + (size_t)kr0 * 2048 + h * 128, 2048, AO + (size_t)m0 * 2048 + h * 128, 2048, seq, lds,
                               OC + (size_t)m0 * 2048 + h * 128, 2048, lam, P.in[I_BSUBLN], 1.0f - LAM_INIT_1);
            __syncthreads();
        }
    } else {
        const bf16* QC = (const bf16*)(R + R_C_Q); const bf16* KF = (const bf16*)(R + R_C_KF); const bf16* VF = (const bf16*)(R + R_C_VF);
        for (int u = F.vcu; u < 1280; u += F.G) {
            int m0, kr0, seq, h;
            if (u < 1024) { const int mb = u >> 8, qb = u & 15; h = (u >> 4) & 15; m0 = MP + mb * DSEQ + qb * 256; kr0 = MP + mb * LSEQ; seq = LSEQ; }
            else { const int v = u - 1024, pb = v >> 4; h = v & 15; m0 = pb * 256; kr0 = pb * 256; seq = SEQ; }
            att::attn_unit_pp<128, false>(QC + (size_t)m0 * 2048 + h * 128, 2048, KF + (size_t)kr0 * 512 + (h >> 2) * 128, 512, nullptr, 0,
                                VF + (size_t)kr0 * 512 + (h >> 2) * 128, 512, AO + (size_t)m0 * 2048 + h * 128, 2048, seq, lds);
            __syncthreads();
        }
    }
}

template <int L> __device__ __forceinline__ void layer(const Params& P, unsigned char* lds, const XcdBarrier& bar) {
    constexpr int KIND = L % 3, J = L / 3;
    unsigned char* ws = P.ws; unsigned char* R = ws + WS_R;
    bf16* H = (bf16*)(ws + WS_H); bf16* T = (bf16*)(ws + WS_T); bf16* AO = (bf16*)(ws + WS_AO);
    const float* MOD = (const float*)(ws + WS_MOD); const float* MODl = MOD + (size_t)L * 5 * 12288;
    const float* ng = P.in[I_NORMG] + (size_t)L * 4 * D;
    if constexpr (KIND == 0) {
        mla_cache_rows(P, lds, J);
        GEMM_PHASE_E(EpiMlaDown, ({(bf16*)(R + R_A_D1), (float*)(R + R_A_SSP), (bf16*)(R + R_A_CKVF), (bf16*)(R + R_A_KPEF), P.out + O_SA_CKV, P.out + O_SA_KPE, P.in[I_AKVN] + J * 256, (const float*)(ws + WS_MISC) + 256,
                      (LAS float*)((LAS unsigned char*)lds + EPI_LDS_OFF), J}), H, ws + WS_W_A_DOWN + (size_t)J * 4 * MiB, M, 1024, 2048); GRID_BAR();
        GEMM_PHASE_EL(EpiMlaQ, ({(bf16*)(R + R_A_Q), (const float*)(ws + WS_MISC) + 256, (const float*)(R + R_A_SSP), (LAS float*)((LAS unsigned char*)lds + EPI_LDS_OFF)}), R + R_A_D1, 1024, ws + WS_W_A_UQ + (size_t)J * 3 * MiB, M, 3072, 512);
        GEMM_PHASE(R + R_A_CKVF, ws + WS_W_A_UKV + (size_t)J * 2 * MiB, LKV, 4096, 256, R + R_A_KV); GRID_BAR();
        attn_phase<0>(P, lds); GRID_BAR();
        GEMM2048_PHASE(AO, ws + WS_W_A_O + (size_t)J * 8 * MiB, 2048); GRID_BAR();
    } else if constexpr (KIND == 1) {
        diff_cache_rows(P, lds);
        GEMM_PHASE_E(EpiDiffQKV, ({(bf16*)(R + R_B_Q), (bf16*)(R + R_B_KF), (bf16*)(R + R_B_VF), P.out + O_SB_K, P.out + O_SB_V, (const float*)(ws + WS_MISC) + 256}), H, ws + WS_W_B_QKV, M, 6144, 2048); GRID_BAR();
        attn_phase<1>(P, lds); GRID_BAR();
        GEMM2048_PHASE(AO, ws + WS_W_B_O, 2048); GRID_BAR();
    } else {
        gqa_cache_rows(P, lds);
        GEMM_PHASE_E(EpiGqaQKV, ({(bf16*)(R + R_C_Q), (bf16*)(R + R_C_KF), (bf16*)(R + R_C_VF), P.out + O_SC_K, P.out + O_SC_V, (const float*)(ws + WS_MISC) + 4096, P.in[I_CQN], P.in[I_CKN], (LAS float*)((LAS unsigned char*)lds + EPI_LDS_OFF)}), H, ws + WS_W_C_QKV, M, 3072, 2048); GRID_BAR();
        attn_phase<2>(P, lds); GRID_BAR();
        GEMM2048_PHASE(AO, ws + WS_W_C_O, 2048); GRID_BAR();
    }
    resnorm_phase<true, true, L == 0, false>(P, lds, T, ng + 1 * D, MODl, 2, ng + 2 * D, MODl, 3, 4, H); GRID_BAR();
    GEMM_PHASE_E(EpiConvGate, ({(bf16*)(R + R_G), (float*)(ws + WS_EDGE), P.in[I_FCW] + (size_t)L * 3 * NFF, P.in[I_FCB] + (size_t)L * NFF, (LAS float*)((LAS unsigned char*)lds + EPI_LDS_OFF)}), H, ws + WS_W_FIN + (size_t)L * 44 * MiB, M, NFF, 2048); GRID_BAR();
    conv_fix_phase(P, lds, L); GRID_BAR();
    GEMM2048_PHASE(R + R_G, ws + WS_W_FDN + (size_t)L * 22 * MiB, DFF); GRID_BAR();
    if constexpr (L < 3) { resnorm_phase<true, true, false, false>(P, lds, T, ng + 3 * D, MODl, 5, ng + 4 * D, MODl + 5 * 12288, 0, 1, H); GRID_BAR(); }
    else resnorm_phase<true, false, false, true>(P, lds, T, ng + 3 * D, MODl, 5, nullptr, nullptr, 0, 0, nullptr);
}

__global__ void __launch_bounds__(NWAVES * 64, 2) mk_fwd(Params P) {
    extern __shared__ __attribute__((aligned(16))) unsigned char lds[];
    volatile LAS unsigned* MISC = (volatile LAS unsigned*)((LAS unsigned char*)lds + MISC_OFF);
    for (int u = threadIdx.x; u < (LDS_BYTES - LDSCTL_OFF) / 4; u += NWAVES * 64) ((LAS unsigned*)((LAS unsigned char*)lds + LDSCTL_OFF))[u] = 0u;
    __syncthreads();
    unsigned* ctl = (unsigned*)(P.ws + WS_CTL);
    XcdBarrier bar = xcd_barrier_post(ctl + CW_BAR, MISC + 8);

    p0_prologue(P, lds); GRID_BAR();
    { const float* MOD = (const float*)(P.ws + WS_MOD); const float* ng = P.in[I_NORMG];
      resnorm_phase<false, true, true, false>(P, lds, nullptr, nullptr, nullptr, 0, ng, MOD, 0, 1, (bf16*)(P.ws + WS_H)); GRID_BAR(); }
    layer<0>(P, lds, bar);
    layer<1>(P, lds, bar);
    layer<2>(P, lds, bar);
    layer<3>(P, lds, bar);
}

extern "C" void kernel_launch(void* const* d_in, const int* in_sizes, int n_in, void* d_out, int out_size, void* d_ws, size_t ws_size, hipStream_t stream) {
    static int grid = 0;
    if (grid == 0) {
        if (n_in != 31 || (size_t)out_size != O_END || ws_size < WS_END) { fprintf(stderr, "kernel_launch: unexpected shapes: n_in %d out %d ws %zu (need >= %zu)\n", n_in, out_size, ws_size, (size_t)WS_END); grid = -1; return; }
        int dev = 0, cus = 0, per_cu = 0;
        if (hipGetDevice(&dev) != hipSuccess || hipDeviceGetAttribute(&cus, hipDeviceAttributeMultiprocessorCount, dev) != hipSuccess) { grid = -1; return; }
        if (hipFuncSetAttribute((const void*)mk_fwd, hipFuncAttributeMaxDynamicSharedMemorySize, LDS_BYTES) != hipSuccess) { fprintf(stderr, "kernel_launch: hipFuncSetAttribute failed\n"); grid = -1; return; }
        if (hipOccupancyMaxActiveBlocksPerMultiprocessor(&per_cu, (const void*)mk_fwd, NWAVES * 64, LDS_BYTES) != hipSuccess || per_cu < 1) { fprintf(stderr, "kernel_launch: occupancy query says %d\n", per_cu); }
        (void)hipGetLastError();
        grid = cus;
    }
    if (grid < 0) return;
    (void)hipMemsetAsync((char*)d_ws + WS_CTL, 0, CTL_ZERO_BYTES, stream);
    Params p{};
    for (int i = 0; i < 31; ++i) p.in[i] = (const float*)d_in[i];
    p.out = (float*)d_out; p.ws = (unsigned char*)d_ws;
    hipLaunchKernelGGL(mk_fwd, dim3(grid), dim3(NWAVES * 64), LDS_BYTES, stream, p);
    const hipError_t le = hipPeekAtLastError();
    if (le != hipSuccess) fprintf(stderr, "kernel_launch: launch failed: %s\n", hipGetErrorName(le));
}
```

```cpp
#include <hip/hip_runtime.h>
#include <cstdio>
#include <cstdint>

namespace pg8 {
#define PG8_LAS __attribute__((address_space(3)))
typedef unsigned short bf16_t;
typedef short bf16x8 __attribute__((ext_vector_type(8)));
typedef float f32x4 __attribute__((ext_vector_type(4)));
typedef unsigned u32x4 __attribute__((ext_vector_type(4)));
constexpr int BM = 256, BK = 64, HALF = 128, HTB = HALF * BK * 2  , STAGE_BYTES = 8 * HTB, NXCD = 8, WGM = 8;

__host__ __device__ __forceinline__ int lds_byte(int r, int c) { const int st = (r >> 4) * 2 + (c >> 5), rr = r & 15, cc = c & 31, ob = rr * 64 + cc * 2; return st * 1024 + (ob ^ (((ob >> 9) & 1) << 5)); }
__host__ __device__ __forceinline__ void stage_rc(int b, int& R, int& C) { const int st = b / 1024, sb = b % 1024, swz = sb ^ (((sb >> 9) & 1) << 5); R = (st >> 1) * 16 + swz / 64; C = (st & 1) * 32 + (swz % 64) / 2; }
__host__ __device__ __forceinline__ int perm32(int rho) { const int n = rho >> 4, i = rho & 15; return 8 * (i >> 2) + 4 * n + (i & 3); }

struct Unit { int pm, pn; };
struct Gemm { const bf16_t* A; const bf16_t* Bt; int M, N, K, lda, ldb; };

struct StaticOrder {
    int nM, nN, nwg, G, c;
    __host__ __device__ void init(int M, int N, int G_, int c_) { nM = M / BM; nN = N / BM; nwg = nM * nN; G = G_; c = c_; }
    __host__ __device__ bool next(int i, Unit& u) const {
        const long L = (long)i * G + c; if (L >= nwg) return false;
        int wgid = (int)L; { const int q = nwg / NXCD, r = nwg % NXCD, xcd = wgid % NXCD, off = wgid / NXCD; wgid = (xcd < r ? xcd * (q + 1) : r * (q + 1) + (xcd - r) * q) + off; }
        const int nig = WGM * nN, gid = wgid / nig, fm = gid * WGM, gsz = (nM - fm) < WGM ? (nM - fm) : WGM;
        u.pm = fm + ((wgid % nig) % gsz); u.pn = (wgid % nig) / gsz; return true;
    }
    __device__ __forceinline__ void a_ready(const Unit&) const {}
    __device__ __forceinline__ void done(const Unit&) const {}
};

struct OneUnit {
    Unit u;
    __device__ __forceinline__ bool next(int i, Unit& o) const { if (i) return false; o = u; return true; }
    __device__ __forceinline__ void a_ready(const Unit&) const {}
    __device__ __forceinline__ void done(const Unit&) const {}
};
__device__ __forceinline__ unsigned cvt_pk_bf16(float lo, float hi) { unsigned r; asm volatile("v_cvt_pk_bf16_f32 %0, %1, %2" : "=v"(r) : "v"(lo), "v"(hi)); return r; }

struct EpiBf16 {
    static constexpr bool PERM = true, AFTER_DRAIN = false, PREFETCH = false, AROWPERM = false;
    bf16_t* O; int ldc;
    __device__ __forceinline__ void operator()(const f32x4 (&acc)[2][2][4][2], const Unit& u, int wr, int wc, int fr, int fq) const {
        const int row0 = u.pm * BM + wr * 64 + fr; const int col0 = u.pn * BM + wc * 32 + 8 * fq;
#pragma unroll
        for (int ai = 0; ai < 2; ++ai)
#pragma unroll
            for (int m = 0; m < 4; ++m) { bf16_t* rowp = O + (size_t)(row0 + ai * HALF + m * 16) * ldc + col0;
#pragma unroll
                for (int bj = 0; bj < 2; ++bj) { const f32x4 v0 = acc[ai][bj][m][0], v1 = acc[ai][bj][m][1];
                    u32x4 w; w.x = cvt_pk_bf16(v0[0], v0[1]); w.y = cvt_pk_bf16(v0[2], v0[3]); w.z = cvt_pk_bf16(v1[0], v1[1]); w.w = cvt_pk_bf16(v1[2], v1[3]);
                    *(u32x4*)(rowp + bj * HALF) = w; } }
    }
};
struct EpiF32 {
    static constexpr bool PERM = false, AFTER_DRAIN = false, PREFETCH = false, AROWPERM = false;
    float* C; int ldc, row_off;
    __device__ __forceinline__ void operator()(const f32x4 (&acc)[2][2][4][2], const Unit& u, int wr, int wc, int fr, int fq) const {
        const int row0 = u.pm * BM - row_off + wr * 64 + fr, col0 = u.pn * BM + wc * 32 + 4 * fq;
#pragma unroll
        for (int ai = 0; ai < 2; ++ai)
#pragma unroll
            for (int m = 0; m < 4; ++m) { float* rowp = C + (size_t)(row0 + ai * HALF + m * 16) * ldc + col0;
#pragma unroll
                for (int bj = 0; bj < 2; ++bj)
#pragma unroll
                    for (int n = 0; n < 2; ++n) *(f32x4*)(rowp + bj * HALF + n * 16) = acc[ai][bj][m][n]; }
    }
};

template <class Epi, class Sched, bool ALIGN_EPI = false, bool SP2 = false>
__device__ __forceinline__ void gemm_phase(PG8_LAS unsigned char* lds, const Gemm g, const Sched& S, const Epi& E) {
    int tid_ = threadIdx.x; asm volatile("" : "+v"(tid_));
    const int tid = tid_, wid = __builtin_amdgcn_readfirstlane(tid >> 6), lane = tid & 63, wr = wid >> 2, wc = wid & 3, fr = lane & 15, fq = lane >> 4;
    const int K = g.K, nt = K / BK;
    unsigned voffA[2], voffB[2];
#pragma unroll
    for (int i = 0; i < 2; ++i) { int R, C; stage_rc(tid * 16 + i * 8192, R, C); const int Rb = Epi::PERM ? ((R & ~31) + perm32(R & 31)) : R;
        const int Ra = Epi::AROWPERM ? ((R & ~63) + 4 * (R & 15) + ((R >> 4) & 3)) : R;
        voffA[i] = (unsigned)(Ra * g.lda + C) * 2u; voffB[i] = (unsigned)(Rb * g.ldb + C) * 2u; }
    const size_t kstep = (size_t)(BK * 2);
    const size_t hstepA = (size_t)HALF * g.lda * 2, hstepB = (size_t)HALF * g.ldb * 2;
    const size_t tstepA = 2 * hstepA, tstepB = 2 * hstepB;
    const unsigned ldsw = (unsigned)wid * 1024u;
    const int aoff = lds_byte(wr * 64 + fr, fq * 8), boff = lds_byte(wc * 32 + fr, fq * 8);
#define PG8_SA(b, h) (((b) * 2 + (h)) * HTB)
#define PG8_SB(b, h) ((4 + (b) * 2 + (h)) * HTB)
    const __amdgpu_buffer_rsrc_t rsA = __builtin_amdgcn_make_buffer_rsrc((void*)g.A, 0, 0x7fffffff, 0x00020000), rsB = __builtin_amdgcn_make_buffer_rsrc((void*)g.Bt, 0, 0x7fffffff, 0x00020000);
#define PG8_RS_voffA rsA
#define PG8_RS_voffB rsB
#define PG8_B0_voffA ((const char*)g.A)
#define PG8_B0_voffB ((const char*)g.Bt)
#define PG8_STAGE(bufoff, gbase, voff) PG8_STAGE_(bufoff, gbase, voff, PG8_RS_##voff, PG8_B0_##voff)
#define PG8_STAGE_(bufoff, gbase, voff, rs, b0) do { const unsigned so_ = (unsigned)((const char*)(gbase) - (b0)); _Pragma("unroll") for (int _i = 0; _i < 2; ++_i) \
        __builtin_amdgcn_raw_ptr_buffer_load_lds(rs, (PG8_LAS unsigned*)(lds + (bufoff) + ldsw + _i * 8192), 16, (int)(voff)[_i], (int)so_, 0, 0); } while (0)
#define PG8_LDA(dst, b, h) do { _Pragma("unroll") for (int m = 0; m < 4; ++m) _Pragma("unroll") for (int k = 0; k < 2; ++k) dst[m][k] = *(const PG8_LAS bf16x8*)(lds + PG8_SA(b, h) + aoff + m * 2048 + k * 1024); } while (0)
#define PG8_LDB(dst, b, h) do { _Pragma("unroll") for (int n = 0; n < 2; ++n) _Pragma("unroll") for (int k = 0; k < 2; ++k) dst[n][k] = *(const PG8_LAS bf16x8*)(lds + PG8_SB(b, h) + boff + n * 2048 + k * 1024); } while (0)
#define PG8_MMA(ai, bj, At, Bt) do { __builtin_amdgcn_s_setprio(1); _Pragma("unroll") for (int m = 0; m < 4; ++m) _Pragma("unroll") for (int n = 0; n < 2; ++n) _Pragma("unroll") for (int k = 0; k < 2; ++k) \
        acc[ai][bj][m][n] = __builtin_amdgcn_mfma_f32_16x16x32_bf16(Bt[n][k], At[m][k], acc[ai][bj][m][n], 0, 0, 0); __builtin_amdgcn_s_setprio(0); } while (0)
#define PG8_WAIT_V(n) asm volatile("s_waitcnt vmcnt(" #n ")" ::: "memory")
#define PG8_WAIT_L(n) asm volatile("s_waitcnt lgkmcnt(" #n ")" ::: "memory")
#define PG8_BAR __builtin_amdgcn_s_barrier()
#define PG8_SCHED __builtin_amdgcn_sched_barrier(0)
    Unit cur, nxt; int ui = 0;
    if (!S.next(0, cur)) return;
    f32x4 acc[2][2][4][2];
#pragma unroll
    for (int a = 0; a < 2; ++a)
#pragma unroll
        for (int b = 0; b < 2; ++b)
#pragma unroll
            for (int m = 0; m < 4; ++m)
#pragma unroll
                for (int n = 0; n < 2; ++n) acc[a][b][m][n] = (f32x4){0.f, 0.f, 0.f, 0.f};
    bf16x8 At[4][2], B0[2][2], B1[2][2];
    const char* cA = (const char*)g.A + (size_t)cur.pm * tstepA; const char* cB = (const char*)g.Bt + (size_t)cur.pn * tstepB;
    float pf0 = 0.f, pf1 = 0.f;
    if constexpr (Epi::PREFETCH) E.prefetch(cur, tid, pf0, pf1);
    S.a_ready(cur);
    if constexpr (SP2) {
        PG8_STAGE(PG8_SB(0, 0), cB, voffB); PG8_STAGE(PG8_SB(0, 1), cB + hstepB, voffB); PG8_STAGE(PG8_SA(0, 0), cA, voffA); PG8_STAGE(PG8_SA(0, 1), cA + hstepA, voffA);
        if (wr == 1) PG8_BAR;
        PG8_WAIT_V(2); PG8_BAR;
        PG8_STAGE(PG8_SB(1, 0), cB + kstep, voffB); PG8_STAGE(PG8_SA(1, 0), cA + kstep, voffA); PG8_STAGE(PG8_SB(1, 1), cB + hstepB + kstep, voffB);
        PG8_WAIT_V(6); PG8_BAR;
    } else {
        PG8_STAGE(PG8_SB(0, 0), cB, voffB); PG8_STAGE(PG8_SA(0, 0), cA, voffA); PG8_STAGE(PG8_SB(0, 1), cB + hstepB, voffB); PG8_STAGE(PG8_SA(0, 1), cA + hstepA, voffA);
        if (wr == 1) PG8_BAR;
        PG8_WAIT_V(4); PG8_BAR;
        PG8_STAGE(PG8_SB(1, 0), cB + kstep, voffB); PG8_STAGE(PG8_SA(1, 0), cA + kstep, voffA); PG8_STAGE(PG8_SB(1, 1), cB + hstepB + kstep, voffB);
        PG8_WAIT_V(6); PG8_BAR;
    }
    for (;;) {
        const bool has_next = S.next(ui + 1, nxt);
        const char* nA = has_next ? (const char*)g.A + (size_t)nxt.pm * tstepA : cA; const char* nB = has_next ? (const char*)g.Bt + (size_t)nxt.pn * tstepB : cB;
        for (int t = 0; t < nt; t += 2) {
            const bool last = (t == nt - 2);
            const char* a1 = cA + (size_t)(t + 1) * kstep;
            const char* a2 = last ? nA : cA + (size_t)(t + 2) * kstep; const char* b2 = last ? nB : cB + (size_t)(t + 2) * kstep;
            const char* a3 = a2 + kstep; const char* b3 = b2 + kstep;
            if (last && has_next) S.a_ready(nxt);
            if constexpr (SP2) {
            PG8_LDB(B0, 0, 0); PG8_LDB(B1, 0, 1); PG8_SCHED; PG8_LDA(At, 0, 0); PG8_STAGE(PG8_SA(1, 1), a1 + hstepA, voffA);
            PG8_WAIT_V(8); PG8_WAIT_L(0); PG8_BAR; PG8_MMA(0, 0, At, B0); PG8_MMA(0, 1, At, B1); PG8_BAR; PG8_SCHED;
            PG8_LDA(At, 0, 1); PG8_STAGE(PG8_SB(0, 0), b2, voffB); PG8_STAGE(PG8_SB(0, 1), b2 + hstepB, voffB); PG8_STAGE(PG8_SA(0, 0), a2, voffA);
            PG8_WAIT_V(8); PG8_WAIT_L(0); PG8_BAR; PG8_MMA(1, 0, At, B0); PG8_MMA(1, 1, At, B1); PG8_BAR; PG8_SCHED;
            PG8_LDB(B0, 1, 0); PG8_LDB(B1, 1, 1); PG8_SCHED; PG8_LDA(At, 1, 0); PG8_STAGE(PG8_SA(0, 1), a2 + hstepA, voffA);
            PG8_WAIT_V(8); PG8_WAIT_L(0); PG8_BAR; PG8_MMA(0, 0, At, B0); PG8_MMA(0, 1, At, B1); PG8_BAR; PG8_SCHED;
            PG8_LDA(At, 1, 1); PG8_STAGE(PG8_SB(1, 0), b3, voffB); PG8_STAGE(PG8_SB(1, 1), b3 + hstepB, voffB); PG8_STAGE(PG8_SA(1, 0), a3, voffA);
            PG8_WAIT_V(8); PG8_WAIT_L(0); PG8_BAR; PG8_MMA(1, 0, At, B0); PG8_MMA(1, 1, At, B1); PG8_BAR; PG8_SCHED;
            } else {
            PG8_LDB(B0, 0, 0); PG8_SCHED; PG8_LDA(At, 0, 0); PG8_STAGE(PG8_SA(1, 1), a1 + hstepA, voffA);
            PG8_WAIT_L(8); PG8_BAR; PG8_WAIT_L(0); PG8_MMA(0, 0, At, B0); PG8_BAR; PG8_SCHED;
            PG8_LDB(B1, 0, 1); PG8_STAGE(PG8_SB(0, 0), b2, voffB);
            PG8_BAR; PG8_WAIT_L(0); PG8_MMA(0, 1, At, B1); PG8_BAR;
            PG8_LDA(At, 0, 1); PG8_STAGE(PG8_SA(0, 0), a2, voffA);
            PG8_BAR; PG8_WAIT_L(0); PG8_MMA(1, 0, At, B0); PG8_BAR; PG8_SCHED;
            PG8_STAGE(PG8_SB(0, 1), b2 + hstepB, voffB);
            PG8_WAIT_V(6); PG8_BAR; PG8_MMA(1, 1, At, B1); PG8_BAR;
            PG8_LDB(B0, 1, 0); PG8_SCHED; PG8_LDA(At, 1, 0); PG8_STAGE(PG8_SA(0, 1), a2 + hstepA, voffA);
            PG8_WAIT_L(8); PG8_BAR; PG8_WAIT_L(0); PG8_MMA(0, 0, At, B0); PG8_BAR; PG8_SCHED;
            PG8_LDB(B1, 1, 1); PG8_STAGE(PG8_SB(1, 0), b3, voffB);
            PG8_BAR; PG8_WAIT_L(0); PG8_MMA(0, 1, At, B1); PG8_BAR;
            PG8_LDA(At, 1, 1); PG8_STAGE(PG8_SA(1, 0), a3, voffA);
            PG8_BAR; PG8_WAIT_L(0); PG8_MMA(1, 0, At, B0); PG8_BAR; PG8_SCHED;
            PG8_STAGE(PG8_SB(1, 1), b3 + hstepB, voffB);
            PG8_WAIT_V(6); PG8_BAR; PG8_MMA(1, 1, At, B1); PG8_BAR;
            }
        }
        if constexpr (ALIGN_EPI) { if (wr == 0) PG8_BAR; }
        if constexpr (!Epi::AFTER_DRAIN) { if constexpr (Epi::PREFETCH) E.stash(tid, pf0, pf1); E(acc, cur, wr, wc, fr, fq); S.done(cur); }
        if (!has_next) break;
#pragma unroll
        for (int a = 0; a < 2; ++a)
#pragma unroll
            for (int b = 0; b < 2; ++b)
#pragma unroll
                for (int m = 0; m < 4; ++m)
#pragma unroll
                    for (int n = 0; n < 2; ++n) acc[a][b][m][n] = (f32x4){0.f, 0.f, 0.f, 0.f};
        cur = nxt; cA = nA; cB = nB; ++ui;
        if constexpr (Epi::PREFETCH) E.prefetch(cur, tid, pf0, pf1);
        if constexpr (ALIGN_EPI) { if (wr == 1) PG8_BAR; }
    }
    PG8_WAIT_V(0);
    if constexpr (!ALIGN_EPI) { if (wr == 0) PG8_BAR; }
    PG8_BAR;
    if constexpr (Epi::AFTER_DRAIN) { E.fused(acc, cur, wr, wc, fr, fq, lds, wid, lane); S.done(cur); }
#undef PG8_SA
#undef PG8_SB
#undef PG8_STAGE
#undef PG8_STAGE_
#undef PG8_RS_voffA
#undef PG8_RS_voffB
#undef PG8_B0_voffA
#undef PG8_B0_voffB
#undef PG8_LDA
#undef PG8_LDB
#undef PG8_MMA
#undef PG8_WAIT_V
#undef PG8_WAIT_L
#undef PG8_BAR
#undef PG8_SCHED
}
}


#define GAS __attribute__((address_space(1)))
#define LAS __attribute__((address_space(3)))
typedef unsigned short bf16;
typedef unsigned v4u __attribute__((ext_vector_type(4)));
typedef unsigned v2u __attribute__((ext_vector_type(2)));
typedef float f32x4 __attribute__((ext_vector_type(4)));
typedef float f32x2 __attribute__((ext_vector_type(2)));
typedef short bf16x8 __attribute__((ext_vector_type(8)));
typedef short s16x4 __attribute__((ext_vector_type(4)));
typedef float f32x16 __attribute__((ext_vector_type(16)));
#define LDS_WAIT() asm volatile("s_waitcnt lgkmcnt(0)" ::: "memory")
#define VM_WAIT() asm volatile("s_waitcnt vmcnt(0)" ::: "memory")

constexpr int D = 2048, NB = 16, SEQ = 256, DB = 4, DSEQ = 4096, PAST = 512;
constexpr int MP = NB * SEQ, MS = DB * DSEQ, M = MP + MS;
constexpr int LSEQ = PAST + DSEQ;
constexpr int LKV = MP + DB * LSEQ;
constexpr int DFF = 5632, NFF = 2 * DFF;
constexpr float EPS = 1e-6f;
constexpr float LAM_INIT_1 = 0.35550906758f;
constexpr int NWAVES = 8;

constexpr size_t O_YP = 0, O_YS = (size_t)MP * D, O_SA_CKV = (size_t)M * D, O_SA_KPE = O_SA_CKV + (size_t)NB * 2 * SEQ * 256,
                 O_SB_K = O_SA_KPE + (size_t)NB * 2 * SEQ * 64, O_SB_V = O_SB_K + (size_t)NB * SEQ * 2048, O_SC_K = O_SB_V + (size_t)NB * SEQ * 2048,
                 O_SC_V = O_SC_K + (size_t)NB * SEQ * 512, O_END = O_SC_V + (size_t)NB * SEQ * 512;
static_assert(O_END == 65536000, "out size");

constexpr size_t MiB = 1u << 20;
constexpr size_t WS_CTL = 0, CTL_ZERO_BYTES = 1 * MiB;
constexpr size_t WS_MOD = 1 * MiB;
constexpr size_t WS_MISC = 2 * MiB;
constexpr size_t WS_W_A_DOWN = 3 * MiB, WS_W_A_UQ = 11 * MiB, WS_W_A_UKV = 17 * MiB, WS_W_A_O = 21 * MiB;
constexpr size_t WS_W_B_QKV = 37 * MiB, WS_W_B_O = 61 * MiB, WS_W_C_QKV = 69 * MiB, WS_W_C_O = 81 * MiB;
constexpr size_t WS_W_FIN = 89 * MiB, WS_W_FDN = 265 * MiB;
constexpr size_t WS_H = 353 * MiB, WS_T = 433 * MiB, WS_AO = 513 * MiB, WS_R = 593 * MiB, WS_SLAB = 1256 * MiB, WS_X16 = 1320 * MiB, WS_EDGE = 1400 * MiB, WS_END = 1416 * MiB;
constexpr int MSPLIT = 16384;
constexpr size_t SLAB_ELEMS = (size_t)(M - MSPLIT) * D;
constexpr size_t R_U = 0, R_G = 440 * MiB;
constexpr size_t R_A_D1 = 0, R_A_SSP = 40 * MiB  , R_A_CKVF = 60 * MiB, R_A_KPEF = 72 * MiB, R_A_Q = 76 * MiB, R_A_KV = 196 * MiB;
constexpr size_t R_B_Q = 0, R_B_KF = 240 * MiB, R_B_VF = 328 * MiB, R_B_OC = 416 * MiB;
constexpr size_t R_C_Q = 0, R_C_KF = 120 * MiB, R_C_VF = 142 * MiB;
static_assert(R_G + (size_t)M * DFF * 2 <= WS_SLAB - WS_R && R_A_KV + (size_t)LKV * 4096 * 2 <= WS_SLAB - WS_R && R_B_OC + (size_t)M * 4096 * 2 <= WS_SLAB - WS_R, "scratch overlays");
constexpr int CW_BAR = 4096;

constexpr int RING_BYTES = 131072;
constexpr int LDSCTL_OFF = RING_BYTES, MISC_OFF = LDSCTL_OFF + 320;
constexpr int LDS_BYTES = 147456;
constexpr int EPI_LDS_OFF = RING_BYTES + 1024;
static_assert(EPI_LDS_OFF + 12288 <= LDS_BYTES, "LDS map");

struct Params { const float* in[31]; float* out; unsigned char* ws; };
enum { I_XP = 0, I_XS, I_C, I_CA_CKV, I_CA_KPE, I_CB_K, I_CB_V, I_CC_K, I_CC_V, I_CCTX, I_NORMG, I_WMOD, I_BMOD, I_FWIN, I_FCW, I_FCB, I_FWDN,
       I_AWD, I_AQN, I_AKVN, I_AWUQ, I_AWUKV, I_AWO, I_BWQKV, I_BLAM, I_BSUBLN, I_BWO, I_CWQKV, I_CQN, I_CKN, I_CWO };

__device__ __forceinline__ unsigned f2bf(float f) { unsigned u = __builtin_bit_cast(unsigned, f); return (u + 0x7fffu + ((u >> 16) & 1u)) >> 16; }
__device__ __forceinline__ unsigned pk2(float lo, float hi) { return f2bf(lo) | (f2bf(hi) << 16); }
__device__ __forceinline__ float bf2f(unsigned short b) { return __builtin_bit_cast(float, (unsigned)b << 16); }
__device__ __forceinline__ float bflo(unsigned w) { return __builtin_bit_cast(float, w << 16); }
__device__ __forceinline__ float bfhi(unsigned w) { return __builtin_bit_cast(float, w & 0xffff0000u); }
__device__ __forceinline__ float wave_sum(float v) {
#pragma unroll
    for (int o = 1; o < 64; o <<= 1) v += __shfl_xor(v, o);
    return v;
}

#define XB_TMO      128
#define XB_XCNT(j)  (256  + 64 * (j))
#define XB_XSUB(j)  (1280 + 64 * (j))
#define XB_XGEN(j)  (2304 + 64 * (j))
#define XB_TOP      3328
#define XB_TOPGEN   3392
#define XCD_BAR_WORDS 3456
#define XB_SPIN_CAP (1u << 22)

__device__ __forceinline__ unsigned xb_ld(unsigned* p)              { return __hip_atomic_load(p, __ATOMIC_RELAXED, __HIP_MEMORY_SCOPE_AGENT); }
__device__ __forceinline__ unsigned xb_add(unsigned* p, unsigned v) { return __hip_atomic_fetch_add(p, v, __ATOMIC_RELAXED, __HIP_MEMORY_SCOPE_AGENT); }
__device__ __forceinline__ unsigned xb_xcc_id() { return (unsigned)__builtin_amdgcn_s_getreg((3 << 11) | 20) & 0xFu; }
#define XB_SPIN(cond, bar) do { unsigned _sp = 0; while (cond) { \
    if ((++_sp & 255u) == 0u) { if (xb_ld(&(bar)[XB_TMO])) break; if (_sp > XB_SPIN_CAP) { atomicAdd(&(bar)[XB_TMO], 1u); break; } } } } while (0)

struct XcdBarrier { unsigned* bar; unsigned x; volatile LAS unsigned* st; };

__device__ __forceinline__ XcdBarrier xcd_barrier_post(unsigned* bar, volatile LAS unsigned* st) {
    XcdBarrier b; b.bar = bar; b.x = xb_xcc_id(); b.st = st;
    if (threadIdx.x == 0) (void)xb_add(&bar[XB_XCNT(b.x)], 1u);
    return b;
}
__device__ __forceinline__ void xcd_barrier_complete(unsigned* bar, unsigned x, unsigned& nloc, unsigned& nx) {
    const unsigned G = gridDim.x * gridDim.y * gridDim.z;
    unsigned sum, cnt, mine, sp = 0u;
    for (;;) {
        sum = 0u; cnt = 0u; mine = 0u;
#pragma unroll
        for (unsigned j = 0; j < 16; ++j) { const unsigned c = xb_ld(&bar[XB_XCNT(j)]); sum += c; cnt += (c > 0u) ? 1u : 0u; mine = (j == x) ? c : mine; }
        if (sum == G) break;
        __builtin_amdgcn_s_sleep(1);
        if ((++sp & 255u) == 0u) { if (xb_ld(&bar[XB_TMO])) break; if (sp > XB_SPIN_CAP) { atomicAdd(&bar[XB_TMO], 1u); break; } }
    }
    nloc = mine > 0u ? mine : 1u; nx = cnt > 0u ? cnt : 1u;
}
__device__ __forceinline__ void xcd_barrier(const XcdBarrier& b) {
    asm volatile("s_waitcnt vmcnt(0)" ::: "memory");
    __syncthreads();
    if (threadIdx.x == 0) {
        unsigned* bar = b.bar;
        __builtin_amdgcn_s_waitcnt(0);
        unsigned nloc = b.st[0], nx = b.st[1];
        if (nloc == 0u) { xcd_barrier_complete(bar, b.x, nloc, nx); b.st[0] = nloc; b.st[1] = nx; }
        const unsigned old = xb_add(&bar[XB_XSUB(b.x)], 1u);
        const unsigned gen = old / nloc;
        if (old + 1u == (gen + 1u) * nloc) {
            __builtin_amdgcn_fence(__ATOMIC_RELEASE, "agent");
            asm volatile("s_waitcnt vmcnt(0)" ::: "memory");
            const unsigned og = xb_add(&bar[XB_TOP], 1u);
            const unsigned tg = og / nx;
            if (og + 1u == (tg + 1u) * nx) xb_add(&bar[XB_TOPGEN], 1u);
            else XB_SPIN(xb_ld(&bar[XB_TOPGEN]) == tg, bar);
            __builtin_amdgcn_fence(__ATOMIC_ACQUIRE, "agent");
            xb_add(&bar[XB_XGEN(b.x)], 1u);
            asm volatile("s_waitcnt vmcnt(0)" ::: "memory");
        } else {
            XB_SPIN(xb_ld(&bar[XB_XGEN(b.x)]) == gen, bar);
            __builtin_amdgcn_fence(__ATOMIC_ACQUIRE, "agent");
            asm volatile("s_waitcnt vmcnt(0)" ::: "memory");
        }
    }
    __syncthreads();
}

struct Frame {
    unsigned char* lds;
    LAS unsigned char* ldsl;
    int tid, lane, wave, vcu, G, gw, NGW;
};
__device__ __forceinline__ Frame make_frame(unsigned char* lds) {
    Frame F; F.lds = lds; F.ldsl = (LAS unsigned char*)lds;
    int t = threadIdx.x; asm volatile("" : "+v"(t));
    F.tid = t; F.lane = t & 63; F.wave = __builtin_amdgcn_readfirstlane(t >> 6);
    int bx = blockIdx.x; asm volatile("" : "+s"(bx));
    F.G = gridDim.x; F.vcu = (F.G % 8 == 0) ? (bx % 8) * (F.G / 8) + bx / 8 : bx;
    F.gw = F.vcu * NWAVES + F.wave; F.NGW = F.G * NWAVES;
    return F;
}

__device__ __forceinline__ int wrow_perm(int n, int mode) {
    if (mode == 1) { if (n >= 2560) return n; const int h = n >> 7, d = n & 127; const int wc = 2 * (d >> 6) + ((d >> 4) & 1), nn = (d >> 5) & 1; return (h << 7) + 32 * wc + 16 * nn + (d & 15); }
    if (mode == 2) { const int isval = n >= DFF ? 1 : 0, c = n - isval * DFF; return (c >> 7) * 256 + isval * 128 + (c & 127); }
    return n;
}
__device__ __forceinline__ void p0_transpose_item(const float* __restrict__ W, int K, int N, bf16* __restrict__ WT, LAS float* scr, int item, int lane, int mode, const float* kscale) {
    const int nblk = N / 32, kb = item / nblk, nb = item % nblk, k0 = 64 * kb, n0 = 32 * nb;
    { float tv[32]; const float* wp = W + (size_t)(k0 + (lane >> 5)) * N + n0 + (lane & 31);
#pragma unroll
      for (int i = 0; i < 32; ++i) tv[i] = wp[(size_t)(2 * i) * N];
#pragma unroll
      for (int i = 0; i < 32; ++i) scr[(2 * i + (lane >> 5)) * 33 + (lane & 31)] = tv[i]; }
    LDS_WAIT(); asm volatile("" ::: "memory");
    const int c = lane & 7;
    float ks[8] = {1.f, 1.f, 1.f, 1.f, 1.f, 1.f, 1.f, 1.f};
    if (kscale) {
#pragma unroll
        for (int q = 0; q < 8; ++q) ks[q] = kscale[k0 + 8 * c + q]; }
#pragma unroll
    for (int j = 0; j < 4; ++j) { const int n = (lane >> 3) + 8 * j; const LAS float* s = scr + (8 * c) * 33 + n;
        v4u o; o.x = pk2(s[0 * 33] * ks[0], s[1 * 33] * ks[1]); o.y = pk2(s[2 * 33] * ks[2], s[3 * 33] * ks[3]); o.z = pk2(s[4 * 33] * ks[4], s[5 * 33] * ks[5]); o.w = pk2(s[6 * 33] * ks[6], s[7 * 33] * ks[7]);
        *(v4u*)(WT + (size_t)wrow_perm(n0 + n, mode) * K + k0 + 8 * c) = o; }
    LDS_WAIT(); asm volatile("" ::: "memory");
}

__device__ __forceinline__ float silu_f(float x) { return x / (1.0f + __expf(-x)); }

__device__ __forceinline__ void p0_prologue(const Params& P, unsigned char* ldsp) {
    const Frame F = make_frame(ldsp);
    unsigned char* ws = P.ws;
    {
        LAS float* scr = (LAS float*)(F.ldsl + F.wave * 16384);
        constexpr int IT_AWD = (2048 / 64) * (832 / 32), IT_AWUQ = (512 / 64) * (3072 / 32), IT_AWUKV = (256 / 64) * (4096 / 32), IT_WO = (2048 / 64) * (2048 / 32);
        constexpr int IT_BQKV = (2048 / 64) * (6144 / 32), IT_CQKV = (2048 / 64) * (3072 / 32), IT_FIN = (2048 / 64) * (NFF / 32), IT_FDN = (DFF / 64) * (2048 / 32);
        constexpr int NITEMS = 2 * (IT_AWD + IT_AWUQ + IT_AWUKV + IT_WO) + IT_BQKV + IT_WO + IT_CQKV + IT_WO + 4 * IT_FIN + 4 * IT_FDN;
        for (int it = F.gw; it < NITEMS; it += F.NGW) {
            int r = it; const float* W; bf16* WT; int K, N, mode = 0; const float* kscale = nullptr;
            if (r < 4 * IT_FIN) { const int l = r / IT_FIN; r -= l * IT_FIN; W = P.in[I_FWIN] + (size_t)l * 2048 * NFF; WT = (bf16*)(ws + WS_W_FIN + (size_t)l * 44 * MiB); K = 2048; N = NFF; mode = 2; }
            else if ((r -= 4 * IT_FIN) < 4 * IT_FDN) { const int l = r / IT_FDN; r -= l * IT_FDN; W = P.in[I_FWDN] + (size_t)l * DFF * 2048; WT = (bf16*)(ws + WS_W_FDN + (size_t)l * 22 * MiB); K = DFF; N = 2048; }
            else if ((r -= 4 * IT_FDN) < IT_BQKV) { W = P.in[I_BWQKV]; WT = (bf16*)(ws + WS_W_B_QKV); K = 2048; N = 6144; }
            else if ((r -= IT_BQKV) < IT_CQKV) { W = P.in[I_CWQKV]; WT = (bf16*)(ws + WS_W_C_QKV); K = 2048; N = 3072; mode = 1; }
            else if ((r -= IT_CQKV) < IT_WO) { W = P.in[I_BWO]; WT = (bf16*)(ws + WS_W_B_O); K = 2048; N = 2048; }
            else if ((r -= IT_WO) < IT_WO) { W = P.in[I_CWO]; WT = (bf16*)(ws + WS_W_C_O); K = 2048; N = 2048; }
            else if ((r -= IT_WO) < 2 * IT_WO) { const int j = r / IT_WO; r -= j * IT_WO; W = P.in[I_AWO] + (size_t)j * 2048 * 2048; WT = (bf16*)(ws + WS_W_A_O + (size_t)j * 8 * MiB); K = 2048; N = 2048; }
            else if ((r -= 2 * IT_WO) < 2 * IT_AWD) { const int j = r / IT_AWD; r -= j * IT_AWD; W = P.in[I_AWD] + (size_t)j * 2048 * 832; WT = (bf16*)(ws + WS_W_A_DOWN + (size_t)j * 4 * MiB); K = 2048; N = 832; }
            else if ((r -= 2 * IT_AWD) < 2 * IT_AWUQ) { const int j = r / IT_AWUQ; r -= j * IT_AWUQ; W = P.in[I_AWUQ] + (size_t)j * 512 * 3072; WT = (bf16*)(ws + WS_W_A_UQ + (size_t)j * 3 * MiB); K = 512; N = 3072; kscale = P.in[I_AQN] + j * 512; }
            else { r -= 2 * IT_AWUQ; const int j = r / IT_AWUKV; r -= j * IT_AWUKV; W = P.in[I_AWUKV] + (size_t)j * 256 * 4096; WT = (bf16*)(ws + WS_W_A_UKV + (size_t)j * 2 * MiB); K = 256; N = 4096; }
            p0_transpose_item(W, K, N, WT, scr, r, F.lane, mode, kscale);
        }
    }
    {
        const size_t n16 = (size_t)(1024 - 832) * 2048 * 2 / 16;
        for (size_t i = (size_t)F.gw * 64 + F.lane; i < 2 * n16; i += (size_t)F.NGW * 64) { const size_t j = i / n16, o = i % n16;
            *(v4u*)(ws + WS_W_A_DOWN + j * 4 * MiB + (size_t)832 * 2048 * 2 + o * 16) = (v4u){0u, 0u, 0u, 0u}; }
    }
    {
        float* misc = (float*)(ws + WS_MISC);
        const int e = F.gw * 64 + F.lane;
        if (e < 1024 + 2048) {
            const bool t16 = e < 1024; const int ee = t16 ? e : e - 1024; const int half = t16 ? 16 : 32; const int pos = ee / half, i = ee % half;
            const float fr = exp2f(-(float)i / (float)half * 13.287712379549449f);
            const float ang = (float)pos * fr;
            const double a = (double)ang;
            float* dst = misc + (t16 ? 256 : 4096) + 2 * ee;
            dst[0] = (float)cos(a); dst[1] = (float)sin(a);
        }
        if (F.gw == F.NGW - 1) {
            const float* lv = P.in[I_BLAM];
            const float s0 = wave_sum(lv[F.lane] * lv[64 + F.lane]), s1 = wave_sum(lv[128 + F.lane] * lv[192 + F.lane]);
            if (F.lane == 0) misc[0] = expf(s0) - expf(s1) + LAM_INIT_1;
        }
    }
    {
        LAS float* sl = (LAS float*)F.ldsl;
        LAS float* red = sl + 5 * 2048;
        __syncthreads();
        for (int i = F.tid; i < 5 * 2048; i += 512) { const float x = i < 2048 ? P.in[I_CCTX][i] : P.in[I_C][i - 2048]; sl[i] = silu_f(x); }
        __syncthreads();
        float* MOD = (float*)(ws + WS_MOD);
        for (int u = F.vcu; u < 4 * 96; u += F.G) {
            const int l = u / 96, n0 = (u % 96) * 128;
            const float* wm = P.in[I_WMOD] + (size_t)l * 2048 * 12288 + n0 + 2 * F.lane;
            float a0[5] = {0.f, 0.f, 0.f, 0.f, 0.f}, a1[5] = {0.f, 0.f, 0.f, 0.f, 0.f};
            const int k0 = F.wave * 256;
#pragma unroll 8
            for (int k = k0; k < k0 + 256; ++k) { const f32x2 w = *(const f32x2*)(wm + (size_t)k * 12288);
#pragma unroll
                for (int j = 0; j < 5; ++j) { const float s = sl[j * 2048 + k]; a0[j] += s * w.x; a1[j] += s * w.y; } }
#pragma unroll
            for (int j = 0; j < 5; ++j) { red[(F.wave * 5 + j) * 128 + 2 * F.lane] = a0[j]; red[(F.wave * 5 + j) * 128 + 2 * F.lane + 1] = a1[j]; }
            __syncthreads();
            for (int o = F.tid; o < 5 * 128; o += 512) { const int j = o / 128, n = o % 128; float s = 0.f;
#pragma unroll
                for (int w = 0; w < 8; ++w) s += red[(w * 5 + j) * 128 + n];
                MOD[((size_t)l * 5 + j) * 12288 + n0 + n] = s + P.in[I_BMOD][(size_t)l * 12288 + n0 + n]; }
            __syncthreads();
        }
    }
}

__device__ __forceinline__ int mod_index(int m) { return m < MP ? 0 : 1 + ((m - MP) >> 12); }

template <bool RES, bool NORM, bool XIN, bool XOUT32>
__device__ __forceinline__ void rn_process(int m, int lane, const f32x4 (&xa)[8], const v4u (&xh)[4], const v4u (&ta)[4], const bf16* slab, bf16* X16, float* Xout, const float* ga, const float* gt, const float* gb, const float* sh, const float* sc, bf16* H) {
    float x[4][8];
#pragma unroll
    for (int jj = 0; jj < 4; ++jj) {
        if constexpr (XIN) { const f32x4 a = xa[2 * jj], b = xa[2 * jj + 1];
            x[jj][0] = a.x; x[jj][1] = a.y; x[jj][2] = a.z; x[jj][3] = a.w; x[jj][4] = b.x; x[jj][5] = b.y; x[jj][6] = b.z; x[jj][7] = b.w; }
        else { const v4u w = xh[jj];
            x[jj][0] = bflo(w.x); x[jj][1] = bfhi(w.x); x[jj][2] = bflo(w.y); x[jj][3] = bfhi(w.y); x[jj][4] = bflo(w.z); x[jj][5] = bfhi(w.z); x[jj][6] = bflo(w.w); x[jj][7] = bfhi(w.w); } }
    if constexpr (RES) {
        float t[4][8]; float ss = 0.f;
        if (m >= MSPLIT) {
            const bf16* s0 = slab + (size_t)(m - MSPLIT) * D; const bf16* s1 = s0 + SLAB_ELEMS;
#pragma unroll
            for (int jj = 0; jj < 4; ++jj) { const int c = 8 * (64 * jj + lane); const v4u a = *(const v4u*)(s0 + c), b = *(const v4u*)(s1 + c);
                t[jj][0] = bflo(a.x) + bflo(b.x); t[jj][1] = bfhi(a.x) + bfhi(b.x); t[jj][2] = bflo(a.y) + bflo(b.y); t[jj][3] = bfhi(a.y) + bfhi(b.y);
                t[jj][4] = bflo(a.z) + bflo(b.z); t[jj][5] = bfhi(a.z) + bfhi(b.z); t[jj][6] = bflo(a.w) + bflo(b.w); t[jj][7] = bfhi(a.w) + bfhi(b.w); }
        } else {
#pragma unroll
            for (int jj = 0; jj < 4; ++jj) { const v4u w = ta[jj];
                t[jj][0] = bflo(w.x); t[jj][1] = bfhi(w.x); t[jj][2] = bflo(w.y); t[jj][3] = bfhi(w.y); t[jj][4] = bflo(w.z); t[jj][5] = bfhi(w.z); t[jj][6] = bflo(w.w); t[jj][7] = bfhi(w.w); }
        }
#pragma unroll
        for (int jj = 0; jj < 4; ++jj)
#pragma unroll
            for (int e = 0; e < 8; ++e) ss += t[jj][e] * t[jj][e];
        const float rstd = rsqrtf(wave_sum(ss) * (1.0f / D) + EPS);
#pragma unroll
        for (int jj = 0; jj < 4; ++jj) { const int c = 8 * (64 * jj + lane);
            const f32x4 g0 = *(const f32x4*)(ga + c), g1 = *(const f32x4*)(ga + c + 4), q0 = *(const f32x4*)(gt + c), q1 = *(const f32x4*)(gt + c + 4);
            const float gg[8] = {g0.x, g0.y, g0.z, g0.w, g1.x, g1.y, g1.z, g1.w}, qq[8] = {q0.x, q0.y, q0.z, q0.w, q1.x, q1.y, q1.z, q1.w};
#pragma unroll
            for (int e = 0; e < 8; ++e) x[jj][e] += qq[e] * (t[jj][e] * rstd * gg[e]);
            if constexpr (XOUT32) { float* xr = Xout + (size_t)m * D; *(f32x4*)(xr + c) = (f32x4){x[jj][0], x[jj][1], x[jj][2], x[jj][3]}; *(f32x4*)(xr + c + 4) = (f32x4){x[jj][4], x[jj][5], x[jj][6], x[jj][7]}; }
            else { v4u o; o.x = pk2(x[jj][0], x[jj][1]); o.y = pk2(x[jj][2], x[jj][3]); o.z = pk2(x[jj][4], x[jj][5]); o.w = pk2(x[jj][6], x[jj][7]); *(v4u*)(X16 + (size_t)m * D + c) = o;
                if constexpr (NORM) {
#pragma unroll
                    for (int e = 0; e < 8; e += 2) { const unsigned w = e == 0 ? o.x : (e == 2 ? o.y : (e == 4 ? o.z : o.w)); x[jj][e] = bflo(w); x[jj][e + 1] = bfhi(w); } } }
        }
    }
    if constexpr (NORM) {
        float ss = 0.f;
#pragma unroll
        for (int jj = 0; jj < 4; ++jj)
#pragma unroll
            for (int e = 0; e < 8; ++e) ss += x[jj][e] * x[jj][e];
        const float rstd = rsqrtf(wave_sum(ss) * (1.0f / D) + EPS);
#pragma unroll
        for (int jj = 0; jj < 4; ++jj) { const int c = 8 * (64 * jj + lane);
            const f32x4 g0 = *(const f32x4*)(gb + c), g1 = *(const f32x4*)(gb + c + 4), h0 = *(const f32x4*)(sh + c), h1 = *(const f32x4*)(sh + c + 4), s0 = *(const f32x4*)(sc + c), s1 = *(const f32x4*)(sc + c + 4);
            const float gg[8] = {g0.x, g0.y, g0.z, g0.w, g1.x, g1.y, g1.z, g1.w}, hh[8] = {h0.x, h0.y, h0.z, h0.w, h1.x, h1.y, h1.z, h1.w}, cc[8] = {s0.x, s0.y, s0.z, s0.w, s1.x, s1.y, s1.z, s1.w};
            float y[8];
#pragma unroll
            for (int e = 0; e < 8; ++e) y[e] = (x[jj][e] * rstd * gg[e]) * (1.0f + cc[e]) + hh[e];
            v4u o; o.x = pk2(y[0], y[1]); o.y = pk2(y[2], y[3]); o.z = pk2(y[4], y[5]); o.w = pk2(y[6], y[7]);
            *(v4u*)(H + (size_t)m * D + c) = o; }
    }
}
template <bool RES, bool NORM, bool XIN, bool XOUT32>
__device__ __forceinline__ void resnorm_phase(const Params& P, unsigned char* ldsp, const bf16* T, const float* ga, const float* modv  , int gate_idx,
                                              const float* gb, const float* modn  , int shift_idx, int scale_idx, bf16* H) {
    const Frame F = make_frame(ldsp);
    const float* xin_p = P.in[I_XP]; const float* xin_s = P.in[I_XS]; bf16* X16 = (bf16*)(P.ws + WS_X16);
#define RN_LOAD(m_, XA, XH, TA) do { \
        if constexpr (XIN) { const float* xs_ = (m_) < MP ? xin_p + (size_t)(m_) * D : xin_s + (size_t)((m_) - MP) * D; \
            _Pragma("unroll") for (int jj = 0; jj < 4; ++jj) { const int c = 8 * (64 * jj + F.lane); XA[2 * jj] = *(const f32x4*)(xs_ + c); XA[2 * jj + 1] = *(const f32x4*)(xs_ + c + 4); } } \
        else { _Pragma("unroll") for (int jj = 0; jj < 4; ++jj) XH[jj] = *(const v4u*)(X16 + (size_t)(m_) * D + 8 * (64 * jj + F.lane)); } \
        if constexpr (RES) { if ((m_) < MSPLIT) { _Pragma("unroll") for (int jj = 0; jj < 4; ++jj) TA[jj] = *(const v4u*)(T + (size_t)(m_) * D + 8 * (64 * jj + F.lane)); } } } while (0)
#define RN_PROC(m_, XA, XH, TA) do { const int mi_ = mod_index(m_); \
        rn_process<RES, NORM, XIN, XOUT32>((m_), F.lane, XA, XH, TA, (const bf16*)(P.ws + WS_SLAB), X16, P.out, ga, RES ? modv + (size_t)mi_ * 12288 + (size_t)gate_idx * D : nullptr, gb, \
                              NORM ? modn + (size_t)mi_ * 12288 + (size_t)shift_idx * D : nullptr, NORM ? modn + (size_t)mi_ * 12288 + (size_t)scale_idx * D : nullptr, H); } while (0)
    f32x4 xa[8] = {}, xb[8] = {}; v4u xha[4] = {}, xhb[4] = {}, xhc[4] = {}, ta[4] = {}, tb[4] = {}, tc[4] = {};
    int m = F.gw; if (m >= M) return;
    const int S = F.NGW;
    if constexpr (XIN) {
        RN_LOAD(m, xa, xha, ta);
        for (;;) {
            if (m + S < M) RN_LOAD(m + S, xb, xhb, tb);
            RN_PROC(m, xa, xha, ta); m += S; if (m >= M) break;
            if (m + S < M) RN_LOAD(m + S, xa, xha, ta);
            RN_PROC(m, xb, xhb, tb); m += S; if (m >= M) break;
        }
    } else {
        RN_LOAD(m, xa, xha, ta); if (m + S < M) RN_LOAD(m + S, xa, xhb, tb);
        for (;;) {
            if (m + 2 * S < M) RN_LOAD(m + 2 * S, xa, xhc, tc);
            RN_PROC(m, xa, xha, ta); m += S; if (m >= M) break;
            if (m + 2 * S < M) RN_LOAD(m + 2 * S, xa, xha, ta);
            RN_PROC(m, xa, xhb, tb); m += S; if (m >= M) break;
            if (m + 2 * S < M) RN_LOAD(m + 2 * S, xa, xhb, tb);
            RN_PROC(m, xa, xhc, tc); m += S; if (m >= M) break;
        }
    }
#undef RN_LOAD
#undef RN_PROC
}

__device__ __forceinline__ float rope64(float v, int lane, int trow, int tcol, const f32x2* T16) {
    const int g = lane >> 5, w = lane & 31, i = w & 15;
    const float other = __shfl_xor(v, 16);
    const f32x2 cs = T16[(g ? tcol : trow) * 16 + i];
    return (w < 16) ? v * cs.x - other * cs.y : other * cs.y + v * cs.x;
}
__device__ __forceinline__ float rope_h64(float v, int lane, int pos, const f32x2* T32) {
    const int i = lane & 31;
    const float other = __shfl_xor(v, 32);
    const f32x2 cs = T32[pos * 32 + i];
    return (lane < 32) ? v * cs.x - other * cs.y : other * cs.y + v * cs.x;
}
__device__ __forceinline__ int key_row(int m) { return m < MP ? m : MP + ((m - MP) >> 12) * LSEQ + PAST + ((m - MP) & 4095); }

__device__ __forceinline__ void mla_cache_rows(const Params& P, unsigned char* ldsp, int j) {
    const Frame F = make_frame(ldsp);
    unsigned char* R = P.ws + WS_R; bf16* CKVF = (bf16*)(R + R_A_CKVF); bf16* KPEF = (bf16*)(R + R_A_KPEF);
    for (int r = F.gw; r < DB * PAST; r += F.NGW) {
        const int mb = r >> 9, p = r & 511; const int kr = MP + mb * LSEQ + p;
        const f32x4 c = *(const f32x4*)(P.in[I_CA_CKV] + ((size_t)(mb * 2 + j) * PAST + p) * 256 + 4 * F.lane);
        v2u o; o.x = pk2(c.x, c.y); o.y = pk2(c.z, c.w);
        *(v2u*)(CKVF + (size_t)kr * 256 + 4 * F.lane) = o;
        KPEF[(size_t)kr * 64 + F.lane] = (bf16)f2bf(P.in[I_CA_KPE][((size_t)(mb * 2 + j) * PAST + p) * 64 + F.lane]);
    }
}
__device__ __forceinline__ void diff_cache_rows(const Params& P, unsigned char* ldsp) {
    const Frame F = make_frame(ldsp);
    unsigned char* R = P.ws + WS_R; bf16* KF = (bf16*)(R + R_B_KF); bf16* VF = (bf16*)(R + R_B_VF);
    for (int r = F.gw; r < DB * PAST; r += F.NGW) {
        const int mb = r >> 9, p = r & 511; const int kr = MP + mb * LSEQ + p;
        const float* ck = P.in[I_CB_K] + (size_t)r * 2048; const float* cv = P.in[I_CB_V] + (size_t)r * 2048;
#pragma unroll
        for (int jj = 0; jj < 4; ++jj) { const int c = 8 * (64 * jj + F.lane);
            const f32x4 a = *(const f32x4*)(ck + c), b = *(const f32x4*)(ck + c + 4), e = *(const f32x4*)(cv + c), f = *(const f32x4*)(cv + c + 4);
            v4u o; o.x = pk2(a.x, a.y); o.y = pk2(a.z, a.w); o.z = pk2(b.x, b.y); o.w = pk2(b.z, b.w); *(v4u*)(KF + (size_t)kr * 2048 + c) = o;
            v4u q; q.x = pk2(e.x, e.y); q.y = pk2(e.z, e.w); q.z = pk2(f.x, f.y); q.w = pk2(f.z, f.w); *(v4u*)(VF + (size_t)kr * 2048 + c) = q; }
    }
}
__device__ __forceinline__ void diff_combine_phase(const Params& P, unsigned char* ldsp) {
    const Frame F = make_frame(ldsp);
    const bf16* OC = (const bf16*)(P.ws + WS_R + R_B_OC); bf16* AO = (bf16*)(P.ws + WS_AO);
    const float lam = ((const float*)(P.ws + WS_MISC))[0];
    const f32x2 sg = *(const f32x2*)(P.in[I_BSUBLN] + 2 * F.lane);
    for (int m = F.gw; m < M; m += F.NGW) {
        const unsigned* oc = (const unsigned*)(OC + (size_t)m * 4096) + F.lane; unsigned* ao = (unsigned*)(AO + (size_t)m * 2048) + F.lane;
#pragma unroll 4
        for (int h = 0; h < 16; ++h) { const unsigned w0 = oc[h * 128], w1 = oc[h * 128 + 64];
            const float a = bflo(w0) - lam * bflo(w1), b = bfhi(w0) - lam * bfhi(w1);
            const float rstd = rsqrtf(wave_sum(a * a + b * b) * (1.0f / 128.0f) + EPS) * (1.0f - LAM_INIT_1);
            ao[h * 64] = pk2(a * rstd * sg.x, b * rstd * sg.y); }
    }
}

__device__ __forceinline__ void gqa_cache_rows(const Params& P, unsigned char* ldsp) {
    const Frame F = make_frame(ldsp);
    unsigned char* R = P.ws + WS_R; bf16* KF = (bf16*)(R + R_C_KF); bf16* VF = (bf16*)(R + R_C_VF);
    for (int r = F.gw; r < DB * PAST; r += F.NGW) {
        const int mb = r >> 9, p = r & 511; const int kr = MP + mb * LSEQ + p;
        const float* ck = P.in[I_CC_K] + (size_t)r * 512 + 8 * F.lane; const float* cv = P.in[I_CC_V] + (size_t)r * 512 + 8 * F.lane;
        const f32x4 a = *(const f32x4*)ck, b = *(const f32x4*)(ck + 4), e = *(const f32x4*)cv, f = *(const f32x4*)(cv + 4);
        v4u o; o.x = pk2(a.x, a.y); o.y = pk2(a.z, a.w); o.z = pk2(b.x, b.y); o.w = pk2(b.z, b.w); *(v4u*)(KF + (size_t)kr * 512 + 8 * F.lane) = o;
        v4u q; q.x = pk2(e.x, e.y); q.y = pk2(e.z, e.w); q.z = pk2(f.x, f.y); q.w = pk2(f.z, f.w); *(v4u*)(VF + (size_t)kr * 512 + 8 * F.lane) = q;
    }
}

__device__ __forceinline__ v2u pack4(const f32x4 v) { v2u w; w.x = pg8::cvt_pk_bf16(v[0], v[1]); w.y = pg8::cvt_pk_bf16(v[2], v[3]); return w; }
__device__ __forceinline__ void rot4(f32x4& v0, f32x4& v1, const f32x4 cs01, const f32x4 cs23) {
    const f32x4 c = {cs01.x, cs01.z, cs23.x, cs23.z}, s = {cs01.y, cs01.w, cs23.y, cs23.w};
    const f32x4 a = v0 * c - v1 * s, b = v0 * s + v1 * c; v0 = a; v1 = b;
}
struct EpiMlaDown {
    static constexpr bool PERM = false, AFTER_DRAIN = false, PREFETCH = false, AROWPERM = false;
    bf16* D1; float* SSP; bf16* CKVF; bf16* KPEF; float* SCKV; float* SKPE; const float* kvn; const float* T16; LAS float* Pl; int j;
    __device__ __forceinline__ void operator()(const pg8::f32x4 (&acc)[2][2][4][2], const pg8::Unit& u, int wr, int wc, int fr_, int fq_) const {
        int fr = fr_, fq = fq_; asm volatile("" : "+v"(fr), "+v"(fq));
        const bool smp = u.pm >= MP / 256;
        if (u.pn < 2) {
#pragma unroll
            for (int ai = 0; ai < 2; ++ai)
#pragma unroll
                for (int m = 0; m < 4; ++m) { const int row = u.pm * 256 + ai * 128 + wr * 64 + m * 16 + fr; float ss = 0.f;
#pragma unroll
                    for (int bj = 0; bj < 2; ++bj) { const f32x4 a = acc[ai][bj][m][0], b = acc[ai][bj][m][1];
                        ss += ((a.x * a.x + a.y * a.y) + (a.z * a.z + a.w * a.w)) + ((b.x * b.x + b.y * b.y) + (b.z * b.z + b.w * b.w));
                        bf16* dst = D1 + (size_t)row * 1024 + u.pn * 256 + bj * 128 + wc * 32 + 4 * fq; *(v2u*)dst = pack4(a); *(v2u*)(dst + 16) = pack4(b); }
                    ss += __shfl_xor(ss, 16); ss += __shfl_xor(ss, 32);
                    if (fq == 0) SSP[(size_t)(u.pn * 4 + wc) * M + row] = ss; }
        } else if (u.pn == 2) {
#pragma unroll
            for (int ai = 0; ai < 2; ++ai)
#pragma unroll
                for (int m = 0; m < 4; ++m) { float ss = 0.f;
#pragma unroll
                    for (int bj = 0; bj < 2; ++bj) { const f32x4 a = acc[ai][bj][m][0], b = acc[ai][bj][m][1];
                        ss += ((a.x * a.x + a.y * a.y) + (a.z * a.z + a.w * a.w)) + ((b.x * b.x + b.y * b.y) + (b.z * b.z + b.w * b.w)); }
                    ss += __shfl_xor(ss, 16); ss += __shfl_xor(ss, 32);
                    if (fq == 0) Pl[(ai * 128 + wr * 64 + m * 16 + fr) * 4 + wc] = ss; }
            asm volatile("s_waitcnt lgkmcnt(0)" ::: "memory"); __builtin_amdgcn_s_barrier(); asm volatile("" ::: "memory");
#pragma unroll
            for (int ai = 0; ai < 2; ++ai)
#pragma unroll
                for (int m = 0; m < 4; ++m) { const int rl = ai * 128 + wr * 64 + m * 16 + fr, row = u.pm * 256 + rl; const int t = (row - MP) & 4095;
                    const int kr = smp ? MP + ((row - MP) >> 12) * LSEQ + PAST + t : row;
                    const f32x4 pp = *(const LAS f32x4*)(Pl + rl * 4); const float rstd = rsqrtf(((pp.x + pp.y) + (pp.z + pp.w)) * (1.0f / 256.0f) + EPS);
#pragma unroll
                    for (int bj = 0; bj < 2; ++bj) { const int c = bj * 128 + wc * 32 + 4 * fq;
                        const f32x4 y0 = acc[ai][bj][m][0] * rstd * *(const f32x4*)(kvn + c), y1 = acc[ai][bj][m][1] * rstd * *(const f32x4*)(kvn + c + 16);
                        bf16* dst = CKVF + (size_t)kr * 256 + c; *(v2u*)dst = pack4(y0); *(v2u*)(dst + 16) = pack4(y1);
                        if (!smp) { float* s = SCKV + ((size_t)((row >> 8) * 2 + j) * SEQ + (row & 255)) * 256 + c; *(f32x4*)s = y0; *(f32x4*)(s + 16) = y1; } } }
        } else if (wc < 2) {
#pragma unroll
            for (int ai = 0; ai < 2; ++ai)
#pragma unroll
                for (int m = 0; m < 4; ++m) { const int row = u.pm * 256 + ai * 128 + wr * 64 + m * 16 + fr; const int t = (row - MP) & 4095;
                    const int kr = smp ? MP + ((row - MP) >> 12) * LSEQ + PAST + t : row; const int c = wc * 32 + 4 * fq;
                    f32x4 v0 = acc[ai][0][m][0], v1 = acc[ai][0][m][1];
                    if (smp) { const int pos = wc ? (t & 63) : (t >> 6); const float* tp = T16 + (pos * 16 + 4 * fq) * 2; rot4(v0, v1, *(const f32x4*)tp, *(const f32x4*)(tp + 4)); }
                    else { float* s = SKPE + ((size_t)((row >> 8) * 2 + j) * SEQ + (row & 255)) * 64 + c; *(f32x4*)s = v0; *(f32x4*)(s + 16) = v1; }
                    bf16* dst = KPEF + (size_t)kr * 64 + c; *(v2u*)dst = pack4(v0); *(v2u*)(dst + 16) = pack4(v1); }
        }
    }
};
struct EpiMlaQ {
    static constexpr bool PERM = false, AFTER_DRAIN = false, PREFETCH = false, AROWPERM = false;
    bf16* Q; const float* T16; const float* SSP; LAS float* RSL;
    __device__ __forceinline__ void operator()(const pg8::f32x4 (&acc)[2][2][4][2], const pg8::Unit& u, int wr, int wc, int fr, int fq) const {
        const bool smp = u.pm >= MP / 256;
        { const int tid = (wr * 4 + wc) * 64 + fq * 16 + fr;
          if (tid < 256) { const int row = u.pm * 256 + tid; float s = 0.f;
#pragma unroll
              for (int q = 0; q < 8; ++q) s += SSP[(size_t)q * M + row];
              RSL[tid] = rsqrtf(s * (1.0f / 512.0f) + EPS); }
          asm volatile("s_waitcnt lgkmcnt(0)" ::: "memory"); __builtin_amdgcn_s_barrier(); asm volatile("" ::: "memory"); }
#pragma unroll
        for (int ai = 0; ai < 2; ++ai)
#pragma unroll
            for (int m = 0; m < 4; ++m) {
                const int rl = ai * 128 + wr * 64 + m * 16 + fr, row = u.pm * 256 + rl; const int t = (row - MP) & 4095;
                const float rs = RSL[rl];
#pragma unroll
                for (int bj = 0; bj < 2; ++bj) {
                    const int colb = u.pn * 256 + bj * 128 + wc * 32; const int g6 = (colb >> 5) % 6;
                    f32x4 v0 = acc[ai][bj][m][0] * rs, v1 = acc[ai][bj][m][1] * rs;
                    if (smp && g6 >= 4) { const int pos = g6 == 4 ? (t >> 6) : (t & 63); const float* tp = T16 + (pos * 16 + 4 * fq) * 2; rot4(v0, v1, *(const f32x4*)tp, *(const f32x4*)(tp + 4)); }
                    bf16* dst = Q + (size_t)row * 3072 + colb + 4 * fq;
                    *(v2u*)dst = pack4(v0); *(v2u*)(dst + 16) = pack4(v1);
                }
            }
    }
};
struct EpiDiffQKV {
    static constexpr bool PERM = false, AFTER_DRAIN = false, PREFETCH = false, AROWPERM = false;
    bf16* Q; bf16* KF; bf16* VF; float* SK; float* SV; const float* T16;
    __device__ __forceinline__ void operator()(const pg8::f32x4 (&acc)[2][2][4][2], const pg8::Unit& u, int wr, int wc, int fr, int fq) const {
        const int region = u.pn >> 3; const bool smp = u.pm >= MP / 256;
#pragma unroll
        for (int ai = 0; ai < 2; ++ai)
#pragma unroll
            for (int m = 0; m < 4; ++m) {
                const int row = u.pm * 256 + ai * 128 + wr * 64 + m * 16 + fr; const int t = (row - MP) & 4095;
                const int kr = smp ? MP + ((row - MP) >> 12) * LSEQ + PAST + t : row;
#pragma unroll
                for (int bj = 0; bj < 2; ++bj) {
                    const int colr = (u.pn & 7) * 256 + bj * 128 + wc * 32 + 4 * fq;
                    f32x4 v0 = acc[ai][bj][m][0], v1 = acc[ai][bj][m][1];
                    if (region < 2 && smp) { const int pos = (wc & 1) ? (t & 63) : (t >> 6); const float* tp = T16 + (pos * 16 + 4 * fq) * 2; rot4(v0, v1, *(const f32x4*)tp, *(const f32x4*)(tp + 4)); }
                    bf16* dst = region == 0 ? Q + (size_t)row * 2048 + colr : (region == 1 ? KF : VF) + (size_t)kr * 2048 + colr;
                    *(v2u*)dst = pack4(v0); *(v2u*)(dst + 16) = pack4(v1);
                    if (region >= 1 && !smp) { float* s = (region == 1 ? SK : SV) + (size_t)row * 2048 + colr; *(f32x4*)s = v0; *(f32x4*)(s + 16) = v1; }
                }
            }
    }
};
struct EpiGqaQKV {
    static constexpr bool PERM = false, AFTER_DRAIN = false, PREFETCH = false, AROWPERM = false;
    bf16* Q; bf16* KF; bf16* VF; float* SK; float* SV; const float* T32; const float* qn; const float* kn; LAS float* Pl;
    __device__ __forceinline__ void operator()(const pg8::f32x4 (&acc)[2][2][4][2], const pg8::Unit& u, int wr, int wc, int fr, int fq) const {
        const bool smp = u.pm >= MP / 256; const bool isv = u.pn >= 10, isk = u.pn >= 8 && !isv;
        if (!isv) {
#pragma unroll
            for (int ai = 0; ai < 2; ++ai)
#pragma unroll
                for (int m = 0; m < 4; ++m)
#pragma unroll
                    for (int bj = 0; bj < 2; ++bj) { const f32x4 a = acc[ai][bj][m][0], b = acc[ai][bj][m][1];
                        float ss = ((a.x * a.x + a.y * a.y) + (a.z * a.z + a.w * a.w)) + ((b.x * b.x + b.y * b.y) + (b.z * b.z + b.w * b.w));
                        ss += __shfl_xor(ss, 16); ss += __shfl_xor(ss, 32);
                        if (fq == 0) Pl[((ai * 128 + wr * 64 + m * 16 + fr) * 2 + bj) * 4 + wc] = ss; }
            asm volatile("s_waitcnt lgkmcnt(0)" ::: "memory"); __builtin_amdgcn_s_barrier(); asm volatile("" ::: "memory");
        }
#pragma unroll
        for (int ai = 0; ai < 2; ++ai)
#pragma unroll
            for (int m = 0; m < 4; ++m) {
                const int row = u.pm * 256 + ai * 128 + wr * 64 + m * 16 + fr; const int t = (row - MP) & 4095;
                const int kr = smp ? MP + ((row - MP) >> 12) * LSEQ + PAST + t : row;
#pragma unroll
                for (int bj = 0; bj < 2; ++bj) {
                    const int head = u.pn * 2 + bj;
                    f32x4 v0 = acc[ai][bj][m][0], v1 = acc[ai][bj][m][1];
                    if (isv) { const int c = (head - 20) * 128 + wc * 32 + 4 * fq; bf16* dst = VF + (size_t)kr * 512 + c; *(v2u*)dst = pack4(v0); *(v2u*)(dst + 16) = pack4(v1);
                        if (!smp) { float* s = SV + (size_t)row * 512 + c; *(f32x4*)s = v0; *(f32x4*)(s + 16) = v1; } }
                    else {
                        const f32x4 pp = *(const LAS f32x4*)(Pl + ((ai * 128 + wr * 64 + m * 16 + fr) * 2 + bj) * 4);
                        const float rstd = rsqrtf(((pp.x + pp.y) + (pp.z + pp.w)) * (1.0f / 128.0f) + EPS);
                        const int d0 = 64 * (wc >> 1) + 16 * (wc & 1) + 4 * fq;
                        const float* gn = isk ? kn : qn;
                        v0 = v0 * rstd * *(const f32x4*)(gn + d0); v1 = v1 * rstd * *(const f32x4*)(gn + d0 + 32);
                        if (isk && !smp) { float* s = SK + (size_t)row * 512 + (head - 16) * 128 + d0; *(f32x4*)s = v0; *(f32x4*)(s + 32) = v1; }
                        if (smp) { const int pos = (wc >> 1) ? (t & 63) : (t >> 6); const float* tp = T32 + (pos * 32 + 16 * (wc & 1) + 4 * fq) * 2; rot4(v0, v1, *(const f32x4*)tp, *(const f32x4*)(tp + 4)); }
                        bf16* dst = isk ? KF + (size_t)kr * 512 + (head - 16) * 128 + d0 : Q + (size_t)row * 2048 + head * 128 + d0;
                        *(v2u*)dst = pack4(v0); *(v2u*)(dst + 32) = pack4(v1);
                    }
                }
            }
    }
};

template <int CTRL> __device__ __forceinline__ float dppf(float old, float src) { return __builtin_bit_cast(float, __builtin_amdgcn_update_dpp(__builtin_bit_cast(int, old), __builtin_bit_cast(int, src), CTRL, 0xf, 0xf, false)); }
constexpr int DPP_SHL1 = 0x101, DPP_SHR1 = 0x111, DPP_ROR1 = 0x121, DPP_ROR15 = 0x12F;
__device__ __forceinline__ void fmac_shr1(float& y, float src, float wv) { asm("v_fmac_f32_dpp %0, %1, %2 row_shr:1 row_mask:0xf bank_mask:0xf" : "+v"(y) : "v"(src), "v"(wv)); }
__device__ __forceinline__ void fmac_shl1(float& y, float src, float wv) { asm("v_fmac_f32_dpp %0, %1, %2 row_shl:1 row_mask:0xf bank_mask:0xf" : "+v"(y) : "v"(src), "v"(wv)); }
__device__ __forceinline__ void fmac_ror1(float& y, float src, float wv) { asm("v_fmac_f32_dpp %0, %1, %2 row_ror:1 row_mask:0xf bank_mask:0xf" : "+v"(y) : "v"(src), "v"(wv)); }
__device__ __forceinline__ void fmac_ror15(float& y, float src, float wv) { asm("v_fmac_f32_dpp %0, %1, %2 row_ror:15 row_mask:0xf bank_mask:0xf" : "+v"(y) : "v"(src), "v"(wv)); }
__device__ __forceinline__ float silu_gate(float g, float v) { return g * v * __builtin_amdgcn_rcpf(1.0f + __builtin_amdgcn_exp2f(-1.4426950408889634f * g)); }
struct EpiConvGate {
    static constexpr bool PERM = true, AFTER_DRAIN = false, PREFETCH = true, AROWPERM = true;
    bf16* G; float* EDGE; const float* cw; const float* cb; LAS float* EX;
    __device__ __forceinline__ void prefetch(const pg8::Unit& u, int tid, float& p0, float& p1) const {
        const int idx = tid * 2, k = idx >> 8, bjl = (idx >> 7) & 1, cl = idx & 127;
        const float* src = (k < 3 ? cw + (size_t)k * NFF : cb) + bjl * DFF + u.pn * 128 + cl; const f32x2 v = *(const f32x2*)src; p0 = v.x; p1 = v.y; }
    __device__ __forceinline__ void stash(int tid, float p0, float p1) const { *(LAS f32x2*)(EX + 2048 + tid * 2) = (f32x2){p0, p1}; }
    __device__ __forceinline__ void operator()(const pg8::f32x4 (&acc)[2][2][4][2], const pg8::Unit& u, int wr, int wc, int fr, int fq) const {
        const int ch = wc * 32 + 8 * fq;
        LAS float* WL = EX + 2048;
#pragma unroll
        for (int ai = 0; ai < 2; ++ai) { const int b = 2 * ai + wr;
#pragma unroll
            for (int bj = 0; bj < 2; ++bj)
#pragma unroll
                for (int n = 0; n < 2; ++n) {
                    if (fr == 0)  *(LAS f32x4*)(EX + ((b * 2 + 0) * 2 + bj) * 128 + ch + 4 * n) = acc[ai][bj][0][n];
                    if (fr == 15) *(LAS f32x4*)(EX + ((b * 2 + 1) * 2 + bj) * 128 + ch + 4 * n) = acc[ai][bj][3][n];
                } }
        if (u.pm >= MP / 256) {
            float* ed = EDGE + ((size_t)u.pm * 44 + u.pn) * 1024;
#pragma unroll
            for (int bj = 0; bj < 2; ++bj)
#pragma unroll
                for (int n = 0; n < 2; ++n) {
                    if (wr == 0 && fr == 0)  { *(f32x4*)(ed + 0 * 256 + bj * 128 + ch + 4 * n) = acc[0][bj][0][n]; *(f32x4*)(ed + 1 * 256 + bj * 128 + ch + 4 * n) = acc[0][bj][1][n]; }
                    if (wr == 1 && fr == 15) { *(f32x4*)(ed + 2 * 256 + bj * 128 + ch + 4 * n) = acc[1][bj][2][n]; *(f32x4*)(ed + 3 * 256 + bj * 128 + ch + 4 * n) = acc[1][bj][3][n]; }
                }
        }
        asm volatile("s_waitcnt lgkmcnt(0)" ::: "memory"); __builtin_amdgcn_s_barrier(); asm volatile("" ::: "memory");
        v2u keep[2][4];
#pragma unroll
        for (int n = 0; n < 2; ++n) {
            f32x4 w0[2], w1[2], w2[2], bb[2], w0e[2], w2e[2];
#pragma unroll
            for (int bj = 0; bj < 2; ++bj) { const int c = bj * 128 + ch + 4 * n; const f32x4 z = {0.f, 0.f, 0.f, 0.f};
                w0[bj] = *(const LAS f32x4*)(WL + c); w1[bj] = *(const LAS f32x4*)(WL + 256 + c); w2[bj] = *(const LAS f32x4*)(WL + 512 + c); bb[bj] = *(const LAS f32x4*)(WL + 768 + c);
                w0e[bj] = fr == 0 ? w0[bj] : z; w2e[bj] = fr == 15 ? w2[bj] : z; }
#pragma unroll
            for (int ai = 0; ai < 2; ++ai) { const int b = 2 * ai + wr;
                f32x4 y[2][4];
#pragma unroll
                for (int bj = 0; bj < 2; ++bj) {
                    const f32x4 z = {0.f, 0.f, 0.f, 0.f};
                    const f32x4 ht = b > 0 ? *(const LAS f32x4*)(EX + (((b - 1) * 2 + 1) * 2 + bj) * 128 + ch + 4 * n) : z;
                    const f32x4 hb = b < 3 ? *(const LAS f32x4*)(EX + (((b + 1) * 2 + 0) * 2 + bj) * 128 + ch + 4 * n) : z;
                    const f32x4 v0 = acc[ai][bj][0][n], v1 = acc[ai][bj][1][n], v2 = acc[ai][bj][2][n], v3 = acc[ai][bj][3][n];
                    f32x4 y0 = w1[bj] * v0 + bb[bj] + w2[bj] * v1 + w0e[bj] * ht;
                    const f32x4 y1 = w1[bj] * v1 + bb[bj] + w0[bj] * v0 + w2[bj] * v2;
                    const f32x4 y2 = w1[bj] * v2 + bb[bj] + w0[bj] * v1 + w2[bj] * v3;
                    f32x4 y3 = w1[bj] * v3 + bb[bj] + w0[bj] * v2 + w2e[bj] * hb;
#pragma unroll
                    for (int e = 0; e < 4; ++e) { float a0 = y0[e], a3 = y3[e];
                        fmac_shr1(a0, v3[e], w0[bj][e]);
                        fmac_shl1(a3, v0[e], w2[bj][e]);
                        y0[e] = a0; y3[e] = a3; }
                    y[bj][0] = y0; y[bj][1] = y1; y[bj][2] = y2; y[bj][3] = y3;
                }
#pragma unroll
                for (int m = 0; m < 4; ++m) { f32x4 g;
#pragma unroll
                    for (int e = 0; e < 4; ++e) g[e] = silu_gate(y[0][m][e], y[1][m][e]);
                    const int row = u.pm * 256 + ai * 128 + wr * 64 + 4 * fr + m;
                    const v2u pk = pack4(g);
                    if (n == 0) keep[ai][m] = pk;
                    else { v4u o; o.x = keep[ai][m].x; o.y = keep[ai][m].y; o.z = pk.x; o.w = pk.y; *(v4u*)(G + (size_t)row * DFF + u.pn * 128 + ch) = o; } }
            }
        }
    }
};
__device__ __forceinline__ void conv_fix_phase(const Params& P, unsigned char* ldsp, int l) {
    const Frame F = make_frame(ldsp);
    bf16* G = (bf16*)(P.ws + WS_R + R_G); const float* EDGE = (const float*)(P.ws + WS_EDGE);
    const float* cw = P.in[I_FCW] + (size_t)l * 3 * NFF; const float* cb = P.in[I_FCB] + (size_t)l * NFF;
    for (int it = F.gw; it < DB * 15 * 44; it += F.NGW) {
        const int pn = it % 44, eb = it / 44, mb = eb / 15, k = eb % 15, pm = MP / 256 + mb * 16 + k;
        const float* e0 = EDGE + ((size_t)pm * 44 + pn) * 1024; const float* e1 = EDGE + ((size_t)(pm + 1) * 44 + pn) * 1024;
        const int c2 = 2 * F.lane;
        f32x2 ua[2], ub[2], uc[2], ud[2], w0[2], w1[2], w2[2], bb[2];
#pragma unroll
        for (int bj = 0; bj < 2; ++bj) { ua[bj] = *(const f32x2*)(e0 + 2 * 256 + bj * 128 + c2); ub[bj] = *(const f32x2*)(e0 + 3 * 256 + bj * 128 + c2); uc[bj] = *(const f32x2*)(e1 + bj * 128 + c2); ud[bj] = *(const f32x2*)(e1 + 256 + bj * 128 + c2);
            const int c = bj * DFF + pn * 128 + c2; w0[bj] = *(const f32x2*)(cw + c); w1[bj] = *(const f32x2*)(cw + NFF + c); w2[bj] = *(const f32x2*)(cw + 2 * NFF + c); bb[bj] = *(const f32x2*)(cb + c); }
        f32x2 ya[2], yb[2];
#pragma unroll
        for (int bj = 0; bj < 2; ++bj) { ya[bj] = w0[bj] * ua[bj] + w1[bj] * ub[bj] + w2[bj] * uc[bj] + bb[bj]; yb[bj] = w0[bj] * ub[bj] + w1[bj] * uc[bj] + w2[bj] * ud[bj] + bb[bj]; }
        const int rlast = pm * 256 + 255;
        *(unsigned*)(G + (size_t)rlast * DFF + pn * 128 + c2) = pg8::cvt_pk_bf16(silu_gate(ya[0].x, ya[1].x), silu_gate(ya[0].y, ya[1].y));
        *(unsigned*)(G + (size_t)(rlast + 1) * DFF + pn * 128 + c2) = pg8::cvt_pk_bf16(silu_gate(yb[0].x, yb[1].x), silu_gate(yb[0].y, yb[1].y));
    }
}

__device__ __forceinline__ void cg_row(const v4u pg, const v4u cg, const v4u ng, const v4u pv, const v4u cv, const v4u nv, const float (&wg)[3][8], const float (&wv)[3][8], const float (&bg)[8], const float (&bv)[8], bf16* dst) {
    const unsigned pgw[4] = {pg.x, pg.y, pg.z, pg.w}, cgw[4] = {cg.x, cg.y, cg.z, cg.w}, ngw[4] = {ng.x, ng.y, ng.z, ng.w};
    const unsigned pvw[4] = {pv.x, pv.y, pv.z, pv.w}, cvw[4] = {cv.x, cv.y, cv.z, cv.w}, nvw[4] = {nv.x, nv.y, nv.z, nv.w};
    float y[8];
#pragma unroll
    for (int e = 0; e < 8; ++e) { const int w = e >> 1;
        const float gp = (e & 1) ? bfhi(pgw[w]) : bflo(pgw[w]), gc = (e & 1) ? bfhi(cgw[w]) : bflo(cgw[w]), gn = (e & 1) ? bfhi(ngw[w]) : bflo(ngw[w]);
        const float vp = (e & 1) ? bfhi(pvw[w]) : bflo(pvw[w]), vc = (e & 1) ? bfhi(cvw[w]) : bflo(cvw[w]), vn = (e & 1) ? bfhi(nvw[w]) : bflo(nvw[w]);
        const float gt = gp * wg[0][e] + gc * wg[1][e] + gn * wg[2][e] + bg[e];
        const float vl = vp * wv[0][e] + vc * wv[1][e] + vn * wv[2][e] + bv[e];
        y[e] = silu_f(gt) * vl; }
    v4u o; o.x = pk2(y[0], y[1]); o.y = pk2(y[2], y[3]); o.z = pk2(y[4], y[5]); o.w = pk2(y[6], y[7]);
    *(v4u*)dst = o;
}
__device__ __forceinline__ void conv_gate_phase(const Params& P, unsigned char* ldsp, int l) {
    const Frame F = make_frame(ldsp);
    const bf16* U = (const bf16*)(P.ws + WS_R + R_U); bf16* G = (bf16*)(P.ws + WS_R + R_G);
    const float* cw = P.in[I_FCW] + (size_t)l * 3 * NFF; const float* cb = P.in[I_FCB] + (size_t)l * NFF;
    constexpr int RC = 32, NRC = M / RC, NCC = DFF / 512;
    for (int u = F.gw; u < NRC * NCC; u += F.NGW) {
        const int rc = u / NCC, cc = u % NCC, r0 = rc * RC, c0 = cc * 512 + 8 * F.lane;
        float wg[3][8], wv[3][8], bg[8], bv[8];
#pragma unroll
        for (int k = 0; k < 3; ++k) { const f32x4 a = *(const f32x4*)(cw + (size_t)k * NFF + c0), b = *(const f32x4*)(cw + (size_t)k * NFF + c0 + 4), c = *(const f32x4*)(cw + (size_t)k * NFF + DFF + c0), d = *(const f32x4*)(cw + (size_t)k * NFF + DFF + c0 + 4);
            wg[k][0] = a.x; wg[k][1] = a.y; wg[k][2] = a.z; wg[k][3] = a.w; wg[k][4] = b.x; wg[k][5] = b.y; wg[k][6] = b.z; wg[k][7] = b.w;
            wv[k][0] = c.x; wv[k][1] = c.y; wv[k][2] = c.z; wv[k][3] = c.w; wv[k][4] = d.x; wv[k][5] = d.y; wv[k][6] = d.z; wv[k][7] = d.w; }
        { const f32x4 a = *(const f32x4*)(cb + c0), b = *(const f32x4*)(cb + c0 + 4), c = *(const f32x4*)(cb + DFF + c0), d = *(const f32x4*)(cb + DFF + c0 + 4);
            bg[0] = a.x; bg[1] = a.y; bg[2] = a.z; bg[3] = a.w; bg[4] = b.x; bg[5] = b.y; bg[6] = b.z; bg[7] = b.w;
            bv[0] = c.x; bv[1] = c.y; bv[2] = c.z; bv[3] = c.w; bv[4] = d.x; bv[5] = d.y; bv[6] = d.z; bv[7] = d.w; }
        const int spos = r0 < MP ? (r0 & 255) : ((r0 - MP) & 4095), slen = r0 < MP ? 256 : 4096;
        const bool has_prev = spos > 0, has_next = spos + RC < slen;
        const v4u z = {0u, 0u, 0u, 0u};
        const bf16* Ug = U + (size_t)r0 * NFF + c0; const bf16* Uv = Ug + DFF; bf16* Go = G + (size_t)r0 * DFF + c0;
        v4u pg = has_prev ? *(const v4u*)(Ug - NFF) : z, pv = has_prev ? *(const v4u*)(Uv - NFF) : z;
        v4u cg = *(const v4u*)Ug, cv = *(const v4u*)Uv;
        v4u ag[4], av[4], bgq[4], bvq[4];
#define CG_LOAD(XG, XV, r_) do { _Pragma("unroll") for (int q = 0; q < 4; ++q) { const int rr = (r_) + 1 + q; const bool ok = rr < RC || (rr == RC && has_next); \
            XG[q] = ok ? *(const v4u*)(Ug + (size_t)rr * NFF) : z; XV[q] = ok ? *(const v4u*)(Uv + (size_t)rr * NFF) : z; } } while (0)
#define CG_STEP(XG, XV, r_) do { cg_row(pg, cg, XG[0], pv, cv, XV[0], wg, wv, bg, bv, Go + (size_t)(r_) * DFF); cg_row(cg, XG[0], XG[1], cv, XV[0], XV[1], wg, wv, bg, bv, Go + (size_t)((r_) + 1) * DFF); \
            cg_row(XG[0], XG[1], XG[2], XV[0], XV[1], XV[2], wg, wv, bg, bv, Go + (size_t)((r_) + 2) * DFF); cg_row(XG[1], XG[2], XG[3], XV[1], XV[2], XV[3], wg, wv, bg, bv, Go + (size_t)((r_) + 3) * DFF); \
            pg = XG[2]; pv = XV[2]; cg = XG[3]; cv = XV[3]; } while (0)
        CG_LOAD(ag, av, 0);
        for (int r = 0; r < RC; r += 8) {
            CG_LOAD(bgq, bvq, r + 4);
            CG_STEP(ag, av, r);
            if (r + 8 < RC) CG_LOAD(ag, av, r + 8);
            CG_STEP(bgq, bvq, r + 4);
        }
#undef CG_LOAD
#undef CG_STEP
    }
}

#ifndef SEED_MASK
#define SEED_MASK 7
#endif
#ifndef M192
#define M192 true
#endif
namespace att {
constexpr int NW = 8, QBLK = 32, KVBLK = 64;
constexpr float THR = 8.f;
#define SBAR() __builtin_amdgcn_sched_barrier(0)
__device__ __forceinline__ int crow(int r, int hi) { return (r & 3) + 8 * (r >> 2) + 4 * hi; }
__device__ __forceinline__ unsigned cvtpk(float lo, float hi) { unsigned r; asm volatile("v_cvt_pk_bf16_f32 %0, %1, %2" : "=v"(r) : "v"(lo), "v"(hi)); return r; }
__device__ __forceinline__ bf16x8 ld8(const bf16* p) { return *reinterpret_cast<const bf16x8*>(p); }

template <int DQK> __device__ __forceinline__ void partialSM(f32x16& p0, f32x16& p1, float& m_reg, float& mn, float& alpha) {
  constexpr float SCALE = DQK == 64 ? 0.125f : (DQK == 128 ? 0.088388347648318440f : 0.072168783648703220f);
  constexpr float C = SCALE * 1.4426950408889634f;
  float pmax = p0[0];
#pragma unroll
  for (int r = 1; r < 16; ++r) pmax = fmaxf(pmax, p0[r]);
#pragma unroll
  for (int r = 0; r < 16; ++r) pmax = fmaxf(pmax, p1[r]);
  { auto rr = __builtin_amdgcn_permlane32_swap(__float_as_uint(pmax), __float_as_uint(pmax), false, false);
    pmax = fmaxf(__uint_as_float(rr[0]), __uint_as_float(rr[1])); }
  if (__builtin_expect(__all(pmax - m_reg <= THR / SCALE), 1)) { mn = m_reg; alpha = 1.f; }
  else { mn = fmaxf(m_reg, pmax); alpha = __builtin_amdgcn_exp2f((m_reg - mn) * C); m_reg = mn; }
  const float mnC = -mn * C;
#pragma unroll
  for (int r = 0; r < 16; ++r) p0[r] = fmaf(p0[r], C, mnC);
#pragma unroll
  for (int r = 0; r < 16; ++r) p1[r] = fmaf(p1[r], C, mnC);
#pragma unroll
  for (int r = 0; r < 16; ++r) p0[r] = __builtin_amdgcn_exp2f(p0[r]);
}
__device__ __forceinline__ void finishSM(f32x16& p0, f32x16& p1, float alpha, float& l_reg, bf16x8& pa0, bf16x8& pa1, bf16x8& pa2, bf16x8& pa3) {
#pragma unroll
  for (int r = 0; r < 16; ++r) p1[r] = __builtin_amdgcn_exp2f(p1[r]);
  float ps = 0;
#pragma unroll
  for (int r = 0; r < 16; ++r) ps += p0[r];
#pragma unroll
  for (int r = 0; r < 16; ++r) ps += p1[r];
  { auto rr = __builtin_amdgcn_permlane32_swap(__float_as_uint(ps), __float_as_uint(ps), false, false);
    ps = __uint_as_float(rr[0]) + __uint_as_float(rr[1]); }
  l_reg = l_reg * alpha + ps;
#define PK4(P, BASE, OUT) do { unsigned a0 = cvtpk(P[BASE + 0], P[BASE + 1]), a1 = cvtpk(P[BASE + 2], P[BASE + 3]);   \
    unsigned b0 = cvtpk(P[BASE + 4], P[BASE + 5]), b1 = cvtpk(P[BASE + 6], P[BASE + 7]);                              \
    auto r0 = __builtin_amdgcn_permlane32_swap(a0, b0, false, false); auto r1 = __builtin_amdgcn_permlane32_swap(a1, b1, false, false); \
    v4u w = {r0[0], r1[0], r0[1], r1[1]}; OUT = *reinterpret_cast<bf16x8*>(&w); } while (0)
  PK4(p0, 0, pa0); PK4(p0, 8, pa1); PK4(p1, 0, pa2); PK4(p1, 8, pa3);
#undef PK4
}
template <int DQK> __device__ __forceinline__ int kswz(int row, int colB) { return row * (DQK * 2) + (colB ^ ((DQK == 128 ? (row & 15) : ((row >> 1) & 7)) << 4)); }
template <int DQK, bool QLDS> __device__ __forceinline__ void qkt(f32x16& p0, f32x16& p1, const char* Ks, const bf16x8* qr, const char* qpe, int r32, int hi) {
  p0 = f32x16{}; p1 = f32x16{};
#pragma unroll
  for (int d0 = 0; d0 < DQK / 16; ++d0) { const int cb = (d0 * 16 + hi * 8) * 2;
    const bf16x8 b0 = *reinterpret_cast<const bf16x8*>(Ks + kswz<DQK>(r32, cb));
    const bf16x8 b1 = *reinterpret_cast<const bf16x8*>(Ks + kswz<DQK>(32 + r32, cb));
    bf16x8 q;
    if constexpr (QLDS) { if (d0 >= 8) q = *reinterpret_cast<const bf16x8*>(qpe + kswz<64>(r32, cb - 256)); else q = qr[d0]; } else q = qr[d0];
    p0 = __builtin_amdgcn_mfma_f32_32x32x16_bf16(b0, q, p0, 0, 0, 0);
    p1 = __builtin_amdgcn_mfma_f32_32x32x16_bf16(b1, q, p1, 0, 0, 0); }
}
__device__ __forceinline__ int v_st(int k, int c) { const int kk = (k & ~0xC) | ((k & 4) << 1) | ((k & 8) >> 1); return ((kk >> 3) * 4 + (c >> 5)) * 512 + ((kk & 7) * 32 + (c & 31)) * 2; }
__device__ __forceinline__ int v_stn(int k, int c) { return ((k >> 3) * 4 + (c >> 5)) * 512 + ((k & 7) * 32 + (c & 31)) * 2; }
__device__ __forceinline__ int v_rd_base(int lane) { return ((lane & 3) << 3) | (((lane >> 2) & 3) << 6) | (((lane >> 4) & 1) << 5) | (((lane >> 5) & 1) << 8); }
constexpr int v_rd_off(int d0, int ks, int half) { return d0 * 512 + ks * 4096 + half * 2048; }
template <int OFF> __device__ __forceinline__ s16x4 tr_read(int vb) {
  s16x4 r; asm volatile("ds_read_b64_tr_b16 %0, %1 offset:%2" : "=&v"(r) : "v"(vb), "i"(OFF) : "memory"); return r;
}
template <int D0> __device__ __forceinline__ void pv_one(f32x16& od, int vb, bf16x8 pa0, bf16x8 pa1, bf16x8 pa2, bf16x8 pa3) {
  const s16x4 l0 = tr_read<v_rd_off(D0, 0, 0)>(vb), h0 = tr_read<v_rd_off(D0, 0, 1)>(vb), l1 = tr_read<v_rd_off(D0, 1, 0)>(vb), h1 = tr_read<v_rd_off(D0, 1, 1)>(vb);
  const s16x4 l2 = tr_read<v_rd_off(D0, 2, 0)>(vb), h2 = tr_read<v_rd_off(D0, 2, 1)>(vb), l3 = tr_read<v_rd_off(D0, 3, 0)>(vb), h3 = tr_read<v_rd_off(D0, 3, 1)>(vb);
  asm volatile("s_waitcnt lgkmcnt(0)" ::: "memory"); SBAR();
#define PK(L, H) (bf16x8){L[0], L[1], L[2], L[3], H[0], H[1], H[2], H[3]}
  od = __builtin_amdgcn_mfma_f32_32x32x16_bf16(pa0, PK(l0, h0), od, 0, 0, 0);
  od = __builtin_amdgcn_mfma_f32_32x32x16_bf16(pa1, PK(l1, h1), od, 0, 0, 0);
  od = __builtin_amdgcn_mfma_f32_32x32x16_bf16(pa2, PK(l2, h2), od, 0, 0, 0);
  od = __builtin_amdgcn_mfma_f32_32x32x16_bf16(pa3, PK(l3, h3), od, 0, 0, 0);
#undef PK
}
__device__ __forceinline__ void pv_d0(f32x16* o, int vb, bf16x8 pa0, bf16x8 pa1, bf16x8 pa2, bf16x8 pa3) {
  pv_one<0>(o[0], vb, pa0, pa1, pa2, pa3); pv_one<1>(o[1], vb, pa0, pa1, pa2, pa3); pv_one<2>(o[2], vb, pa0, pa1, pa2, pa3); pv_one<3>(o[3], vb, pa0, pa1, pa2, pa3);
}

template <int DQK, int SDEPTH, bool QLDS>
__device__ __forceinline__ void attn_unit(const bf16* __restrict__ Qb, int ldq, const bf16* __restrict__ Kh, int ldk, const bf16* __restrict__ Kp, int ldkp,
                                          const bf16* __restrict__ Vh, int ldv, bf16* __restrict__ Ob, int ldo, int seq, char* lds) {
  constexpr int SHM_V = KVBLK * 128 * 2, SHM_K = KVBLK * DQK * 2;
  int tid_ = threadIdx.x; asm volatile("" : "+v"(tid_));
  const int tid = tid_, wid = tid >> 6, lane = tid & 63, r32 = lane & 31, hi = lane >> 5;
  char* V_lds = lds; char* K_lds = lds + 2 * SHM_V;
  float* wsf = (float*)(lds + 2 * SHM_V + 2 * SHM_K) + wid * 64; float* li_l = wsf; float* al_l = wsf + 32;
  constexpr int NQR = QLDS ? 8 : DQK / 16;
  float m_reg = -1e30f, l_reg = 0; f32x16 o[4] = {}; bf16x8 qr[NQR];
  const bf16* Qw = Qb + (long)(wid * QBLK + r32) * ldq + hi * 8;
#pragma unroll
  for (int d0 = 0; d0 < NQR; ++d0) qr[d0] = ld8(Qw + d0 * 16);
  char* qpe_l = lds + 2 * SHM_V + 2 * SHM_K + 2048 + wid * 4096;
  if constexpr (QLDS) {
#pragma unroll
    for (int d0 = 8; d0 < DQK / 16; ++d0) *(bf16x8*)(qpe_l + kswz<64>(r32, (d0 * 16 + hi * 8) * 2 - 256)) = ld8(Qw + d0 * 16);
    asm volatile("s_waitcnt lgkmcnt(0)" ::: "memory");
  }
  const int sr = tid >> 4, sc = (tid & 15) * 8, vst0 = v_st(sr, sc), vst1 = v_st(32 + sr, sc);
  const int sr8 = tid >> 3, sc8 = (tid & 7) * 8;
  const int vb0 = (int)(uintptr_t)V_lds + v_rd_base(lane);
  struct Slot { bf16x8 vs0, vs1, ks0, ks1, kp; } sr_[SDEPTH];
  constexpr int SE = 0, SO = SDEPTH - 1;
#define SLOAD(i, k0) do { sr_[i].vs0 = ld8(&Vh[(long)((k0) + sr) * ldv + sc]); sr_[i].vs1 = ld8(&Vh[(long)((k0) + 32 + sr) * ldv + sc]); \
    if constexpr (DQK == 64) { sr_[i].ks0 = ld8(&Kh[(long)((k0) + sr8) * ldk + sc8]); } \
    else { sr_[i].ks0 = ld8(&Kh[(long)((k0) + sr) * ldk + sc]); sr_[i].ks1 = ld8(&Kh[(long)((k0) + 32 + sr) * ldk + sc]); } \
    if constexpr (DQK == 192) { sr_[i].kp = ld8(&Kp[(long)((k0) + sr8) * ldkp + sc8]); } } while (0)
#define SWRITE(b, i) do { *(bf16x8*)(V_lds + (b) * SHM_V + vst0) = sr_[i].vs0; *(bf16x8*)(V_lds + (b) * SHM_V + vst1) = sr_[i].vs1; \
    if constexpr (DQK == 64) { *(bf16x8*)(K_lds + (b) * SHM_K + kswz<DQK>(sr8, sc8 * 2)) = sr_[i].ks0; } \
    else { *(bf16x8*)(K_lds + (b) * SHM_K + kswz<DQK>(sr, sc * 2)) = sr_[i].ks0; *(bf16x8*)(K_lds + (b) * SHM_K + kswz<DQK>(32 + sr, sc * 2)) = sr_[i].ks1; } \
    if constexpr (DQK == 192) { *(bf16x8*)(K_lds + (b) * SHM_K + kswz<DQK>(sr8, 256 + sc8 * 2)) = sr_[i].kp; } } while (0)
  constexpr int LPT = DQK == 64 ? 3 : (DQK == 128 ? 4 : 5);
#define SWAIT() do { if constexpr (SDEPTH == 1) asm volatile("s_waitcnt vmcnt(0)" ::: "memory"); else if constexpr (LPT == 3) asm volatile("s_waitcnt vmcnt(3)" ::: "memory"); else if constexpr (LPT == 4) asm volatile("s_waitcnt vmcnt(4)" ::: "memory"); else asm volatile("s_waitcnt vmcnt(5)" ::: "memory"); } while (0)
#define RESC(a) do { if (__any((a) < 1.f)) { if (hi == 0) al_l[r32] = (a); asm volatile("s_waitcnt lgkmcnt(0)" ::: "memory"); \
    _Pragma("unroll") for (int d = 0; d < 4; ++d) _Pragma("unroll") for (int r = 0; r < 16; ++r) o[d][r] *= al_l[crow(r, hi)]; } } while (0)
  f32x16 pA0, pA1, pB0, pB1; float mnA, mnB, alA, alB; bf16x8 pa0, pa1, pa2, pa3; const int NT = seq / KVBLK;
  SLOAD(SE, 0); asm volatile("s_waitcnt vmcnt(0)" ::: "memory"); SWRITE(0, SE); __syncthreads();
  qkt<DQK, QLDS>(pA0, pA1, K_lds, qr, qpe_l, r32, hi); partialSM<DQK>(pA0, pA1, m_reg, mnA, alA);
  SLOAD(SO, KVBLK); if constexpr (SDEPTH == 2) { if (2 < NT) SLOAD(SE, 2 * KVBLK); }
  SWAIT(); SWRITE(1, SO); __syncthreads();
  for (int j = 1; j + 1 < NT; j += 2) {
    SBAR(); qkt<DQK, QLDS>(pB0, pB1, K_lds + SHM_K, qr, qpe_l, r32, hi);
    finishSM(pA0, pA1, alA, l_reg, pa0, pa1, pa2, pa3); SBAR();
    SLOAD(SO, (j + SDEPTH) * KVBLK); SBAR();
    pv_d0(o, vb0, pa0, pa1, pa2, pa3); partialSM<DQK>(pB0, pB1, m_reg, mnB, alB);
    __syncthreads(); SWAIT(); SWRITE(0, SE);
    RESC(alB); __syncthreads();
    SBAR(); qkt<DQK, QLDS>(pA0, pA1, K_lds, qr, qpe_l, r32, hi);
    finishSM(pB0, pB1, alB, l_reg, pa0, pa1, pa2, pa3); SBAR();
    if (SDEPTH == 1 || j + 3 < NT) SLOAD(SE, (j + 1 + SDEPTH) * KVBLK); SBAR();
    pv_d0(o, vb0 + SHM_V, pa0, pa1, pa2, pa3); partialSM<DQK>(pA0, pA1, m_reg, mnA, alA);
    __syncthreads(); SWAIT(); SWRITE(1, SO);
    RESC(alA); __syncthreads();
  }
  SBAR(); qkt<DQK, QLDS>(pB0, pB1, K_lds + SHM_K, qr, qpe_l, r32, hi);
  finishSM(pA0, pA1, alA, l_reg, pa0, pa1, pa2, pa3); SBAR();
  pv_d0(o, vb0, pa0, pa1, pa2, pa3); partialSM<DQK>(pB0, pB1, m_reg, mnB, alB);
  __syncthreads(); RESC(alB);
  finishSM(pB0, pB1, alB, l_reg, pa0, pa1, pa2, pa3); SBAR();
  pv_d0(o, vb0 + SHM_V, pa0, pa1, pa2, pa3);
  if (hi == 0) li_l[r32] = l_reg; asm volatile("s_waitcnt lgkmcnt(0)" ::: "memory");
  float rli[16];
#pragma unroll
  for (int r = 0; r < 16; ++r) rli[r] = __builtin_amdgcn_rcpf(li_l[crow(r, hi)]);
  bf16* Ow = Ob + (long)(wid * QBLK) * ldo;
#pragma unroll
  for (int r = 0; r < 16; ++r) { const int orow = crow(r, hi);
#pragma unroll
    for (int d0 = 0; d0 < 4; ++d0) Ow[(long)orow * ldo + d0 * 32 + r32] = (bf16)f2bf(o[d0][r] * rli[r]); }
#undef SLOAD
#undef SWRITE
#undef SWAIT
#undef RESC
}

template <int DQK, bool QLDS>
__device__ __forceinline__ void attn_unit_s(const bf16* __restrict__ Qb, int ldq, const bf16* __restrict__ Kh, int ldk, const bf16* __restrict__ Kp, int ldkp,
                                            const bf16* __restrict__ Vh, int ldv, bf16* __restrict__ Ob, int ldo, int seq, char* lds) {
  constexpr int SHM_V = KVBLK * 128 * 2, SHM_K = KVBLK * DQK * 2;
  int tid_ = threadIdx.x; asm volatile("" : "+v"(tid_));
  const int tid = tid_, wid = tid >> 6, lane = tid & 63, r32 = lane & 31, hi = lane >> 5;
  char* V_lds = lds; char* K_lds = lds + 2 * SHM_V;
  float* wsf = (float*)(lds + 2 * SHM_V + 2 * SHM_K) + wid * 64; float* li_l = wsf; float* al_l = wsf + 32;
  constexpr int NQR = QLDS ? 8 : DQK / 16;
  float m_reg = -1e30f, l_reg = 0; f32x16 o[4] = {}; bf16x8 qr[NQR];
  const bf16* Qw = Qb + (long)(wid * QBLK + r32) * ldq + hi * 8;
#pragma unroll
  for (int d0 = 0; d0 < NQR; ++d0) qr[d0] = ld8(Qw + d0 * 16);
  char* qpe_l = lds + 2 * SHM_V + 2 * SHM_K + 2048 + wid * 4096;
  if constexpr (QLDS) {
#pragma unroll
    for (int d0 = 8; d0 < DQK / 16; ++d0) *(bf16x8*)(qpe_l + kswz<64>(r32, (d0 * 16 + hi * 8) * 2 - 256)) = ld8(Qw + d0 * 16);
    asm volatile("s_waitcnt lgkmcnt(0)" ::: "memory");
  }
  const int sr = tid >> 4, sc = (tid & 15) * 8, vst0 = v_st(sr, sc), vst1 = v_st(32 + sr, sc);
  const int sr8 = tid >> 3, sc8 = (tid & 7) * 8;
  const int vb0 = (int)(uintptr_t)V_lds + v_rd_base(lane);
  bf16x8 vs0, vs1, ks0, ks1, kp;
#define SLOAD1(k0) do { vs0 = ld8(&Vh[(long)((k0) + sr) * ldv + sc]); vs1 = ld8(&Vh[(long)((k0) + 32 + sr) * ldv + sc]); \
    if constexpr (DQK == 64) { ks0 = ld8(&Kh[(long)((k0) + sr8) * ldk + sc8]); } \
    else { ks0 = ld8(&Kh[(long)((k0) + sr) * ldk + sc]); ks1 = ld8(&Kh[(long)((k0) + 32 + sr) * ldk + sc]); } \
    if constexpr (DQK == 192) { kp = ld8(&Kp[(long)((k0) + sr8) * ldkp + sc8]); } } while (0)
#define SWRITE1(b) do { *(bf16x8*)(V_lds + (b) * SHM_V + vst0) = vs0; *(bf16x8*)(V_lds + (b) * SHM_V + vst1) = vs1; \
    if constexpr (DQK == 64) { *(bf16x8*)(K_lds + (b) * SHM_K + kswz<DQK>(sr8, sc8 * 2)) = ks0; } \
    else { *(bf16x8*)(K_lds + (b) * SHM_K + kswz<DQK>(sr, sc * 2)) = ks0; *(bf16x8*)(K_lds + (b) * SHM_K + kswz<DQK>(32 + sr, sc * 2)) = ks1; } \
    if constexpr (DQK == 192) { *(bf16x8*)(K_lds + (b) * SHM_K + kswz<DQK>(sr8, 256 + sc8 * 2)) = kp; } } while (0)
#define RESC1(a) do { if (__any((a) < 1.f)) { if (hi == 0) al_l[r32] = (a); asm volatile("s_waitcnt lgkmcnt(0)" ::: "memory"); \
    _Pragma("unroll") for (int d = 0; d < 4; ++d) _Pragma("unroll") for (int r = 0; r < 16; ++r) o[d][r] *= al_l[crow(r, hi)]; } } while (0)
  f32x16 p0, p1; float mn, al; bf16x8 pa0, pa1, pa2, pa3; const int NT = seq / KVBLK;
  SLOAD1(0); asm volatile("s_waitcnt vmcnt(0)" ::: "memory"); SWRITE1(0); SLOAD1(KVBLK); __syncthreads();
  for (int j = 0; j < NT; j += 2) {
    SWRITE1(1);
    if (j + 2 < NT) SLOAD1((j + 2) * KVBLK);
    SBAR(); qkt<DQK, QLDS>(p0, p1, K_lds, qr, qpe_l, r32, hi); partialSM<DQK>(p0, p1, m_reg, mn, al);
    RESC1(al); finishSM(p0, p1, al, l_reg, pa0, pa1, pa2, pa3); SBAR();
    pv_d0(o, vb0, pa0, pa1, pa2, pa3);
    __syncthreads();
    if (j + 2 < NT) SWRITE1(0);
    if (j + 3 < NT) SLOAD1((j + 3) * KVBLK);
    SBAR(); qkt<DQK, QLDS>(p0, p1, K_lds + SHM_K, qr, qpe_l, r32, hi); partialSM<DQK>(p0, p1, m_reg, mn, al);
    RESC1(al); finishSM(p0, p1, al, l_reg, pa0, pa1, pa2, pa3); SBAR();
    pv_d0(o, vb0 + SHM_V, pa0, pa1, pa2, pa3);
    __syncthreads();
  }
  if (hi == 0) li_l[r32] = l_reg; asm volatile("s_waitcnt lgkmcnt(0)" ::: "memory");
  float rli[16];
#pragma unroll
  for (int r = 0; r < 16; ++r) rli[r] = __builtin_amdgcn_rcpf(li_l[crow(r, hi)]);
  bf16* Ow = Ob + (long)(wid * QBLK) * ldo;
#pragma unroll
  for (int r = 0; r < 16; ++r) { const int orow = crow(r, hi);
#pragma unroll
    for (int d0 = 0; d0 < 4; ++d0) Ow[(long)orow * ldo + d0 * 32 + r32] = (bf16)f2bf(o[d0][r] * rli[r]); }
#undef SLOAD1
#undef SWRITE1
#undef RESC1
}

template <int DQK> __device__ __forceinline__ void softmax_tile(f32x16& p0, f32x16& p1, float& m_reg, float& l_reg, float& alpha, bf16x8& pa0, bf16x8& pa1, bf16x8& pa2, bf16x8& pa3) {
  float mn; partialSM<DQK>(p0, p1, m_reg, mn, alpha); finishSM(p0, p1, alpha, l_reg, pa0, pa1, pa2, pa3);
}
#define PK4S(P, BASE, OUT) do { v4u w = {cvtpk(P[BASE + 0], P[BASE + 1]), cvtpk(P[BASE + 2], P[BASE + 3]), cvtpk(P[BASE + 4], P[BASE + 5]), cvtpk(P[BASE + 6], P[BASE + 7])}; \
    OUT = *reinterpret_cast<bf16x8*>(&w); } while (0)
__device__ __forceinline__ float xhalf_max(float v) {
  auto rr = __builtin_amdgcn_permlane32_swap(__float_as_uint(v), __float_as_uint(v), false, false);
  float mx_; asm("v_max_f32 %0, %1, %2" : "=v"(mx_) : "v"(rr[0]), "v"(rr[1]));
  return mx_;
}
__device__ __forceinline__ float ownmax32(const f32x16& p0, const f32x16& p1) {
  float pmax = p0[0];
#pragma unroll
  for (int r = 1; r < 16; ++r) pmax = fmaxf(pmax, p0[r]);
#pragma unroll
  for (int r = 0; r < 16; ++r) pmax = fmaxf(pmax, p1[r]);
  return pmax;
}
__device__ __forceinline__ float rowmax32(const f32x16& p0, const f32x16& p1) {
  float pmax = p0[0];
#pragma unroll
  for (int r = 1; r < 16; ++r) pmax = fmaxf(pmax, p0[r]);
#pragma unroll
  for (int r = 0; r < 16; ++r) pmax = fmaxf(pmax, p1[r]);
  return xhalf_max(pmax);
}
__device__ __forceinline__ float expsum32(f32x16& p0, f32x16& p1) {
#pragma unroll
  for (int r = 0; r < 16; ++r) p0[r] = __builtin_amdgcn_exp2f(p0[r]);
#pragma unroll
  for (int r = 0; r < 16; ++r) p1[r] = __builtin_amdgcn_exp2f(p1[r]);
  float ps = p0[0];
#pragma unroll
  for (int r = 1; r < 16; ++r) ps += p0[r];
#pragma unroll
  for (int r = 0; r < 16; ++r) ps += p1[r];
  return ps;
}
__device__ __forceinline__ void softmax_first(f32x16& p0, f32x16& p1, float& m_reg, float& l_reg, float& alpha, f32x16& minit, bf16x8& pa0, bf16x8& pa1, bf16x8& pa2, bf16x8& pa3) {
  const float pmax = rowmax32(p0, p1);
  m_reg = pmax; alpha = 1.f;
#pragma unroll
  for (int r = 0; r < 16; ++r) { minit[r] = -pmax; p0[r] -= pmax; p1[r] -= pmax; }
  l_reg = expsum32(p0, p1);
  PK4S(p0, 0, pa0); PK4S(p0, 8, pa1); PK4S(p1, 0, pa2); PK4S(p1, 8, pa3);
}
__device__ __forceinline__ bool softmax_seeded(f32x16& p0, f32x16& p1, float& m_reg, float& l_reg, float& alpha, f32x16& minit, bf16x8& pa0, bf16x8& pa1, bf16x8& pa2, bf16x8& pa3) {
  const float pown = ownmax32(p0, p1); bool moved = false;
  if (__builtin_expect(__all(pown <= THR * 1.4426950408889634f), 1)) { alpha = 1.f; }
  else { moved = true; const float pmax = xhalf_max(pown); const float d = fmaxf(pmax, 0.f); alpha = __builtin_amdgcn_exp2f(-d); m_reg += d;
#pragma unroll
    for (int r = 0; r < 16; ++r) { p0[r] -= d; p1[r] -= d; minit[r] = -m_reg; } }
  const float ps = expsum32(p0, p1);
  l_reg = l_reg * alpha + ps;
  PK4S(p0, 0, pa0); PK4S(p0, 8, pa1); PK4S(p1, 0, pa2); PK4S(p1, 8, pa3);
  return moved;
}
#undef PK4S
__device__ __forceinline__ bf16x8 scale_bf16x8(bf16x8 v, float c) {
  v4u u = *reinterpret_cast<v4u*>(&v), w;
#pragma unroll
  for (int i = 0; i < 4; ++i) { const float lo = __uint_as_float(u[i] << 16) * c, hi = __uint_as_float(u[i] & 0xffff0000u) * c; w[i] = cvtpk(lo, hi); }
  return *reinterpret_cast<bf16x8*>(&w);
}
typedef short v4i16_t __attribute__((ext_vector_type(4)));
__device__ __forceinline__ s16x4 vtr(int addr) { return __builtin_bit_cast(s16x4, __builtin_amdgcn_ds_read_tr16_b64_v4i16((__attribute__((address_space(3))) v4i16_t*)(uintptr_t)(unsigned)addr)); }
template <int DQK, bool HAVE_QK, bool SEED>
__device__ __forceinline__ void mseg(f32x16* o, f32x16& p0, f32x16& p1, const f32x16& minit, const char* Ks, int vb, const bf16x8* qr, bf16x8 pa0, bf16x8 pa1, bf16x8 pa2, bf16x8 pa3, int r32, int hi) {
  constexpr int CH = DQK == 192 ? 2 : DQK / 64;
  s16x4 va[8], vbq[8]; bf16x8 ka[2 * CH], kb[2 * CH];
#define VRD(dst, D0) do { _Pragma("unroll") for (int ks = 0; ks < 4; ++ks) { dst[2 * ks] = vtr(vb + v_rd_off(D0, ks, 0)); dst[2 * ks + 1] = vtr(vb + v_rd_off(D0, ks, 1)); } } while (0)
#define KRD(dst, C) do { _Pragma("unroll") for (int i = 0; i < CH; ++i) { const int cb = (((C) * CH + i) * 16 + hi * 8) * 2; \
    dst[2 * i] = *reinterpret_cast<const bf16x8*>(Ks + kswz<DQK>(r32, cb)); dst[2 * i + 1] = *reinterpret_cast<const bf16x8*>(Ks + kswz<DQK>(32 + r32, cb)); } } while (0)
#define PKV(L, H) (bf16x8){L[0], L[1], L[2], L[3], H[0], H[1], H[2], H[3]}
#define PVM(src, D0) do { o[D0] = __builtin_amdgcn_mfma_f32_32x32x16_bf16(pa0, PKV(src[0], src[1]), o[D0], 0, 0, 0); o[D0] = __builtin_amdgcn_mfma_f32_32x32x16_bf16(pa1, PKV(src[2], src[3]), o[D0], 0, 0, 0); \
    o[D0] = __builtin_amdgcn_mfma_f32_32x32x16_bf16(pa2, PKV(src[4], src[5]), o[D0], 0, 0, 0); o[D0] = __builtin_amdgcn_mfma_f32_32x32x16_bf16(pa3, PKV(src[6], src[7]), o[D0], 0, 0, 0); } while (0)
#define QKM(src, C) do { _Pragma("unroll") for (int i = 0; i < CH; ++i) { p0 = __builtin_amdgcn_mfma_f32_32x32x16_bf16(src[2 * i], qr[(C) * CH + i], p0, 0, 0, 0); \
    p1 = __builtin_amdgcn_mfma_f32_32x32x16_bf16(src[2 * i + 1], qr[(C) * CH + i], p1, 0, 0, 0); } } while (0)
  if constexpr (HAVE_QK) { if constexpr (SEED) { p0 = minit; p1 = minit; } else { p0 = f32x16{}; p1 = f32x16{}; } }
#define IL_PV() do { _Pragma("unroll") for (int g_ = 0; g_ < 4; ++g_) { __builtin_amdgcn_sched_group_barrier(0x008, 1, 0); __builtin_amdgcn_sched_group_barrier(0x100, 2, 0); } } while (0)
#define IL_QK() do { _Pragma("unroll") for (int g_ = 0; g_ < 2 * CH; ++g_) { __builtin_amdgcn_sched_group_barrier(0x008, 1, 0); __builtin_amdgcn_sched_group_barrier(0x100, 1, 0); } } while (0)
  __builtin_amdgcn_s_setprio(1);
  if constexpr (DQK != 192) {
    VRD(va, 0); if constexpr (HAVE_QK) KRD(ka, 0); SBAR();
    VRD(vbq, 1); PVM(va, 0); IL_PV(); SBAR();
    if constexpr (HAVE_QK) { KRD(kb, 1); QKM(ka, 0); IL_QK(); SBAR(); }
    VRD(va, 2); PVM(vbq, 1); IL_PV(); SBAR();
    if constexpr (HAVE_QK) { KRD(ka, 2); QKM(kb, 1); IL_QK(); SBAR(); }
    VRD(vbq, 3); PVM(va, 2); IL_PV(); SBAR();
    if constexpr (HAVE_QK) { KRD(kb, 3); QKM(ka, 2); IL_QK(); SBAR(); }
    PVM(vbq, 3); SBAR();
    if constexpr (HAVE_QK) { QKM(kb, 3); SBAR(); }
  } else {
    VRD(va, 0); if constexpr (HAVE_QK) KRD(ka, 0); SBAR();
    VRD(vbq, 1); PVM(va, 0); IL_PV(); SBAR();
    if constexpr (HAVE_QK) { KRD(kb, 1); QKM(ka, 0); IL_QK(); SBAR(); }
    VRD(va, 2); PVM(vbq, 1); IL_PV(); SBAR();
    if constexpr (HAVE_QK) { KRD(ka, 2); QKM(kb, 1); IL_QK(); SBAR(); KRD(kb, 3); QKM(ka, 2); IL_QK(); SBAR(); }
    VRD(vbq, 3); PVM(va, 2); IL_PV(); SBAR();
    if constexpr (HAVE_QK) { KRD(ka, 4); QKM(kb, 3); IL_QK(); SBAR(); KRD(kb, 5); QKM(ka, 4); IL_QK(); SBAR(); }
    PVM(vbq, 3); SBAR();
    if constexpr (HAVE_QK) { QKM(kb, 5); SBAR(); }
  }
  __builtin_amdgcn_s_setprio(0);
#undef IL_PV
#undef IL_QK
#undef VRD
#undef KRD
#undef PKV
#undef PVM
#undef QKM
}
template <bool HAVE_QK, bool SEED>
__device__ __forceinline__ void mseg192(f32x16* o, f32x16& p0, f32x16& p1, const f32x16& minit, const char* Ks, int vb, const bf16x8* qr, bf16x8 pa0, bf16x8 pa1, bf16x8 pa2, bf16x8 pa3, int r32, int hi) {
  bf16x8 b0x, b0y, b1x, b1y, b2x, b2y;
#define PKV(L, H) (bf16x8){L[0], L[1], L[2], L[3], H[0], H[1], H[2], H[3]}
#define MF32(a, b, c) __builtin_amdgcn_mfma_f32_32x32x16_bf16(a, b, c, 0, 0, 0)
#define SGB(m, n) __builtin_amdgcn_sched_group_barrier(m, n, 0)
  if constexpr (HAVE_QK) { if constexpr (SEED) { p0 = minit; p1 = minit; } else { p0 = f32x16{}; p1 = f32x16{}; } }
  __builtin_amdgcn_s_setprio(1);
  if constexpr (HAVE_QK) {
    b0x = PKV(vtr(vb + v_rd_off(0, 0, 0)), vtr(vb + v_rd_off(0, 0, 1))); b0y = PKV(vtr(vb + v_rd_off(0, 1, 0)), vtr(vb + v_rd_off(0, 1, 1)));
    { const int cb = (0 * 16 + hi * 8) * 2; b1x = *reinterpret_cast<const bf16x8*>(Ks + kswz<192>(r32, cb)); b1y = *reinterpret_cast<const bf16x8*>(Ks + kswz<192>(32 + r32, cb)); }
    SBAR();
    b2x = PKV(vtr(vb + v_rd_off(0, 2, 0)), vtr(vb + v_rd_off(0, 2, 1))); b2y = PKV(vtr(vb + v_rd_off(0, 3, 0)), vtr(vb + v_rd_off(0, 3, 1))); o[0] = MF32(pa0, b0x, o[0]); o[0] = MF32(pa1, b0y, o[0]); SGB(0x008, 1); SGB(0x100, 2); SGB(0x008, 1); SGB(0x100, 2); SBAR();
    { const int cb = (1 * 16 + hi * 8) * 2; b0x = *reinterpret_cast<const bf16x8*>(Ks + kswz<192>(r32, cb)); b0y = *reinterpret_cast<const bf16x8*>(Ks + kswz<192>(32 + r32, cb)); } p0 = MF32(b1x, qr[0], p0); p1 = MF32(b1y, qr[0], p1); SGB(0x008, 1); SGB(0x100, 1); SGB(0x008, 1); SGB(0x100, 1); SBAR();
    { const int cb = (2 * 16 + hi * 8) * 2; b1x = *reinterpret_cast<const bf16x8*>(Ks + kswz<192>(r32, cb)); b1y = *reinterpret_cast<const bf16x8*>(Ks + kswz<192>(32 + r32, cb)); } o[0] = MF32(pa2, b2x, o[0]); o[0] = MF32(pa3, b2y, o[0]); SGB(0x008, 1); SGB(0x100, 1); SGB(0x008, 1); SGB(0x100, 1); SBAR();
    b2x = PKV(vtr(vb + v_rd_off(1, 0, 0)), vtr(vb + v_rd_off(1, 0, 1))); b2y = PKV(vtr(vb + v_rd_off(1, 1, 0)), vtr(vb + v_rd_off(1, 1, 1))); p0 = MF32(b0x, qr[1], p0); p1 = MF32(b0y, qr[1], p1); SGB(0x008, 1); SGB(0x100, 2); SGB(0x008, 1); SGB(0x100, 2); SBAR();
    { const int cb = (3 * 16 + hi * 8) * 2; b0x = *reinterpret_cast<const bf16x8*>(Ks + kswz<192>(r32, cb)); b0y = *reinterpret_cast<const bf16x8*>(Ks + kswz<192>(32 + r32, cb)); } p0 = MF32(b1x, qr[2], p0); p1 = MF32(b1y, qr[2], p1); SGB(0x008, 1); SGB(0x100, 1); SGB(0x008, 1); SGB(0x100, 1); SBAR();
    b1x = PKV(vtr(vb + v_rd_off(1, 2, 0)), vtr(vb + v_rd_off(1, 2, 1))); b1y = PKV(vtr(vb + v_rd_off(1, 3, 0)), vtr(vb + v_rd_off(1, 3, 1))); o[1] = MF32(pa0, b2x, o[1]); o[1] = MF32(pa1, b2y, o[1]); SGB(0x008, 1); SGB(0x100, 2); SGB(0x008, 1); SGB(0x100, 2); SBAR();
    { const int cb = (4 * 16 + hi * 8) * 2; b2x = *reinterpret_cast<const bf16x8*>(Ks + kswz<192>(r32, cb)); b2y = *reinterpret_cast<const bf16x8*>(Ks + kswz<192>(32 + r32, cb)); } p0 = MF32(b0x, qr[3], p0); p1 = MF32(b0y, qr[3], p1); SGB(0x008, 1); SGB(0x100, 1); SGB(0x008, 1); SGB(0x100, 1); SBAR();
    { const int cb = (5 * 16 + hi * 8) * 2; b0x = *reinterpret_cast<const bf16x8*>(Ks + kswz<192>(r32, cb)); b0y = *reinterpret_cast<const bf16x8*>(Ks + kswz<192>(32 + r32, cb)); } o[1] = MF32(pa2, b1x, o[1]); o[1] = MF32(pa3, b1y, o[1]); SGB(0x008, 1); SGB(0x100, 1); SGB(0x008, 1); SGB(0x100, 1); SBAR();
    b1x = PKV(vtr(vb + v_rd_off(2, 0, 0)), vtr(vb + v_rd_off(2, 0, 1))); b1y = PKV(vtr(vb + v_rd_off(2, 1, 0)), vtr(vb + v_rd_off(2, 1, 1))); p0 = MF32(b2x, qr[4], p0); p1 = MF32(b2y, qr[4], p1); SGB(0x008, 1); SGB(0x100, 2); SGB(0x008, 1); SGB(0x100, 2); SBAR();
    { const int cb = (6 * 16 + hi * 8) * 2; b2x = *reinterpret_cast<const bf16x8*>(Ks + kswz<192>(r32, cb)); b2y = *reinterpret_cast<const bf16x8*>(Ks + kswz<192>(32 + r32, cb)); } p0 = MF32(b0x, qr[5], p0); p1 = MF32(b0y, qr[5], p1); SGB(0x008, 1); SGB(0x100, 1); SGB(0x008, 1); SGB(0x100, 1); SBAR();
    b0x = PKV(vtr(vb + v_rd_off(2, 2, 0)), vtr(vb + v_rd_off(2, 2, 1))); b0y = PKV(vtr(vb + v_rd_off(2, 3, 0)), vtr(vb + v_rd_off(2, 3, 1))); o[2] = MF32(pa0, b1x, o[2]); o[2] = MF32(pa1, b1y, o[2]); SGB(0x008, 1); SGB(0x100, 2); SGB(0x008, 1); SGB(0x100, 2); SBAR();
    { const int cb = (7 * 16 + hi * 8) * 2; b1x = *reinterpret_cast<const bf16x8*>(Ks + kswz<192>(r32, cb)); b1y = *reinterpret_cast<const bf16x8*>(Ks + kswz<192>(32 + r32, cb)); } p0 = MF32(b2x, qr[6], p0); p1 = MF32(b2y, qr[6], p1); SGB(0x008, 1); SGB(0x100, 1); SGB(0x008, 1); SGB(0x100, 1); SBAR();
    { const int cb = (8 * 16 + hi * 8) * 2; b2x = *reinterpret_cast<const bf16x8*>(Ks + kswz<192>(r32, cb)); b2y = *reinterpret_cast<const bf16x8*>(Ks + kswz<192>(32 + r32, cb)); } o[2] = MF32(pa2, b0x, o[2]); o[2] = MF32(pa3, b0y, o[2]); SGB(0x008, 1); SGB(0x100, 1); SGB(0x008, 1); SGB(0x100, 1); SBAR();
    b0x = PKV(vtr(vb + v_rd_off(3, 0, 0)), vtr(vb + v_rd_off(3, 0, 1))); b0y = PKV(vtr(vb + v_rd_off(3, 1, 0)), vtr(vb + v_rd_off(3, 1, 1))); p0 = MF32(b1x, qr[7], p0); p1 = MF32(b1y, qr[7], p1); SGB(0x008, 1); SGB(0x100, 2); SGB(0x008, 1); SGB(0x100, 2); SBAR();
    { const int cb = (9 * 16 + hi * 8) * 2; b1x = *reinterpret_cast<const bf16x8*>(Ks + kswz<192>(r32, cb)); b1y = *reinterpret_cast<const bf16x8*>(Ks + kswz<192>(32 + r32, cb)); } p0 = MF32(b2x, qr[8], p0); p1 = MF32(b2y, qr[8], p1); SGB(0x008, 1); SGB(0x100, 1); SGB(0x008, 1); SGB(0x100, 1); SBAR();
    b2x = PKV(vtr(vb + v_rd_off(3, 2, 0)), vtr(vb + v_rd_off(3, 2, 1))); b2y = PKV(vtr(vb + v_rd_off(3, 3, 0)), vtr(vb + v_rd_off(3, 3, 1))); o[3] = MF32(pa0, b0x, o[3]); o[3] = MF32(pa1, b0y, o[3]); SGB(0x008, 1); SGB(0x100, 2); SGB(0x008, 1); SGB(0x100, 2); SBAR();
    { const int cb = (10 * 16 + hi * 8) * 2; b0x = *reinterpret_cast<const bf16x8*>(Ks + kswz<192>(r32, cb)); b0y = *reinterpret_cast<const bf16x8*>(Ks + kswz<192>(32 + r32, cb)); } p0 = MF32(b1x, qr[9], p0); p1 = MF32(b1y, qr[9], p1); SGB(0x008, 1); SGB(0x100, 1); SGB(0x008, 1); SGB(0x100, 1); SBAR();
    { const int cb = (11 * 16 + hi * 8) * 2; b1x = *reinterpret_cast<const bf16x8*>(Ks + kswz<192>(r32, cb)); b1y = *reinterpret_cast<const bf16x8*>(Ks + kswz<192>(32 + r32, cb)); } o[3] = MF32(pa2, b2x, o[3]); o[3] = MF32(pa3, b2y, o[3]); SGB(0x008, 1); SGB(0x100, 1); SGB(0x008, 1); SGB(0x100, 1); SBAR();
    p0 = MF32(b0x, qr[10], p0); p1 = MF32(b0y, qr[10], p1); SBAR();
    p0 = MF32(b1x, qr[11], p0); p1 = MF32(b1y, qr[11], p1); SBAR();
  } else {
    b0x = PKV(vtr(vb + v_rd_off(0, 0, 0)), vtr(vb + v_rd_off(0, 0, 1))); b0y = PKV(vtr(vb + v_rd_off(0, 1, 0)), vtr(vb + v_rd_off(0, 1, 1)));
    b1x = PKV(vtr(vb + v_rd_off(0, 2, 0)), vtr(vb + v_rd_off(0, 2, 1))); b1y = PKV(vtr(vb + v_rd_off(0, 3, 0)), vtr(vb + v_rd_off(0, 3, 1)));
    SBAR();
    b2x = PKV(vtr(vb + v_rd_off(1, 0, 0)), vtr(vb + v_rd_off(1, 0, 1))); b2y = PKV(vtr(vb + v_rd_off(1, 1, 0)), vtr(vb + v_rd_off(1, 1, 1))); o[0] = MF32(pa0, b0x, o[0]); o[0] = MF32(pa1, b0y, o[0]); SGB(0x008, 1); SGB(0x100, 2); SGB(0x008, 1); SGB(0x100, 2); SBAR();
    b0x = PKV(vtr(vb + v_rd_off(1, 2, 0)), vtr(vb + v_rd_off(1, 2, 1))); b0y = PKV(vtr(vb + v_rd_off(1, 3, 0)), vtr(vb + v_rd_off(1, 3, 1))); o[0] = MF32(pa2, b1x, o[0]); o[0] = MF32(pa3, b1y, o[0]); SGB(0x008, 1); SGB(0x100, 2); SGB(0x008, 1); SGB(0x100, 2); SBAR();
    b1x = PKV(vtr(vb + v_rd_off(2, 0, 0)), vtr(vb + v_rd_off(2, 0, 1))); b1y = PKV(vtr(vb + v_rd_off(2, 1, 0)), vtr(vb + v_rd_off(2, 1, 1))); o[1] = MF32(pa0, b2x, o[1]); o[1] = MF32(pa1, b2y, o[1]); SGB(0x008, 1); SGB(0x100, 2); SGB(0x008, 1); SGB(0x100, 2); SBAR();
    b2x = PKV(vtr(vb + v_rd_off(2, 2, 0)), vtr(vb + v_rd_off(2, 2, 1))); b2y = PKV(vtr(vb + v_rd_off(2, 3, 0)), vtr(vb + v_rd_off(2, 3, 1))); o[1] = MF32(pa2, b0x, o[1]); o[1] = MF32(pa3, b0y, o[1]); SGB(0x008, 1); SGB(0x100, 2); SGB(0x008, 1); SGB(0x100, 2); SBAR();
    b0x = PKV(vtr(vb + v_rd_off(3, 0, 0)), vtr(vb + v_rd_off(3, 0, 1))); b0y = PKV(vtr(vb + v_rd_off(3, 1, 0)), vtr(vb + v_rd_off(3, 1, 1))); o[2] = MF32(pa0, b1x, o[2]); o[2] = MF32(pa1, b1y, o[2]); SGB(0x008, 1); SGB(0x100, 2); SGB(0x008, 1); SGB(0x100, 2); SBAR();
    b1x = PKV(vtr(vb + v_rd_off(3, 2, 0)), vtr(vb + v_rd_off(3, 2, 1))); b1y = PKV(vtr(vb + v_rd_off(3, 3, 0)), vtr(vb + v_rd_off(3, 3, 1))); o[2] = MF32(pa2, b2x, o[2]); o[2] = MF32(pa3, b2y, o[2]); SGB(0x008, 1); SGB(0x100, 2); SGB(0x008, 1); SGB(0x100, 2); SBAR();
    o[3] = MF32(pa0, b0x, o[3]); o[3] = MF32(pa1, b0y, o[3]); SBAR();
    o[3] = MF32(pa2, b1x, o[3]); o[3] = MF32(pa3, b1y, o[3]); SBAR();
  }
  __builtin_amdgcn_s_setprio(0);
#undef PKV
#undef MF32
#undef SGB
}
template <int DQK, bool QLDS, int COMB = 0>
__device__ __forceinline__ void attn_unit_pp(const bf16* __restrict__ Qb, int ldq, const bf16* __restrict__ Kh, int ldk, const bf16* __restrict__ Kp, int ldkp,
                                             const bf16* __restrict__ Vh, int ldv, bf16* __restrict__ Ob, int ldo, int seq, char* lds,
                                             const bf16* O0 = nullptr, int ldo0 = 0, float lam = 0.f, const float* sg = nullptr, float cscale = 1.f) {
  constexpr int SHM_V = KVBLK * 128 * 2, SHM_K = KVBLK * DQK * 2, OFF_K = 3 * SHM_V, OFF_W = OFF_K + 2 * SHM_K, OFF_Q = OFF_W + 2048;
  int tid_ = threadIdx.x; asm volatile("" : "+v"(tid_));
  const int tid = tid_, wid = tid >> 6, lane = tid & 63, r32 = lane & 31, hi = lane >> 5;
  const int grp = __builtin_amdgcn_readfirstlane(wid >> 2);
  char* V_lds = lds; char* K_lds = lds + OFF_K;
  float* wsf = (float*)(lds + OFF_W) + wid * 64; float* li_l = wsf; float* al_l = wsf + 32;
  constexpr int NQR = QLDS ? 8 : DQK / 16;
  float m_reg = -1e30f, l_reg = 0; f32x16 o[4] = {}; bf16x8 qr[NQR];
  const bf16* Qw = Qb + (long)(wid * QBLK + r32) * ldq + hi * 8;
#pragma unroll
  for (int d0 = 0; d0 < NQR; ++d0) qr[d0] = ld8(Qw + d0 * 16);
  constexpr bool SEED = SEED_MASK & (DQK == 64 ? 1 : (DQK == 128 ? 2 : 4));
  f32x16 minit = {};
  if constexpr (SEED) { constexpr float QS = (DQK == 64 ? 0.125f : (DQK == 128 ? 0.088388347648318440f : 0.072168783648703220f)) * 1.4426950408889634f;
#pragma unroll
    for (int d0 = 0; d0 < NQR; ++d0) qr[d0] = scale_bf16x8(qr[d0], QS); }
  char* qpe_l = lds + OFF_Q + wid * 4096;
  if constexpr (QLDS) {
#pragma unroll
    for (int d0 = 8; d0 < DQK / 16; ++d0) *(bf16x8*)(qpe_l + kswz<64>(r32, (d0 * 16 + hi * 8) * 2 - 256)) = ld8(Qw + d0 * 16);
  }
  constexpr bool SEED_IMG = SEED_MASK & (DQK == 64 ? 1 : (DQK == 128 ? 2 : 4));
  const int sr = tid >> 4, sc = (tid & 15) * 8, vst0 = SEED_IMG ? v_stn(sr, sc) : v_st(sr, sc), vst1 = SEED_IMG ? v_stn(32 + sr, sc) : v_st(32 + sr, sc);
  const int sr8 = tid >> 3, sc8 = (tid & 7) * 8;
  const int vb0 = (int)(uintptr_t)V_lds + v_rd_base(lane);
  bf16x8 vs0, vs1, ks0, ks1, kp;
  const unsigned vo0 = (unsigned)(sr * ldv + sc) * 2u, vo1 = (unsigned)((32 + sr) * ldv + sc) * 2u;
  const unsigned ko0 = DQK == 64 ? (unsigned)(sr8 * ldk + sc8) * 2u : (unsigned)(sr * ldk + sc) * 2u, ko1 = (unsigned)((32 + sr) * ldk + sc) * 2u;
  const unsigned kpo = DQK == 192 ? (unsigned)(sr8 * ldkp + sc8) * 2u : 0u;
  const __amdgpu_buffer_rsrc_t rV = __builtin_amdgcn_make_buffer_rsrc((void*)Vh, 0, 0x7fffffff, 0x00020000), rK = __builtin_amdgcn_make_buffer_rsrc((void*)Kh, 0, 0x7fffffff, 0x00020000);
  const __amdgpu_buffer_rsrc_t rP = __builtin_amdgcn_make_buffer_rsrc((void*)(DQK == 192 ? Kp : Kh), 0, 0x7fffffff, 0x00020000);
#define BLD(r, vo, so) __builtin_bit_cast(bf16x8, __builtin_amdgcn_raw_buffer_load_b128((r), (int)(vo), (int)(so), 0))
#define PLOAD(k0) do { const unsigned sv_ = (unsigned)(k0) * (unsigned)ldv * 2u, sk_ = (unsigned)(k0) * (unsigned)ldk * 2u; \
    vs0 = BLD(rV, vo0, sv_); vs1 = BLD(rV, vo1, sv_); ks0 = BLD(rK, ko0, sk_); \
    if constexpr (DQK != 64) { ks1 = BLD(rK, ko1, sk_); } \
    if constexpr (DQK == 192) { kp = BLD(rP, kpo, (unsigned)(k0) * (unsigned)ldkp * 2u); } } while (0)
#define PWRITE(koff, voff) do { *(bf16x8*)(V_lds + (voff) + vst0) = vs0; *(bf16x8*)(V_lds + (voff) + vst1) = vs1; \
    if constexpr (DQK == 64) { *(bf16x8*)(K_lds + (koff) + kswz<DQK>(sr8, sc8 * 2)) = ks0; } \
    else { *(bf16x8*)(K_lds + (koff) + kswz<DQK>(sr, sc * 2)) = ks0; *(bf16x8*)(K_lds + (koff) + kswz<DQK>(32 + sr, sc * 2)) = ks1; } \
    if constexpr (DQK == 192) { *(bf16x8*)(K_lds + (koff) + kswz<DQK>(sr8, 256 + sc8 * 2)) = kp; } } while (0)
#define PRESC(a) do { if (__any((a) < 1.f)) { if (hi == 0) al_l[r32] = (a); asm volatile("s_waitcnt lgkmcnt(0)" ::: "memory"); \
    _Pragma("unroll") for (int d = 0; d < 4; ++d) _Pragma("unroll") for (int r = 0; r < 16; ++r) o[d][r] *= al_l[crow(r, hi)]; } } while (0)
#define PBAR() do { __builtin_amdgcn_sched_barrier(0); asm volatile("s_waitcnt lgkmcnt(0)" ::: "memory"); __builtin_amdgcn_s_barrier(); asm volatile("" ::: "memory"); __builtin_amdgcn_sched_barrier(0); } while (0)
  f32x16 p0, p1; float al; bf16x8 pa0, pa1, pa2, pa3; const int NT = seq / KVBLK;
  constexpr bool SM = false;
  PLOAD(0); PWRITE(0, 0); PLOAD(KVBLK); PWRITE(SHM_K, SHM_V);
  if ((SM || grp == 1) && 2 < NT) PLOAD(2 * KVBLK);
  PBAR();
  if (grp == 1) PBAR();
  const int LD = 2 + grp;
  int vw = SM ? 2 * SHM_V : (LD - 1) * SHM_V;
  SBAR(); qkt<DQK, QLDS>(p0, p1, K_lds, qr, qpe_l, r32, hi);
  PBAR();
  if constexpr (SEED) softmax_first(p0, p1, m_reg, l_reg, al, minit, pa0, pa1, pa2, pa3); else softmax_tile<DQK>(p0, p1, m_reg, l_reg, al, pa0, pa1, pa2, pa3);
  if constexpr (!SM) { const int u = LD - 1; if (u >= 2 && u < NT) PWRITE((u & 1) * SHM_K, vw); if (u + 1 >= 2 && u + 1 < NT) PLOAD((u + 1) * KVBLK);
    vw += SHM_V; if (vw == 3 * SHM_V) vw = 0; }
  PBAR();
  int vr = 0;
  for (int t = 0; t < NT; ++t) {
    SBAR();
    static_assert(!QLDS, "the ping-pong MFMA segment keeps all of Q in registers");
    if constexpr (DQK == 192 && M192) {
      if (t + 1 < NT) mseg192<true, SEED>(o, p0, p1, minit, K_lds + ((t + 1) & 1) * SHM_K, vb0 + vr, qr, pa0, pa1, pa2, pa3, r32, hi);
      else mseg192<false, SEED>(o, p0, p1, minit, K_lds, vb0 + vr, qr, pa0, pa1, pa2, pa3, r32, hi);
    } else {
      if (t + 1 < NT) mseg<DQK, true, SEED>(o, p0, p1, minit, K_lds + ((t + 1) & 1) * SHM_K, vb0 + vr, qr, pa0, pa1, pa2, pa3, r32, hi);
      else mseg<DQK, false, SEED>(o, p0, p1, minit, K_lds, vb0 + vr, qr, pa0, pa1, pa2, pa3, r32, hi);
    }
    vr += SHM_V; if (vr == 3 * SHM_V) vr = 0;
    if constexpr (SM) { const int u = t + 2; if (u < NT) PWRITE((u & 1) * SHM_K, vw); if (u + 1 < NT) PLOAD((u + 1) * KVBLK);
      vw += SHM_V; if (vw == 3 * SHM_V) vw = 0; }
    PBAR();
    if (t + 1 < NT) { if constexpr (SEED) { if (softmax_seeded(p0, p1, m_reg, l_reg, al, minit, pa0, pa1, pa2, pa3)) PRESC(al); } else { softmax_tile<DQK>(p0, p1, m_reg, l_reg, al, pa0, pa1, pa2, pa3); PRESC(al); } }
    if constexpr (!SM) { const int u = t + LD; if (u < NT) PWRITE((u & 1) * SHM_K, vw); if (u + 1 < NT) PLOAD((u + 1) * KVBLK);
      vw += SHM_V; if (vw == 3 * SHM_V) vw = 0; }
    PBAR();
  }
  if (grp == 0) PBAR();
  if constexpr (SEED) { auto rr = __builtin_amdgcn_permlane32_swap(__float_as_uint(l_reg), __float_as_uint(l_reg), false, false); l_reg = __uint_as_float(rr[0]) + __uint_as_float(rr[1]); }
  if (hi == 0) li_l[r32] = l_reg; asm volatile("s_waitcnt lgkmcnt(0)" ::: "memory");
  float rli[16];
#pragma unroll
  for (int r = 0; r < 16; ++r) rli[r] = __builtin_amdgcn_rcpf(li_l[crow(r, hi)]);
  bf16* Ow = Ob + (long)(wid * QBLK) * ldo;
  if constexpr (COMB == 2) {
    const bf16* O0w = O0 + (long)(wid * QBLK) * ldo0; float g4[4];
#pragma unroll
    for (int d0 = 0; d0 < 4; ++d0) g4[d0] = sg[d0 * 32 + r32] * cscale;
#pragma unroll
    for (int r = 0; r < 16; ++r) { const int orow = crow(r, hi); float v[4]; float ss = 0.f;
#pragma unroll
      for (int d0 = 0; d0 < 4; ++d0) { v[d0] = bf2f(O0w[(long)orow * ldo0 + d0 * 32 + r32]) - lam * bf2f((bf16)f2bf(o[d0][r] * rli[r])); ss += v[d0] * v[d0]; }
#pragma unroll
      for (int sft = 1; sft < 32; sft <<= 1) ss += __shfl_xor(ss, sft);
      const float rstd = rsqrtf(ss * (1.0f / 128.0f) + EPS);
#pragma unroll
      for (int d0 = 0; d0 < 4; ++d0) Ow[(long)orow * ldo + d0 * 32 + r32] = (bf16)f2bf(v[d0] * rstd * g4[d0]); }
  } else {
#pragma unroll
    for (int r = 0; r < 16; ++r) { const int orow = crow(r, hi);
#pragma unroll
      for (int d0 = 0; d0 < 4; ++d0) Ow[(long)orow * ldo + d0 * 32 + r32] = (bf16)f2bf(o[d0][r] * rli[r]); }
  }
#undef PLOAD
#undef BLD
#undef PWRITE
#undef PRESC
#undef PBAR
}
}

#define GRID_BAR() xcd_barrier(bar)
#define GEMM_PHASE_E(EpiT, Einit, Aptr, Btptr, Mm, Nn, Kk) do { pg8::Gemm g_{(const bf16*)(Aptr), (const bf16*)(Btptr), (Mm), (Nn), (Kk), (Kk), (Kk)}; pg8::StaticOrder S_; S_.init((Mm), (Nn), (int)gridDim.x, (int)blockIdx.x); \
    const EpiT E_ Einit; pg8::gemm_phase<EpiT, pg8::StaticOrder, true, true>((LAS unsigned char*)lds, g_, S_, E_); } while (0)
#define GEMM_PHASE_EL(EpiT, Einit, Aptr, Lda, Btptr, Mm, Nn, Kk) do { pg8::Gemm g_{(const bf16*)(Aptr), (const bf16*)(Btptr), (Mm), (Nn), (Kk), (Lda), (Kk)}; pg8::StaticOrder S_; S_.init((Mm), (Nn), (int)gridDim.x, (int)blockIdx.x); \
    const EpiT E_ Einit; pg8::gemm_phase<EpiT, pg8::StaticOrder, true, true>((LAS unsigned char*)lds, g_, S_, E_); } while (0)
#define GEMM_PHASE(Aptr, Btptr, Mm, Nn, Kk, Optr) do { pg8::Gemm g_{(const bf16*)(Aptr), (const bf16*)(Btptr), (Mm), (Nn), (Kk), (Kk), (Kk)}; pg8::StaticOrder S_; S_.init((Mm), (Nn), (int)gridDim.x, (int)blockIdx.x); \
    pg8::EpiBf16 E_{(bf16*)(Optr), (Nn)}; pg8::gemm_phase<pg8::EpiBf16, pg8::StaticOrder, true, true>((LAS unsigned char*)lds, g_, S_, E_); } while (0)

#define GEMM2048_PHASE(Aptr, Btptr, Kk) do { \
    { pg8::Gemm g_{(const bf16*)(Aptr), (const bf16*)(Btptr), MSPLIT, 2048, (Kk), (Kk), (Kk)}; pg8::StaticOrder S_; S_.init(MSPLIT, 2048, (int)gridDim.x, (int)blockIdx.x); \
      pg8::EpiBf16 E_{(bf16*)(ws + WS_T), 2048}; pg8::gemm_phase<pg8::EpiBf16, pg8::StaticOrder, true, true>((LAS unsigned char*)lds, g_, S_, E_); } \
    { const int G_ = (int)gridDim.x, bx_ = (int)blockIdx.x; \
      for (int hu_ = (G_ % 8 == 0) ? (bx_ % 8) * (G_ / 8) + bx_ / 8 : bx_; hu_ < 2 * ((M - MSPLIT) / 256) * 8; hu_ += G_) { const int tile_ = hu_ >> 1, kh_ = hu_ & 1; \
        pg8::Gemm g_{(const bf16*)(Aptr) + kh_ * ((Kk) / 2), (const bf16*)(Btptr) + kh_ * ((Kk) / 2), M, 2048, (Kk) / 2, (Kk), (Kk)}; pg8::OneUnit S_{{MSPLIT / 256 + (tile_ >> 3), tile_ & 7}}; \
        pg8::EpiBf16 E_{(bf16*)(ws + WS_SLAB) + (size_t)kh_ * SLAB_ELEMS - (size_t)MSPLIT * 2048, 2048}; pg8::gemm_phase<pg8::EpiBf16, pg8::OneUnit, true, true>((LAS unsigned char*)lds, g_, S_, E_); } } } while (0)

#ifndef ATT_SD_A
#define ATT_SD_A 1
#endif
#ifndef ATT_QLDS_A
#define ATT_QLDS_A false
#endif
template <int KIND> __device__ __forceinline__ void attn_phase(const Params& P, unsigned char* ldsp) {
    const Frame F = make_frame(ldsp);
    unsigned char* R = P.ws + WS_R; bf16* AO = (bf16*)(P.ws + WS_AO); char* lds = (char*)ldsp;
    if constexpr (KIND == 0) {
        const bf16* Q = (const bf16*)(R + R_A_Q); const bf16* KV = (const bf16*)(R + R_A_KV); const bf16* KPEF = (const bf16*)(R + R_A_KPEF);
        for (int u = F.vcu; u < 1280; u += F.G) {
            int m0, kr0, seq, h;
            if (u < 1024) { const int mb = u >> 8, qb = u & 15; h = (u >> 4) & 15; m0 = MP + mb * DSEQ + qb * 256; kr0 = MP + mb * LSEQ; seq = LSEQ; }
            else { const int v = u - 1024, pb = v >> 4; h = v & 15; m0 = pb * 256; kr0 = pb * 256; seq = SEQ; }
            att::attn_unit_pp<192, false>(Q + (size_t)m0 * 3072 + h * 192, 3072, KV + (size_t)kr0 * 4096 + h * 256, 4096, KPEF + (size_t)kr0 * 64, 64,
                                KV + (size_t)kr0 * 4096 + h * 256 + 128, 4096, AO + (size_t)m0 * 2048 + h * 128, 2048, seq, lds);
            __syncthreads();
        }
    } else if constexpr (KIND == 1) {
        const bf16* QB = (const bf16*)(R + R_B_Q); const bf16* KF = (const bf16*)(R + R_B_KF); const bf16* VF = (const bf16*)(R + R_B_VF); bf16* OC = (bf16*)(R + R_B_OC);
        const float lam = ((const float*)(P.ws + WS_MISC))[0];
        for (int u = F.vcu; u < 1280; u += F.G) {
            int m0, kr0, seq, h;
            if (u < 1024) { const int mb = u >> 8, qb = u & 15; h = (u >> 4) & 15; m0 = MP + mb * DSEQ + qb * 256; kr0 = MP + mb * LSEQ; seq = LSEQ; }
            else { const int v = u - 1024, pb = v >> 4; h = v & 15; m0 = pb * 256; kr0 = pb * 256; seq = SEQ; }
            att::attn_unit_pp<64, false, 1>(QB + (size_t)m0 * 2048 + h * 128, 2048, KF + (size_t)kr0 * 2048 + h * 128, 2048, nullptr, 0,
                               VF + (size_t)kr0 * 2048 + h * 128, 2048, OC + (size_t)m0 * 2048 + h * 128, 2048, seq, lds);
            __syncthreads();
            att::attn_unit_pp<64, false, 2>(QB + (size_t)m0 * 2048 + h * 128 + 64, 2048, KF + (size_t)kr0 * 2048 + h * 128 + 64, 2048, nullptr, 0,
                               VF + (size_t)kr0 * 2048 + h * 128, 2048, AO + (size_t)m0 * 2048 + h * 128, 2048, seq, lds,
                               OC + (size_t)m0 * 2048 + h * 128, 2048, lam, P.in[I_BSUBLN], 1.0f - LAM_INIT_1);
            __syncthreads();
        }
    } else {
        const bf16* QC = (const bf16*)(R + R_C_Q); const bf16* KF = (const bf16*)(R + R_C_KF); const bf16* VF = (const bf16*)(R + R_C_VF);
        for (int u = F.vcu; u < 1280; u += F.G) {
            int m0, kr0, seq, h;
            if (u < 1024) { const int mb = u >> 8, qb = u & 15; h = (u >> 4) & 15; m0 = MP + mb * DSEQ + qb * 256; kr0 = MP + mb * LSEQ; seq = LSEQ; }
            else { const int v = u - 1024, pb = v >> 4; h = v & 15; m0 = pb * 256; kr0 = pb * 256; seq = SEQ; }
            att::attn_unit_pp<128, false>(QC + (size_t)m0 * 2048 + h * 128, 2048, KF + (size_t)kr0 * 512 + (h >> 2) * 128, 512, nullptr, 0,
                                VF + (size_t)kr0 * 512 + (h >> 2) * 128, 512, AO + (size_t)m0 * 2048 + h * 128, 2048, seq, lds);
            __syncthreads();
        }
    }
}

template <int L> __device__ __forceinline__ void layer(const Params& P, unsigned char* lds, const XcdBarrier& bar) {
    constexpr int KIND = L % 3, J = L / 3;
    unsigned char* ws = P.ws; unsigned char* R = ws + WS_R;
    bf16* H = (bf16*)(ws + WS_H); bf16* T = (bf16*)(ws + WS_T); bf16* AO = (bf16*)(ws + WS_AO);
    const float* MOD = (const float*)(ws + WS_MOD); const float* MODl = MOD + (size_t)L * 5 * 12288;
    const float* ng = P.in[I_NORMG] + (size_t)L * 4 * D;
    if constexpr (KIND == 0) {
        mla_cache_rows(P, lds, J);
        GEMM_PHASE_E(EpiMlaDown, ({(bf16*)(R + R_A_D1), (float*)(R + R_A_SSP), (bf16*)(R + R_A_CKVF), (bf16*)(R + R_A_KPEF), P.out + O_SA_CKV, P.out + O_SA_KPE, P.in[I_AKVN] + J * 256, (const float*)(ws + WS_MISC) + 256,
                      (LAS float*)((LAS unsigned char*)lds + EPI_LDS_OFF), J}), H, ws + WS_W_A_DOWN + (size_t)J * 4 * MiB, M, 1024, 2048); GRID_BAR();
        GEMM_PHASE_EL(EpiMlaQ, ({(bf16*)(R + R_A_Q), (const float*)(ws + WS_MISC) + 256, (const float*)(R + R_A_SSP), (LAS float*)((LAS unsigned char*)lds + EPI_LDS_OFF)}), R + R_A_D1, 1024, ws + WS_W_A_UQ + (size_t)J * 3 * MiB, M, 3072, 512);
        GEMM_PHASE(R + R_A_CKVF, ws + WS_W_A_UKV + (size_t)J * 2 * MiB, LKV, 4096, 256, R + R_A_KV); GRID_BAR();
        attn_phase<0>(P, lds); GRID_BAR();
        GEMM2048_PHASE(AO, ws + WS_W_A_O + (size_t)J * 8 * MiB, 2048); GRID_BAR();
    } else if constexpr (KIND == 1) {
        diff_cache_rows(P, lds);
        GEMM_PHASE_E(EpiDiffQKV, ({(bf16*)(R + R_B_Q), (bf16*)(R + R_B_KF), (bf16*)(R + R_B_VF), P.out + O_SB_K, P.out + O_SB_V, (const float*)(ws + WS_MISC) + 256}), H, ws + WS_W_B_QKV, M, 6144, 2048); GRID_BAR();
        attn_phase<1>(P, lds); GRID_BAR();
        GEMM2048_PHASE(AO, ws + WS_W_B_O, 2048); GRID_BAR();
    } else {
        gqa_cache_rows(P, lds);
        GEMM_PHASE_E(EpiGqaQKV, ({(bf16*)(R + R_C_Q), (bf16*)(R + R_C_KF), (bf16*)(R + R_C_VF), P.out + O_SC_K, P.out + O_SC_V, (const float*)(ws + WS_MISC) + 4096, P.in[I_CQN], P.in[I_CKN], (LAS float*)((LAS unsigned char*)lds + EPI_LDS_OFF)}), H, ws + WS_W_C_QKV, M, 3072, 2048); GRID_BAR();
        attn_phase<2>(P, lds); GRID_BAR();
        GEMM2048_PHASE(AO, ws + WS_W_C_O, 2048); GRID_BAR();
    }
    resnorm_phase<true, true, L == 0, false>(P, lds, T, ng + 1 * D, MODl, 2, ng + 2 * D, MODl, 3, 4, H); GRID_BAR();
    GEMM_PHASE_E(EpiConvGate, ({(bf16*)(R + R_G), (float*)(ws + WS_EDGE), P.in[I_FCW] + (size_t)L * 3 * NFF, P.in[I_FCB] + (size_t)L * NFF, (LAS float*)((LAS unsigned char*)lds + EPI_LDS_OFF)}), H, ws + WS_W_FIN + (size_t)L * 44 * MiB, M, NFF, 2048); GRID_BAR();
    conv_fix_phase(P, lds, L); GRID_BAR();
    GEMM2048_PHASE(R + R_G, ws + WS_W_FDN + (size_t)L * 22 * MiB, DFF); GRID_BAR();
    if constexpr (L < 3) { resnorm_phase<true, true, false, false>(P, lds, T, ng + 3 * D, MODl, 5, ng + 4 * D, MODl + 5 * 12288, 0, 1, H); GRID_BAR(); }
    else resnorm_phase<true, false, false, true>(P, lds, T, ng + 3 * D, MODl, 5, nullptr, nullptr, 0, 0, nullptr);
}

__global__ void __launch_bounds__(NWAVES * 64, 2) mk_fwd(Params P) {
    extern __shared__ __attribute__((aligned(16))) unsigned char lds[];
    volatile LAS unsigned* MISC = (volatile LAS unsigned*)((LAS unsigned char*)lds + MISC_OFF);
    for (int u = threadIdx.x; u < (LDS_BYTES - LDSCTL_OFF) / 4; u += NWAVES * 64) ((LAS unsigned*)((LAS unsigned char*)lds + LDSCTL_OFF))[u] = 0u;
    __syncthreads();
    unsigned* ctl = (unsigned*)(P.ws + WS_CTL);
    XcdBarrier bar = xcd_barrier_post(ctl + CW_BAR, MISC + 8);

    p0_prologue(P, lds); GRID_BAR();
    { const float* MOD = (const float*)(P.ws + WS_MOD); const float* ng = P.in[I_NORMG];
      resnorm_phase<false, true, true, false>(P, lds, nullptr, nullptr, nullptr, 0, ng, MOD, 0, 1, (bf16*)(P.ws + WS_H)); GRID_BAR(); }
    layer<0>(P, lds, bar);
    layer<1>(P, lds, bar);
    layer<2>(P, lds, bar);
    layer<3>(P, lds, bar);
}

extern "C" void kernel_launch(void* const* d_in, const int* in_sizes, int n_in, void* d_out, int out_size, void* d_ws, size_t ws_size, hipStream_t stream) {
    static int grid = 0;
    if (grid == 0) {
        if (n_in != 31 || (size_t)out_size != O_END || ws_size < WS_END) { fprintf(stderr, "kernel_launch: unexpected shapes: n_in %d out %d ws %zu (need >= %zu)\n", n_in, out_size, ws_size, (size_t)WS_END); grid = -1; return; }
        int dev = 0, cus = 0, per_cu = 0;
        if (hipGetDevice(&dev) != hipSuccess || hipDeviceGetAttribute(&cus, hipDeviceAttributeMultiprocessorCount, dev) != hipSuccess) { grid = -1; return; }
        if (hipFuncSetAttribute((const void*)mk_fwd, hipFuncAttributeMaxDynamicSharedMemorySize, LDS_BYTES) != hipSuccess) { fprintf(stderr, "kernel_launch: hipFuncSetAttribute failed\n"); grid = -1; return; }
        if (hipOccupancyMaxActiveBlocksPerMultiprocessor(&per_cu, (const void*)mk_fwd, NWAVES * 64, LDS_BYTES) != hipSuccess || per_cu < 1) { fprintf(stderr, "kernel_launch: occupancy query says %d\n", per_cu); }
        (void)hipGetLastError();
        grid = cus;
    }
    if (grid < 0) return;
    (void)hipMemsetAsync((char*)d_ws + WS_CTL, 0, CTL_ZERO_BYTES, stream);
    Params p{};
    for (int i = 0; i < 31; ++i) p.in[i] = (const float*)d_in[i];
    p.out = (float*)d_out; p.ws = (unsigned char*)d_ws;
    hipLaunchKernelGGL(mk_fwd, dim3(grid), dim3(NWAVES * 64), LDS_BYTES, stream, p);
    const hipError_t le = hipPeekAtLastError();
    if (le != hipSuccess) fprintf(stderr, "kernel_launch: launch failed: %s\n", hipGetErrorName(le));
}
```
